# Optimizing an MI355X kernel written in HIP

```python
import math
import jax, jax.numpy as jnp
from jax import lax
import numpy as np

D_MODEL = 1024
BATCH = 8
SEQ = 4096
DEPTH = 1

GRID_W = 64
CTX_LEN = 256
D_HYENA = 512
D_GLA = D_MODEL - D_HYENA
GLA_HEADS = 4
GLA_DK = D_GLA // 2
GLA_DV = D_GLA
GLA_HEAD_DK = GLA_DK // GLA_HEADS
GLA_HEAD_DV = GLA_DV // GLA_HEADS
GATE_RANK = 16
GATE_NORMALIZER = 16.0
GLA_CHUNK = 64
SHORT_CONV = 3
FILTER_EMB = 33
FILTER_BANDS = (FILTER_EMB - 1) // 2
FILTER_HIDDEN = 64
FAST_DECAY_PCT = 0.3
SLOW_DECAY_PCT = 1.5
DECAY_TARGET = 1e-2
D_FF = 4 * D_MODEL
EPS = 1e-6
PROJ_WIDTHS = (3 * D_HYENA, GLA_DK, GLA_DK, GLA_DV, GLA_DV, GATE_RANK, GATE_RANK)
PROJ_SPLITS = tuple(int(s) for s in np.cumsum(PROJ_WIDTHS)[:-1])
N_IN = sum(PROJ_WIDTHS)

kernel_name = 'hybrid_hyena_gla_prefix_dit'


def _rms_norm(x, g):
    xf = x.astype(jnp.float32)
    y = xf * lax.rsqrt(jnp.mean(xf * xf, axis=-1, keepdims=True) + EPS)
    return (y * g.astype(jnp.float32)).astype(x.dtype)


def _sq_relu_mlp(h, w1, w2):
    return jnp.square(jax.nn.relu(h @ w1)) @ w2


def _short_conv(u, w, b):
    t = u.shape[-2]
    pad = SHORT_CONV // 2
    up = jnp.pad(u, [(0, 0)] * (u.ndim - 2) + [(pad, pad), (0, 0)])
    out = b
    for j in range(SHORT_CONV):
        out = out + w[j] * up[..., j:j + t, :]
    return out


def _hyena_spectrum(length, w1, b1, w2, b2, w3, b3, freq, wout):
    f32 = jnp.float32
    t = jnp.linspace(0.0, 1.0, length, dtype=f32)[:, None]
    w = 2.0 * math.pi * jnp.arange(length, dtype=f32) / length
    f = jnp.linspace(1e-4, FILTER_BANDS - 1, FILTER_BANDS, dtype=f32)
    ang = w[:, None] * f[None, :]
    z = jnp.concatenate([t, jnp.cos(ang), -jnp.sin(ang)], axis=-1)
    fr = freq.astype(f32)
    hdn = jnp.sin(fr * (z @ w1.astype(f32) + b1.astype(f32)))
    hdn = jnp.sin(fr * (hdn @ w2.astype(f32) + b2.astype(f32)))
    hdn = jnp.sin(fr * (hdn @ w3.astype(f32) + b3.astype(f32)))
    h = (hdn @ wout.astype(f32)).reshape(length, 2, D_HYENA)
    min_decay = math.log(DECAY_TARGET) / SLOW_DECAY_PCT
    max_decay = math.log(DECAY_TARGET) / FAST_DECAY_PCT
    deltas = jnp.abs(jnp.linspace(min_decay, max_decay, D_HYENA, dtype=f32))
    h = h * jnp.exp(-t * deltas)[:, None, :]
    kern = jnp.concatenate([h[:, 0], jnp.zeros((1, D_HYENA), f32), h[:0:-1, 1]], axis=0)
    kern = kern * lax.rsqrt(jnp.sum(kern * kern, axis=0, keepdims=True) + EPS)
    return jnp.fft.rfft(kern, axis=0)


def _long_conv(u, spec, bias):
    length = u.shape[1]
    uf = u.astype(jnp.float32)
    y = jnp.fft.irfft(jnp.fft.rfft(uf, n=2 * length, axis=1) * spec, n=2 * length, axis=1)[:, :length]
    return (y + uf * bias.astype(jnp.float32)).astype(u.dtype)


def _hyena_gate_conv(u, spec, bias):
    x0, x1, v = jnp.split(u, 3, axis=-1)
    return x0 * _long_conv(x1 * v, spec, bias)


def _to_heads(z, n_heads):
    b, t, w = z.shape
    return z.reshape(b, t, n_heads, w // n_heads).transpose(0, 2, 1, 3)


def _log_gate(gr, w, b):
    lg = jax.nn.log_sigmoid(gr.astype(jnp.float32) @ w.astype(jnp.float32) + b.astype(jnp.float32))
    return _to_heads(lg / GATE_NORMALIZER, GLA_HEADS)


def _gla_chunked(q, k, v, lg, s0):
    bsz, nh, t, dk = q.shape
    dv = v.shape[-1]
    n = t // GLA_CHUNK
    q = q.reshape(bsz, nh, n, GLA_CHUNK, dk)
    k = k.reshape(bsz, nh, n, GLA_CHUNK, dk)
    lg = lg.reshape(bsz, nh, n, GLA_CHUNK, dk)
    v = v.reshape(bsz, nh, n, GLA_CHUNK, dv)
    b = jnp.cumsum(lg, axis=3)
    b_last = b[:, :, :, -1:, :]
    q_in = q * jnp.exp(b)
    k_in = k * jnp.exp(-b)
    k_end = k * jnp.exp(b_last - b)
    mask = jnp.tril(jnp.ones((GLA_CHUNK, GLA_CHUNK), dtype=bool))
    att = jnp.where(mask, jnp.einsum('bhncd,bhnsd->bhncs', q_in, k_in), 0.0)
    o_intra = jnp.einsum('bhncs,bhnse->bhnce', att, v)
    ds = jnp.einsum('bhnsd,bhnse->nbhde', k_end, v)
    decay = jnp.moveaxis(jnp.exp(b_last[:, :, :, 0, :]), 2, 0)

    def step(s, inp):
        d, dsn = inp
        return d[..., None] * s + dsn, s

    s_final, s_start = lax.scan(step, s0, (decay, ds))
    o_inter = jnp.einsum('bhncd,nbhde->bhnce', q_in, s_start)
    return (o_intra + o_inter).reshape(bsz, nh, t, dv), s_final


def _gla_final_state(k, v, lg):
    b = jnp.cumsum(lg, axis=2)
    return jnp.einsum('bhtd,bhte->bhde', k * jnp.exp(b[:, :, -1:] - b), v)


def _rev(a):
    return jnp.flip(a, axis=2)


def _gla_bidir(q, k, v, lg_f, lg_b, s_f0, s_b0):
    o_f, s_f = _gla_chunked(q, k, v, lg_f, s_f0)
    o_b, s_b = _gla_chunked(_rev(q), _rev(k), _rev(v), _rev(lg_b), s_b0)
    return o_f + _rev(o_b), s_f, s_b


def _gla_heads(q, k, v):
    f32 = jnp.float32
    qh = _to_heads(q.astype(f32), GLA_HEADS) * (GLA_HEAD_DK ** -0.5)
    return qh, _to_heads(k.astype(f32), GLA_HEADS), _to_heads(v.astype(f32), GLA_HEADS)


def _gla_output(o, og, g_norm):
    on = o * lax.rsqrt(jnp.mean(o * o, axis=-1, keepdims=True) + EPS) * g_norm.astype(jnp.float32)
    bsz, _, t, _ = o.shape
    y = on.transpose(0, 2, 1, 3).reshape(bsz, t, GLA_DV)
    return (y * jax.nn.silu(og.astype(jnp.float32))).astype(og.dtype)


def setup_inputs(seed: int = 0) -> dict:
    key = jax.random.key(seed)
    ks = jax.random.split(key, 29)
    D = D_MODEL
    L = DEPTH

    def nrm(i, shape, scale):
        return scale * jax.random.normal(ks[i], shape, jnp.float32)

    return {
        'x': nrm(0, (BATCH, SEQ, D), 1.0),
        'c': nrm(1, (BATCH, D), 1.0),
        'ctx': nrm(2, (BATCH, CTX_LEN, D), 1.0),
        'c_ctx': nrm(3, (D,), 1.0),
        'w_ada': nrm(4, (L, D, 6 * D), 0.5 * D ** -0.5),
        'b_ada': nrm(5, (L, 6 * D), 0.02),
        'norm_mix': 1.0 + nrm(6, (L, D), 0.05),
        'norm_mlp': 1.0 + nrm(7, (L, D), 0.05),
        'w_in': nrm(8, (L, D, N_IN), D ** -0.5),
        'conv_w': nrm(9, (L, SHORT_CONV, 3 * D_HYENA), SHORT_CONV ** -0.5),
        'conv_b': nrm(10, (L, 3 * D_HYENA), 0.02),
        'filt_w1': nrm(11, (L, FILTER_EMB, FILTER_HIDDEN), FILTER_EMB ** -0.5),
        'filt_b1': nrm(12, (L, FILTER_HIDDEN), 0.1),
        'filt_w2': nrm(13, (L, FILTER_HIDDEN, FILTER_HIDDEN), FILTER_HIDDEN ** -0.5),
        'filt_b2': nrm(14, (L, FILTER_HIDDEN), 0.1),
        'filt_w3': nrm(15, (L, FILTER_HIDDEN, FILTER_HIDDEN), FILTER_HIDDEN ** -0.5),
        'filt_b3': nrm(16, (L, FILTER_HIDDEN), 0.1),
        'filt_freq': 1.0 + nrm(17, (L, FILTER_HIDDEN), 0.1),
        'filt_wout': nrm(18, (L, FILTER_HIDDEN, 2 * D_HYENA), FILTER_HIDDEN ** -0.5),
        'hyena_bias': nrm(19, (L, D_HYENA), 0.5),
        'gk_w_fwd': nrm(20, (L, GATE_RANK, GLA_DK), GATE_RANK ** -0.5),
        'gk_b_fwd': nrm(21, (L, GLA_DK), 0.1),
        'gk_w_bwd': nrm(22, (L, GATE_RANK, GLA_DK), GATE_RANK ** -0.5),
        'gk_b_bwd': nrm(23, (L, GLA_DK), 0.1),
        'gla_norm': 1.0 + nrm(24, (L, GLA_HEAD_DV), 0.05),
        'w_out': nrm(25, (L, D, D), D ** -0.5),
        'w_mlp1': nrm(26, (L, D, D_FF), D ** -0.5),
        'w_mlp2': nrm(27, (L, D_FF, D), D_FF ** -0.5),
        'norm_final': 1.0 + nrm(28, (D,), 0.05),
    }


def reference(x, c, ctx, c_ctx, w_ada, b_ada, norm_mix, norm_mlp, w_in, conv_w, conv_b,
              filt_w1, filt_b1, filt_w2, filt_b2, filt_w3, filt_b3, filt_freq, filt_wout,
              hyena_bias, gk_w_fwd, gk_b_fwd, gk_w_bwd, gk_b_bwd, gla_norm, w_out,
              w_mlp1, w_mlp2, norm_final):
    bsz, seq, _ = x.shape
    rows = seq // GRID_W
    ctx_len = ctx.shape[1]
    for l in range(DEPTH):
        last = l == DEPTH - 1
        filt = (filt_w1[l], filt_b1[l], filt_w2[l], filt_b2[l], filt_w3[l], filt_b3[l], filt_freq[l], filt_wout[l])
        mod = jax.nn.silu(c) @ w_ada[l] + b_ada[l]
        mod_c = jax.nn.silu(c_ctx) @ w_ada[l] + b_ada[l]
        sh1, sc1, g1, sh2, sc2, g2 = jnp.split(mod[:, None, :], 6, axis=-1)
        csh1, csc1, cg1, csh2, csc2, cg2 = jnp.split(mod_c, 6)

        h_lat = _rms_norm(x, norm_mix[l]) * (1.0 + sc1) + sh1
        h_ctx = _rms_norm(ctx, norm_mix[l]) * (1.0 + csc1) + csh1
        hy_l, q_l, k_l, v_l, og_l, gf_l, gb_l = jnp.split(h_lat @ w_in[l], PROJ_SPLITS, axis=-1)
        hy_c, q_c, k_c, v_c, og_c, gf_c, gb_c = jnp.split(h_ctx @ w_in[l], PROJ_SPLITS, axis=-1)

        qh_c, kh_c, vh_c = _gla_heads(q_c, k_c, v_c)
        lgf_c = _log_gate(gf_c, gk_w_fwd[l], gk_b_fwd[l])
        lgb_c = _log_gate(gb_c, gk_w_bwd[l], gk_b_bwd[l])
        if last:
            s_f = _gla_final_state(kh_c, vh_c, lgf_c)
            s_b = _gla_final_state(_rev(kh_c), _rev(vh_c), _rev(lgb_c))
        else:
            zeros = jnp.zeros((bsz, GLA_HEADS, GLA_HEAD_DK, GLA_HEAD_DV), jnp.float32)
            o_c, s_f, s_b = _gla_bidir(qh_c, kh_c, vh_c, lgf_c, lgb_c, zeros, zeros)

        qh_l, kh_l, vh_l = _gla_heads(q_l, k_l, v_l)
        lgf_l = _log_gate(gf_l, gk_w_fwd[l], gk_b_fwd[l])
        lgb_l = _log_gate(gb_l, gk_w_bwd[l], gk_b_bwd[l])
        o_l, _, _ = _gla_bidir(qh_l, kh_l, vh_l, lgf_l, lgb_l, s_f, s_b)
        y_gla_l = _gla_output(o_l, og_l, gla_norm[l])

        u_l = _short_conv(hy_l.reshape(bsz, rows, GRID_W, 3 * D_HYENA), conv_w[l], conv_b[l])
        u_l = u_l.reshape(bsz, seq, 3 * D_HYENA)
        y_hy_l = _hyena_gate_conv(u_l, _hyena_spectrum(seq, *filt), hyena_bias[l])

        x = x + g1 * (jnp.concatenate([y_hy_l, y_gla_l], axis=-1) @ w_out[l])
        h2 = _rms_norm(x, norm_mlp[l]) * (1.0 + sc2) + sh2
        x = x + g2 * _sq_relu_mlp(h2, w_mlp1[l], w_mlp2[l])

        if not last:
            u_c = _short_conv(hy_c, conv_w[l], conv_b[l])
            y_hy_c = _hyena_gate_conv(u_c, _hyena_spectrum(ctx_len, *filt), hyena_bias[l])
            y_gla_c = _gla_output(o_c, og_c, gla_norm[l])
            ctx = ctx + cg1 * (jnp.concatenate([y_hy_c, y_gla_c], axis=-1) @ w_out[l])
            h2c = _rms_norm(ctx, norm_mlp[l]) * (1.0 + csc2) + csh2
            ctx = ctx + cg2 * _sq_relu_mlp(h2c, w_mlp1[l], w_mlp2[l])
    return _rms_norm(x, norm_final)
```

```cpp
#include <hip/hip_runtime.h>
#include <hip/hip_cooperative_groups.h>
#include <cstdio>
#include <cstdint>
#include <cmath>
namespace cg = cooperative_groups;
namespace pg8 {
#define PG8_LAS __attribute__((address_space(3)))
typedef unsigned short bf16_t;
typedef short bf16x8 __attribute__((ext_vector_type(8)));
typedef float f32x4 __attribute__((ext_vector_type(4)));
typedef unsigned u32x4 __attribute__((ext_vector_type(4)));
constexpr int BM = 256, BK = 64, HALF = 128, HTB = HALF * BK * 2  , STAGE_BYTES = 8 * HTB, NXCD = 8, WGM = 8;

__host__ __device__ __forceinline__ int lds_byte(int r, int c) { const int st = (r >> 4) * 2 + (c >> 5), rr = r & 15, cc = c & 31, ob = rr * 64 + cc * 2; return st * 1024 + (ob ^ (((ob >> 9) & 1) << 5)); }
__host__ __device__ __forceinline__ void stage_rc(int b, int& R, int& C) { const int st = b / 1024, sb = b % 1024, swz = sb ^ (((sb >> 9) & 1) << 5); R = (st >> 1) * 16 + swz / 64; C = (st & 1) * 32 + (swz % 64) / 2; }
__host__ __device__ __forceinline__ int perm32(int rho) { const int n = rho >> 4, i = rho & 15; return 8 * (i >> 2) + 4 * n + (i & 3); }

struct Unit { int pm, pn; };
struct Gemm { const bf16_t* A; const bf16_t* Bt; int M, N, K; };

struct StaticOrder {
    int nM, nN, nwg, G, c;
    __host__ __device__ void init(int M, int N, int G_, int c_) { nM = M / BM; nN = N / BM; nwg = nM * nN; G = G_; c = c_; }
    __host__ __device__ bool next(int i, Unit& u) const {
        const long L = (long)i * G + c; if (L >= nwg) return false;
        int wgid = (int)L; { const int q = nwg / NXCD, r = nwg % NXCD, xcd = wgid % NXCD, off = wgid / NXCD; wgid = (xcd < r ? xcd * (q + 1) : r * (q + 1) + (xcd - r) * q) + off; }
        const int nig = WGM * nN, gid = wgid / nig, fm = gid * WGM, gsz = (nM - fm) < WGM ? (nM - fm) : WGM;
        u.pm = fm + ((wgid % nig) % gsz); u.pn = (wgid % nig) / gsz; return true;
    }
    __device__ __forceinline__ void a_ready(const Unit&) const {}
    __device__ __forceinline__ void done(const Unit&) const {}
};


__device__ __forceinline__ unsigned cvt_pk_bf16(float lo, float hi) { unsigned r; asm volatile("v_cvt_pk_bf16_f32 %0, %1, %2" : "=v"(r) : "v"(lo), "v"(hi)); return r; }

template <int ACT> struct EpiBf16 {
    static constexpr bool PERM = true, AFTER_DRAIN = false;
    bf16_t* O; int ldc;
    __device__ __forceinline__ void operator()(const f32x4 (&acc)[2][2][4][2], const Unit& u, int wr, int wc, int fr, int fq) const {
        const int row0 = u.pm * BM + wr * 64 + fr; const int col0 = u.pn * BM + wc * 32 + 8 * fq;
#pragma unroll
        for (int ai = 0; ai < 2; ++ai)
#pragma unroll
            for (int m = 0; m < 4; ++m) { bf16_t* rowp = O + (size_t)(row0 + ai * HALF + m * 16) * ldc + col0;
#pragma unroll
                for (int bj = 0; bj < 2; ++bj) { f32x4 v0 = acc[ai][bj][m][0], v1 = acc[ai][bj][m][1];
                    if (ACT == 1) {
#pragma unroll
                        for (int q = 0; q < 4; ++q) { const float a0 = fmaxf(v0[q], 0.f), a1 = fmaxf(v1[q], 0.f); v0[q] = a0 * a0; v1[q] = a1 * a1; } }
                    u32x4 w; w.x = cvt_pk_bf16(v0[0], v0[1]); w.y = cvt_pk_bf16(v0[2], v0[3]); w.z = cvt_pk_bf16(v1[0], v1[1]); w.w = cvt_pk_bf16(v1[2], v1[3]);
                    *(u32x4*)(rowp + bj * HALF) = w; } }
    }
};
struct EpiResid {
    static constexpr bool PERM = false, AFTER_DRAIN = false;
    const float* base; float* out; int ldc; const float* gate; int rows_per_gate; int gate_stride;
    __device__ __forceinline__ void operator()(const f32x4 (&acc)[2][2][4][2], const Unit& u, int wr, int wc, int fr, int fq) const {
        const int row0 = u.pm * BM + wr * 64 + fr, col0 = u.pn * BM + wc * 32 + 4 * fq;
        const float* gp = gate + (size_t)((u.pm * BM) / rows_per_gate) * gate_stride + col0;
        f32x4 gv[2][2];
#pragma unroll
        for (int bj = 0; bj < 2; ++bj)
#pragma unroll
            for (int n = 0; n < 2; ++n) gv[bj][n] = *(const f32x4*)(gp + bj * HALF + n * 16);
#pragma unroll
        for (int ai = 0; ai < 2; ++ai)
#pragma unroll
            for (int m = 0; m < 4; ++m) { const size_t off = (size_t)(row0 + ai * HALF + m * 16) * ldc + col0;
#pragma unroll
                for (int bj = 0; bj < 2; ++bj)
#pragma unroll
                    for (int n = 0; n < 2; ++n) { const f32x4 bs = *(const f32x4*)(base + off + bj * HALF + n * 16);
                        *(f32x4*)(out + off + bj * HALF + n * 16) = bs + gv[bj][n] * acc[ai][bj][m][n]; } }
    }
};

template <class Epi, class Sched, bool ALIGN_EPI = false, bool SP2 = false>
__device__ __forceinline__ void gemm_phase(PG8_LAS unsigned char* lds, const Gemm g, const Sched& S, const Epi& E) {
    const int tid = threadIdx.x, wid = __builtin_amdgcn_readfirstlane(tid >> 6), lane = tid & 63, wr = wid >> 2, wc = wid & 3, fr = lane & 15, fq = lane >> 4;
    const int K = g.K, nt = K / BK;
    unsigned voffA[2], voffB[2];
#pragma unroll
    for (int i = 0; i < 2; ++i) { int R, C; stage_rc(tid * 16 + i * 8192, R, C); const int Rb = Epi::PERM ? ((R & ~31) + perm32(R & 31)) : R;
        voffA[i] = (unsigned)(R * K + C) * 2u; voffB[i] = (unsigned)(Rb * K + C) * 2u; }
    const size_t kstep = (size_t)(BK * 2);
    const size_t hstep = (size_t)HALF * K * 2;
    const size_t tstep = 2 * hstep;
    const unsigned ldsw = (unsigned)wid * 1024u;
    const int aoff = lds_byte(wr * 64 + fr, fq * 8), boff = lds_byte(wc * 32 + fr, fq * 8);
#define PG8_SA(b, h) (((b) * 2 + (h)) * HTB)
#define PG8_SB(b, h) ((4 + (b) * 2 + (h)) * HTB)
#define PG8_STAGE(bufoff, gbase, voff) do { _Pragma("unroll") for (int _i = 0; _i < 2; ++_i) \
        __builtin_amdgcn_global_load_lds((const unsigned*)((const char*)(gbase) + (voff)[_i]), (PG8_LAS unsigned*)(lds + (bufoff) + ldsw + _i * 8192), 16, 0, 0); } while (0)
#define PG8_LDA(dst, b, h) do { _Pragma("unroll") for (int m = 0; m < 4; ++m) _Pragma("unroll") for (int k = 0; k < 2; ++k) dst[m][k] = *(const PG8_LAS bf16x8*)(lds + PG8_SA(b, h) + aoff + m * 2048 + k * 1024); } while (0)
#define PG8_LDB(dst, b, h) do { _Pragma("unroll") for (int n = 0; n < 2; ++n) _Pragma("unroll") for (int k = 0; k < 2; ++k) dst[n][k] = *(const PG8_LAS bf16x8*)(lds + PG8_SB(b, h) + boff + n * 2048 + k * 1024); } while (0)
#define PG8_MMA(ai, bj, At, Bt) do { __builtin_amdgcn_s_setprio(1); _Pragma("unroll") for (int m = 0; m < 4; ++m) _Pragma("unroll") for (int n = 0; n < 2; ++n) _Pragma("unroll") for (int k = 0; k < 2; ++k) \
        acc[ai][bj][m][n] = __builtin_amdgcn_mfma_f32_16x16x32_bf16(Bt[n][k], At[m][k], acc[ai][bj][m][n], 0, 0, 0); __builtin_amdgcn_s_setprio(0); } while (0)
#define PG8_WAIT_V(n) asm volatile("s_waitcnt vmcnt(" #n ")" ::: "memory")
#define PG8_WAIT_L(n) asm volatile("s_waitcnt lgkmcnt(" #n ")" ::: "memory")
#define PG8_BAR __builtin_amdgcn_s_barrier()
#define PG8_SCHED __builtin_amdgcn_sched_barrier(0)
    Unit cur, nxt; int ui = 0;
    if (!S.next(0, cur)) return;
    f32x4 acc[2][2][4][2];
#pragma unroll
    for (int a = 0; a < 2; ++a)
#pragma unroll
        for (int b = 0; b < 2; ++b)
#pragma unroll
            for (int m = 0; m < 4; ++m)
#pragma unroll
                for (int n = 0; n < 2; ++n) acc[a][b][m][n] = (f32x4){0.f, 0.f, 0.f, 0.f};
    bf16x8 At[4][2], B0[2][2], B1[2][2];
    const char* cA = (const char*)g.A + (size_t)cur.pm * tstep; const char* cB = (const char*)g.Bt + (size_t)cur.pn * tstep;
    S.a_ready(cur);
    if constexpr (SP2) {
        PG8_STAGE(PG8_SB(0, 0), cB, voffB); PG8_STAGE(PG8_SB(0, 1), cB + hstep, voffB); PG8_STAGE(PG8_SA(0, 0), cA, voffA); PG8_STAGE(PG8_SA(0, 1), cA + hstep, voffA);
        if (wr == 1) PG8_BAR;
        PG8_WAIT_V(2); PG8_BAR;
        PG8_STAGE(PG8_SB(1, 0), cB + kstep, voffB); PG8_STAGE(PG8_SA(1, 0), cA + kstep, voffA); PG8_STAGE(PG8_SB(1, 1), cB + hstep + kstep, voffB);
        PG8_WAIT_V(6); PG8_BAR;
    } else {
        PG8_STAGE(PG8_SB(0, 0), cB, voffB); PG8_STAGE(PG8_SA(0, 0), cA, voffA); PG8_STAGE(PG8_SB(0, 1), cB + hstep, voffB); PG8_STAGE(PG8_SA(0, 1), cA + hstep, voffA);
        if (wr == 1) PG8_BAR;
        PG8_WAIT_V(4); PG8_BAR;
        PG8_STAGE(PG8_SB(1, 0), cB + kstep, voffB); PG8_STAGE(PG8_SA(1, 0), cA + kstep, voffA); PG8_STAGE(PG8_SB(1, 1), cB + hstep + kstep, voffB);
        PG8_WAIT_V(6); PG8_BAR;
    }
    for (;;) {
        const bool has_next = S.next(ui + 1, nxt);
        const char* nA = has_next ? (const char*)g.A + (size_t)nxt.pm * tstep : cA; const char* nB = has_next ? (const char*)g.Bt + (size_t)nxt.pn * tstep : cB;
        for (int t = 0; t < nt; t += 2) {
            const bool last = (t == nt - 2);
            const char* a1 = cA + (size_t)(t + 1) * kstep;
            const char* a2 = last ? nA : cA + (size_t)(t + 2) * kstep; const char* b2 = last ? nB : cB + (size_t)(t + 2) * kstep;
            const char* a3 = a2 + kstep; const char* b3 = b2 + kstep;
            if (last && has_next) S.a_ready(nxt);
            if constexpr (SP2) {
            PG8_LDB(B0, 0, 0); PG8_LDB(B1, 0, 1); PG8_SCHED; PG8_LDA(At, 0, 0); PG8_STAGE(PG8_SA(1, 1), a1 + hstep, voffA);
            PG8_WAIT_V(8); PG8_WAIT_L(0); PG8_BAR; PG8_MMA(0, 0, At, B0); PG8_MMA(0, 1, At, B1); PG8_BAR; PG8_SCHED;
            PG8_LDA(At, 0, 1); PG8_STAGE(PG8_SB(0, 0), b2, voffB); PG8_STAGE(PG8_SB(0, 1), b2 + hstep, voffB); PG8_STAGE(PG8_SA(0, 0), a2, voffA);
            PG8_WAIT_V(8); PG8_WAIT_L(0); PG8_BAR; PG8_MMA(1, 0, At, B0); PG8_MMA(1, 1, At, B1); PG8_BAR; PG8_SCHED;
            PG8_LDB(B0, 1, 0); PG8_LDB(B1, 1, 1); PG8_SCHED; PG8_LDA(At, 1, 0); PG8_STAGE(PG8_SA(0, 1), a2 + hstep, voffA);
            PG8_WAIT_V(8); PG8_WAIT_L(0); PG8_BAR; PG8_MMA(0, 0, At, B0); PG8_MMA(0, 1, At, B1); PG8_BAR; PG8_SCHED;
            PG8_LDA(At, 1, 1); PG8_STAGE(PG8_SB(1, 0), b3, voffB); PG8_STAGE(PG8_SB(1, 1), b3 + hstep, voffB); PG8_STAGE(PG8_SA(1, 0), a3, voffA);
            PG8_WAIT_V(8); PG8_WAIT_L(0); PG8_BAR; PG8_MMA(1, 0, At, B0); PG8_MMA(1, 1, At, B1); PG8_BAR; PG8_SCHED;
            } else {
            PG8_LDB(B0, 0, 0); PG8_SCHED; PG8_LDA(At, 0, 0); PG8_STAGE(PG8_SA(1, 1), a1 + hstep, voffA);
            PG8_WAIT_L(8); PG8_BAR; PG8_WAIT_L(0); PG8_MMA(0, 0, At, B0); PG8_BAR; PG8_SCHED;
            PG8_LDB(B1, 0, 1); PG8_STAGE(PG8_SB(0, 0), b2, voffB);
            PG8_BAR; PG8_WAIT_L(0); PG8_MMA(0, 1, At, B1); PG8_BAR;
            PG8_LDA(At, 0, 1); PG8_STAGE(PG8_SA(0, 0), a2, voffA);
            PG8_BAR; PG8_WAIT_L(0); PG8_MMA(1, 0, At, B0); PG8_BAR; PG8_SCHED;
            PG8_STAGE(PG8_SB(0, 1), b2 + hstep, voffB);
            PG8_WAIT_V(6); PG8_BAR; PG8_MMA(1, 1, At, B1); PG8_BAR;
            PG8_LDB(B0, 1, 0); PG8_SCHED; PG8_LDA(At, 1, 0); PG8_STAGE(PG8_SA(0, 1), a2 + hstep, voffA);
            PG8_WAIT_L(8); PG8_BAR; PG8_WAIT_L(0); PG8_MMA(0, 0, At, B0); PG8_BAR; PG8_SCHED;
            PG8_LDB(B1, 1, 1); PG8_STAGE(PG8_SB(1, 0), b3, voffB);
            PG8_BAR; PG8_WAIT_L(0); PG8_MMA(0, 1, At, B1); PG8_BAR;
            PG8_LDA(At, 1, 1); PG8_STAGE(PG8_SA(1, 0), a3, voffA);
            PG8_BAR; PG8_WAIT_L(0); PG8_MMA(1, 0, At, B0); PG8_BAR; PG8_SCHED;
            PG8_STAGE(PG8_SB(1, 1), b3 + hstep, voffB);
            PG8_WAIT_V(6); PG8_BAR; PG8_MMA(1, 1, At, B1); PG8_BAR;
            }
        }
        if constexpr (ALIGN_EPI) { if (wr == 0) PG8_BAR; }
        if constexpr (!Epi::AFTER_DRAIN) { E(acc, cur, wr, wc, fr, fq); S.done(cur); }
        if (!has_next) break;
#pragma unroll
        for (int a = 0; a < 2; ++a)
#pragma unroll
            for (int b = 0; b < 2; ++b)
#pragma unroll
                for (int m = 0; m < 4; ++m)
#pragma unroll
                    for (int n = 0; n < 2; ++n) acc[a][b][m][n] = (f32x4){0.f, 0.f, 0.f, 0.f};
        cur = nxt; cA = nA; cB = nB; ++ui;
        if constexpr (ALIGN_EPI) { if (wr == 1) PG8_BAR; }
    }
    PG8_WAIT_V(0);
    if constexpr (!ALIGN_EPI) { if (wr == 0) PG8_BAR; }
    PG8_BAR;
    if constexpr (Epi::AFTER_DRAIN) { E.fused(acc, cur, wr, wc, fr, fq, lds, wid, lane); S.done(cur); }
#undef PG8_SA
#undef PG8_SB
#undef PG8_STAGE
#undef PG8_LDA
#undef PG8_LDB
#undef PG8_MMA
#undef PG8_WAIT_V
#undef PG8_WAIT_L
#undef PG8_BAR
#undef PG8_SCHED
}
}

constexpr int NB = 8, SEQ = 4096, DM = 1024, CTXL = 256;
constexpr int MLAT = NB * SEQ, MCTX = NB * CTXL, MALL = MLAT + MCTX;
constexpr int DH = 512, NHY = 1536, NGL = 1792, NINP = NHY + NGL, NIN = 3104, FF = 4096;
constexpr int GQ = 0, GK = 256, GV = 512, GOG = 1024, GGF = 1536;
constexpr int NSIG = 68, NITEM = NB * 4 * 2 * NSIG;
constexpr float EPSF = 1e-6f;
constexpr int MOD_SH1 = 0, MOD_SC1 = 1024, MOD_G1 = 2048, MOD_SH2 = 3072, MOD_SC2 = 4096, MOD_G2 = 5120, MODW = 6144;

constexpr size_t MiB = 1u << 20;
constexpr size_t WS_CTL = 0, WS_MOD = 1 * MiB, WS_SSQ = 2 * MiB, WS_WIN = 4 * MiB, WS_WOUT = 11 * MiB, WS_W1 = 13 * MiB, WS_W2 = 21 * MiB;
constexpr size_t WS_KRAW = 30 * MiB, WS_DEC = 46 * MiB, WS_XN = 48 * MiB  , WS_HYT = 116 * MiB, WS_GPROJ = 212 * MiB;
constexpr size_t WS_YT = 331 * MiB, WS_YCAT = 363 * MiB, WS_HID = 116 * MiB  , WS_END = 427 * MiB;
static_assert(WS_WIN + (size_t)NINP * DM * 2 <= WS_WOUT && WS_W2 + (size_t)DM * FF * 2 <= WS_KRAW && WS_KRAW + (size_t)DH * 8192 * 4 <= WS_DEC, "ws map 1");
static_assert(WS_DEC + (size_t)NITEM * 64 * 4 <= WS_XN && WS_XN + (size_t)MALL * DM * 2 <= WS_HYT && WS_XN + (size_t)NITEM * 8192 * 2 <= WS_HYT, "ws map 2");
static_assert(WS_HYT + (size_t)NHY * MLAT * 2 <= WS_GPROJ && WS_GPROJ + (size_t)MALL * NGL * 2 <= WS_YT && WS_YT + (size_t)DH * MLAT * 2 <= WS_YCAT, "ws map 3");
static_assert(WS_HID + (size_t)MLAT * FF * 2 <= WS_YCAT + (size_t)MLAT * DM * 2 && WS_YCAT + (size_t)MLAT * DM * 2 <= WS_END, "ws map 4");

constexpr int NTHR = 512, NWAVES = 8;
constexpr int LDS_BYTES = 147456;

#define LAS __attribute__((address_space(3)))
typedef unsigned short bf16;
typedef unsigned v4u __attribute__((ext_vector_type(4)));
typedef unsigned v2u __attribute__((ext_vector_type(2)));
typedef float f32x4 __attribute__((ext_vector_type(4)));
#define LDS_WAIT() asm volatile("s_waitcnt lgkmcnt(0)" ::: "memory")

__device__ __forceinline__ unsigned f2bf(float f) { unsigned u = __builtin_bit_cast(unsigned, f); return (u + 0x7fffu + ((u >> 16) & 1u)) >> 16; }
__device__ __forceinline__ unsigned pk2(float lo, float hi) { return f2bf(lo) | (f2bf(hi) << 16); }
__device__ __forceinline__ float bf2f(unsigned h) { return __builtin_bit_cast(float, h << 16); }
__device__ __forceinline__ float wave_sum(float v) {
#pragma unroll
    for (int o = 1; o < 64; o <<= 1) v += __shfl_xor(v, o);
    return v;
}
__device__ __forceinline__ float siluf(float v) { return v / (1.f + __expf(-v)); }
__device__ __forceinline__ float logsigmoidf(float a) { return fminf(a, 0.f) - log1pf(__expf(-fabsf(a))); }

struct Args { const float* in[29]; float* out; unsigned char* ws; int ph_lo, ph_hi; };

enum { I_X = 0, I_C, I_CTX, I_CCTX, I_WADA, I_BADA, I_NMIX, I_NMLP, I_WIN, I_CONVW, I_CONVB, I_FW1, I_FB1, I_FW2, I_FB2, I_FW3, I_FB3, I_FFREQ, I_FWOUT,
       I_HBIAS, I_GKWF, I_GKBF, I_GKWB, I_GKBB, I_GLAN, I_WOUT, I_WM1, I_WM2, I_NFIN };

__device__ __forceinline__ void p0_transpose_item(const float* W, int K, int N, bf16* WT, int row_off, float* scr, int item, int lane) {
    const int nblk = N / 32, kb = item / nblk, nb = item % nblk, k0 = 64 * kb, n0 = 32 * nb;
#pragma unroll 8
    for (int i = 0; i < 32; ++i) { const int kk = 2 * i + (lane >> 5); scr[kk * 33 + (lane & 31)] = W[(size_t)(k0 + kk) * N + n0 + (lane & 31)]; }
    LDS_WAIT(); asm volatile("" ::: "memory");
    const int c = lane & 7;
#pragma unroll
    for (int j = 0; j < 4; ++j) { const int n = (lane >> 3) + 8 * j; const float* s = scr + (8 * c) * 33 + n;
        v4u o; o.x = pk2(s[0 * 33], s[1 * 33]); o.y = pk2(s[2 * 33], s[3 * 33]); o.z = pk2(s[4 * 33], s[5 * 33]); o.w = pk2(s[6 * 33], s[7 * 33]);
        *(v4u*)(WT + (size_t)(row_off + n0 + n) * K + k0 + 8 * c) = o; }
    LDS_WAIT(); asm volatile("" ::: "memory");
}

__device__ __forceinline__ void p0_filter(const Args& a, unsigned char* lds) {
    float* zb = (float*)lds;
    float* h1 = zb + 16 * 33;
    float* h2 = h1 + 16 * 64;
    const int tid = threadIdx.x;
    float* Kraw = (float*)(a.ws + WS_KRAW); float* SSQ = (float*)(a.ws + WS_SSQ);
    const float* w1 = a.in[I_FW1]; const float* b1 = a.in[I_FB1]; const float* w2 = a.in[I_FW2]; const float* b2 = a.in[I_FB2];
    const float* w3 = a.in[I_FW3]; const float* b3 = a.in[I_FB3]; const float* fr = a.in[I_FFREQ]; const float* wo = a.in[I_FWOUT];
    for (int pg = blockIdx.x; pg < 256; pg += gridDim.x) {
        const int p0 = pg * 16;
        for (int i = tid; i < 16 * 33; i += NTHR) { const int pp = i / 33, j = i % 33; const int p = p0 + pp; float val;
            if (j == 0) val = (float)p * (1.0f / 4095.0f);
            else { const int bi = (j - 1) & 15; const float f = 1e-4f + (float)bi * ((15.0f - 1e-4f) / 15.0f); const float w = 6.283185307179586f * (float)p / 4096.0f; const float ang = w * f;
                   val = (j <= 16) ? cosf(ang) : -sinf(ang); }
            zb[i] = val; }
        __syncthreads();
        for (int i = tid; i < 1024; i += NTHR) { const int pp = i >> 6, j = i & 63; float acc = b1[j];
            for (int k = 0; k < 33; ++k) acc += zb[pp * 33 + k] * w1[k * 64 + j];
            h1[i] = sinf(fr[j] * acc); }
        __syncthreads();
        for (int i = tid; i < 1024; i += NTHR) { const int pp = i >> 6, j = i & 63; float acc = b2[j];
            for (int k = 0; k < 64; ++k) acc += h1[pp * 64 + k] * w2[k * 64 + j];
            h2[i] = sinf(fr[j] * acc); }
        __syncthreads();
        for (int i = tid; i < 1024; i += NTHR) { const int pp = i >> 6, j = i & 63; float acc = b3[j];
            for (int k = 0; k < 64; ++k) acc += h2[pp * 64 + k] * w3[k * 64 + j];
            h1[i] = sinf(fr[j] * acc); }
        __syncthreads();
        for (int dir = 0; dir < 2; ++dir) { const int c = tid, o = dir * 512 + c; float acc[16];
#pragma unroll
            for (int pp = 0; pp < 16; ++pp) acc[pp] = 0.f;
            for (int j = 0; j < 64; ++j) { const float w = wo[j * 1024 + o];
#pragma unroll
                for (int pp = 0; pp < 16; ++pp) acc[pp] += h1[pp * 64 + j] * w; }
            const float delta = 3.0701134573253945f + (float)c * ((15.350567286626972f - 3.0701134573253945f) / 511.0f); float ssq = 0.f;
#pragma unroll
            for (int pp = 0; pp < 16; ++pp) { const int p = p0 + pp; const float tn = (float)p * (1.0f / 4095.0f); const float val = acc[pp] * expf(-tn * delta);
                if (dir == 0) { Kraw[(size_t)c * 8192 + 4096 + p] = val; ssq += val * val; }
                else if (p >= 1) { Kraw[(size_t)c * 8192 + 4096 - p] = val; ssq += val * val; } }
            SSQ[pg * 1024 + o] = ssq;
            if (pg == 0 && dir == 0) Kraw[(size_t)c * 8192] = 0.f; }
        __syncthreads();
    }
}

__device__ __forceinline__ void p0_mod(const Args& a, unsigned char* lds) {
    float* sc = (float*)lds;
    float* red = sc + 9 * 1024;
    const int tid = threadIdx.x;
    if ((int)blockIdx.x >= 192) return;
    for (int i = tid; i < 9 * 1024; i += NTHR) { const float v = (i < 8192) ? a.in[I_C][i] : a.in[I_CCTX][i - 8192]; sc[i] = siluf(v); }
    __syncthreads();
    const float* wa = a.in[I_WADA]; const float* ba = a.in[I_BADA]; float* mod = (float*)(a.ws + WS_MOD);
    for (int it = blockIdx.x; it < 192; it += gridDim.x) {
        const int col = tid & 31, ks = tid >> 5, c0 = it * 32; float acc[9];
#pragma unroll
        for (int r = 0; r < 9; ++r) acc[r] = 0.f;
#pragma unroll 4
        for (int k = ks * 64; k < ks * 64 + 64; ++k) { const float w = wa[(size_t)k * MODW + c0 + col];
#pragma unroll
            for (int r = 0; r < 9; ++r) acc[r] += sc[r * 1024 + k] * w; }
#pragma unroll
        for (int r = 0; r < 9; ++r) red[(ks * 9 + r) * 32 + col] = acc[r];
        __syncthreads();
        if (tid < 288) { const int r = tid >> 5, cc = tid & 31; float s = ba[c0 + cc];
            for (int k2 = 0; k2 < 16; ++k2) s += red[(k2 * 9 + r) * 32 + cc];
            mod[r * MODW + c0 + cc] = s; }
        __syncthreads();
    }
}

__device__ __forceinline__ void p0_prologue(const Args& a, unsigned char* lds) {
    const int tid = threadIdx.x, lane = tid & 63, wave = tid >> 6;
    p0_filter(a, lds);
    __syncthreads();
    p0_mod(a, lds);
    __syncthreads();
    { v4u* z = (v4u*)((bf16*)(a.ws + WS_WIN) + (size_t)NIN * DM); const int n16 = (NINP - NIN) * DM * 2 / 16;
      for (int i = blockIdx.x * NTHR + tid; i < n16; i += gridDim.x * NTHR) z[i] = (v4u){0u, 0u, 0u, 0u}; }
    float* scr = (float*)(lds + wave * 16384);
    const int gw = blockIdx.x * NWAVES + wave, NGW = gridDim.x * NWAVES;
    constexpr int I_IN = (DM / 64) * (NIN / 32), I_O = (DM / 64) * (DM / 32), I_1 = (DM / 64) * (FF / 32), I_2 = (FF / 64) * (DM / 32);
    constexpr int NITEMS = I_IN + I_O + I_1 + I_2;
    for (int it = gw; it < NITEMS; it += NGW) {
        int r = it;
        if (r < I_IN) { p0_transpose_item(a.in[I_WIN], DM, NIN, (bf16*)(a.ws + WS_WIN), 0, scr, r, lane); continue; } r -= I_IN;
        if (r < I_O) { p0_transpose_item(a.in[I_WOUT], DM, DM, (bf16*)(a.ws + WS_WOUT), 0, scr, r, lane); continue; } r -= I_O;
        if (r < I_1) { p0_transpose_item(a.in[I_WM1], DM, FF, (bf16*)(a.ws + WS_W1), 0, scr, r, lane); continue; } r -= I_1;
        p0_transpose_item(a.in[I_WM2], FF, DM, (bf16*)(a.ws + WS_W2), 0, scr, r, lane);
    }
}

__device__ __forceinline__ void norm_mod_rows(const Args& a, const float* src_lat, const float* src_ctx, int nrows, const float* g, int sc_off, int sh_off, bf16* dst) {
    const int tid = threadIdx.x, lane = tid & 63, wave = tid >> 6;
    const int gw = blockIdx.x * NWAVES + wave, NGW = gridDim.x * NWAVES;
    const float* mod = (const float*)(a.ws + WS_MOD);
    for (int row = gw; row < nrows; row += NGW) {
        const float* src = row < MLAT ? src_lat + (size_t)row * DM : src_ctx + (size_t)(row - MLAT) * DM;
        const int mrow = row < MLAT ? row / SEQ : 8;
        const f32x4* xr = (const f32x4*)src + lane;
        f32x4 v[4]; float s = 0.f;
#pragma unroll
        for (int j = 0; j < 4; ++j) { v[j] = xr[64 * j]; s += (v[j].x * v[j].x + v[j].y * v[j].y) + (v[j].z * v[j].z + v[j].w * v[j].w); }
        const float rstd = rsqrtf(wave_sum(s) * (1.f / DM) + EPSF);
        unsigned long long* o8 = (unsigned long long*)(dst + (size_t)row * DM) + lane;
#pragma unroll
        for (int j = 0; j < 4; ++j) { const int col = 256 * j + 4 * lane;
            const f32x4 gg = *(const f32x4*)(g + col), scv = *(const f32x4*)(mod + mrow * MODW + sc_off + col), shv = *(const f32x4*)(mod + mrow * MODW + sh_off + col);
            const f32x4 y = (v[j] * rstd * gg) * (scv + 1.f) + shv;
            o8[64 * j] = (unsigned long long)pk2(y.x, y.y) | ((unsigned long long)pk2(y.z, y.w) << 32); }
    }
}
__device__ __forceinline__ void final_norm_rows(const Args& a) {
    const int tid = threadIdx.x, lane = tid & 63, wave = tid >> 6;
    const int gw = blockIdx.x * NWAVES + wave, NGW = gridDim.x * NWAVES;
    const float* g = a.in[I_NFIN];
    for (int row = gw; row < MLAT; row += NGW) {
        f32x4* xr = (f32x4*)(a.out + (size_t)row * DM) + lane;
        f32x4 v[4]; float s = 0.f;
#pragma unroll
        for (int j = 0; j < 4; ++j) { v[j] = xr[64 * j]; s += (v[j].x * v[j].x + v[j].y * v[j].y) + (v[j].z * v[j].z + v[j].w * v[j].w); }
        const float rstd = rsqrtf(wave_sum(s) * (1.f / DM) + EPSF);
#pragma unroll
        for (int j = 0; j < 4; ++j) { const f32x4 gg = *(const f32x4*)(g + 256 * j + 4 * lane); xr[64 * j] = v[j] * rstd * gg; }
    }
}

constexpr int L_GR = 0, L_WG = 1024, L_BG = 2048, L_TOT = 2112, L_BC = 2176, L_KE = L_BC + 4096, L_KI = L_KE + 64 * 65, L_ATT = L_KI + 64 * 65, L_V = L_ATT + 64 * 65, L_S = L_V + 64 * 128, L_END = L_S + 128 * 65;
static_assert(L_END * 4 <= LDS_BYTES, "GLA LDS map");

__device__ __forceinline__ void gla_gate_cumsum(const Args& a, float* L, const bf16* gp, size_t row0, int h, int dir) {
    const int tid = threadIdx.x;
    const float* gkw = a.in[dir ? I_GKWB : I_GKWF]; const float* gkb = a.in[dir ? I_GKBB : I_GKBF];
    for (int i = tid; i < 1024; i += NTHR) { const int tok = i >> 4, r = i & 15; L[L_GR + i] = bf2f(gp[(row0 + tok) * NGL + GGF + dir * 16 + r]); }
    for (int i = tid; i < 1024; i += NTHR) { const int r = i >> 6, d = i & 63; L[L_WG + i] = gkw[r * 256 + h * 64 + d]; }
    if (tid < 64) L[L_BG + tid] = gkb[h * 64 + tid];
    __syncthreads();
    for (int i = tid; i < 4096; i += NTHR) { const int tok = i >> 6, d = i & 63; float acc = L[L_BG + d];
#pragma unroll
        for (int r = 0; r < 16; ++r) acc += L[L_GR + tok * 16 + r] * L[L_WG + r * 64 + d];
        L[L_BC + i] = logsigmoidf(acc) * (1.0f / 16.0f); }
    __syncthreads();
    if (tid < 64) { float run = 0.f;
        if (dir == 0) { for (int tok = 0; tok < 64; ++tok) { run += L[L_BC + tok * 64 + tid]; L[L_BC + tok * 64 + tid] = run; } }
        else { for (int tok = 63; tok >= 0; --tok) { run += L[L_BC + tok * 64 + tid]; L[L_BC + tok * 64 + tid] = run; } }
        L[L_TOT + tid] = run; }
    __syncthreads();
}

__device__ __forceinline__ size_t gla_chunk_row0(int b, int dir, int sig) {
    if (sig < 4) { const int cc = dir == 0 ? sig : 3 - sig; return (size_t)MLAT + b * CTXL + cc * 64; }
    const int n = dir == 0 ? sig - 4 : 67 - sig; return (size_t)b * SEQ + n * 64;
}

__device__ __forceinline__ void gla_local(const Args& a, unsigned char* lds) {
    float* L = (float*)lds; const int tid = threadIdx.x;
    const bf16* gp = (const bf16*)(a.ws + WS_GPROJ); bf16* ST = (bf16*)(a.ws + WS_XN); float* DEC = (float*)(a.ws + WS_DEC);
    for (int item = blockIdx.x; item < NITEM; item += gridDim.x) {
        const int sig = item % NSIG, chain = item / NSIG, dir = chain & 1, h = (chain >> 1) & 3, b = chain >> 3;
        const size_t row0 = gla_chunk_row0(b, dir, sig);
        gla_gate_cumsum(a, L, gp, row0, h, dir);
        for (int i = tid; i < 4096; i += NTHR) { const int tok = i >> 6, d = i & 63;
            L[L_KE + tok * 65 + d] = bf2f(gp[(row0 + tok) * NGL + GK + h * 64 + d]) * __expf(L[L_TOT + d] - L[L_BC + i]); }
        for (int i = tid; i < 8192; i += NTHR) { const int tok = i >> 7, e = i & 127; L[L_V + i] = bf2f(gp[(row0 + tok) * NGL + GV + h * 128 + e]); }
        __syncthreads();
        { const int d = tid & 63, e0 = (tid >> 6) * 16; float acc[16];
#pragma unroll
          for (int i = 0; i < 16; ++i) acc[i] = 0.f;
          for (int tok = 0; tok < 64; ++tok) { const float ke = L[L_KE + tok * 65 + d];
#pragma unroll
              for (int i = 0; i < 16; ++i) acc[i] += L[L_V + tok * 128 + e0 + i] * ke; }
#pragma unroll
          for (int i = 0; i < 16; ++i) ST[(size_t)item * 8192 + (e0 + i) * 64 + d] = (bf16)f2bf(acc[i]);
          if (tid < 64) DEC[item * 64 + tid] = __expf(L[L_TOT + tid]); }
        __syncthreads();
    }
}

__device__ __forceinline__ void gla_scan(const Args& a) {
    bf16* ST = (bf16*)(a.ws + WS_XN); const float* DEC = (const float*)(a.ws + WS_DEC);
    for (int w = blockIdx.x * NTHR + threadIdx.x; w < 64 * 1024; w += gridDim.x * NTHR) {
        const int chain = w >> 10, el = (w & 1023) * 8, d0 = el & 63; float s[8];
#pragma unroll
        for (int i = 0; i < 8; ++i) s[i] = 0.f;
#pragma unroll 4
        for (int sig = 0; sig < NSIG; ++sig) { const size_t item = (size_t)chain * NSIG + sig;
            v4u* p = (v4u*)(ST + item * 8192 + el); const v4u dsv = *p;
            const f32x4 d0v = *(const f32x4*)(DEC + item * 64 + d0), d1v = *(const f32x4*)(DEC + item * 64 + d0 + 4);
            v4u o; o.x = pk2(s[0], s[1]); o.y = pk2(s[2], s[3]); o.z = pk2(s[4], s[5]); o.w = pk2(s[6], s[7]); *p = o;
            s[0] = d0v.x * s[0] + bf2f(dsv.x & 0xffffu); s[1] = d0v.y * s[1] + bf2f(dsv.x >> 16);
            s[2] = d0v.z * s[2] + bf2f(dsv.y & 0xffffu); s[3] = d0v.w * s[3] + bf2f(dsv.y >> 16);
            s[4] = d1v.x * s[4] + bf2f(dsv.z & 0xffffu); s[5] = d1v.y * s[5] + bf2f(dsv.z >> 16);
            s[6] = d1v.z * s[6] + bf2f(dsv.w & 0xffffu); s[7] = d1v.w * s[7] + bf2f(dsv.w >> 16); }
    }
}

__device__ __forceinline__ void gla_out(const Args& a, unsigned char* lds) {
    float* L = (float*)lds; const int tid = threadIdx.x, lane = tid & 63, wave = tid >> 6;
    const bf16* gp = (const bf16*)(a.ws + WS_GPROJ); const bf16* ST = (const bf16*)(a.ws + WS_XN); bf16* ycat = (bf16*)(a.ws + WS_YCAT);
    const float* gn = a.in[I_GLAN];
    for (int it = blockIdx.x; it < NB * 4 * 64; it += gridDim.x) {
        const int n = it & 63, h = (it >> 6) & 3, b = it >> 8; const size_t row0 = (size_t)b * SEQ + n * 64;
        const int e = tid & 127, c0 = (tid >> 7) * 16; float o[16];
#pragma unroll
        for (int i = 0; i < 16; ++i) o[i] = 0.f;
        for (int dir = 0; dir < 2; ++dir) {
            gla_gate_cumsum(a, L, gp, row0, h, dir);
            const int sig = dir == 0 ? n + 4 : 67 - n; const size_t item = (size_t)((b * 4 + h) * 2 + dir) * NSIG + sig;
            for (int i = tid; i < 4096; i += NTHR) { const int tok = i >> 6, d = i & 63; const float bc = L[L_BC + i];
                L[L_KE + tok * 65 + d] = bf2f(gp[(row0 + tok) * NGL + GQ + h * 64 + d]) * 0.125f * __expf(bc);
                L[L_KI + tok * 65 + d] = bf2f(gp[(row0 + tok) * NGL + GK + h * 64 + d]) * __expf(-bc); }
            if (dir == 0) for (int i = tid; i < 8192; i += NTHR) { const int tok = i >> 7, ee = i & 127; L[L_V + i] = bf2f(gp[(row0 + tok) * NGL + GV + h * 128 + ee]); }
            for (int i = tid; i < 8192; i += NTHR) { const int ee = i >> 6, d = i & 63; L[L_S + ee * 65 + d] = bf2f(ST[item * 8192 + i]); }
            __syncthreads();
            { const int s = tid & 63, ca = (tid >> 6) * 8; float acc[8];
#pragma unroll
              for (int i = 0; i < 8; ++i) acc[i] = 0.f;
              for (int d = 0; d < 64; ++d) { const float ki = L[L_KI + s * 65 + d];
#pragma unroll
                  for (int i = 0; i < 8; ++i) acc[i] += L[L_KE + (ca + i) * 65 + d] * ki; }
#pragma unroll
              for (int i = 0; i < 8; ++i) { const int c = ca + i; const bool keep = dir == 0 ? (s <= c) : (s >= c); L[L_ATT + c * 65 + s] = keep ? acc[i] : 0.f; } }
            __syncthreads();
            for (int s = 0; s < 64; ++s) { const float vv = L[L_V + s * 128 + e];
#pragma unroll
                for (int i = 0; i < 16; ++i) o[i] += L[L_ATT + (c0 + i) * 65 + s] * vv; }
            for (int d = 0; d < 64; ++d) { const float sv = L[L_S + e * 65 + d];
#pragma unroll
                for (int i = 0; i < 16; ++i) o[i] += L[L_KE + (c0 + i) * 65 + d] * sv; }
            __syncthreads();
        }
        float* OB = L + L_KE;
#pragma unroll
        for (int i = 0; i < 16; ++i) OB[(c0 + i) * 128 + e] = o[i];
        __syncthreads();
        for (int j = 0; j < 8; ++j) { const int c = wave * 8 + j; const float v0 = OB[c * 128 + lane], v1 = OB[c * 128 + 64 + lane];
            const float rstd = rsqrtf(wave_sum(v0 * v0 + v1 * v1) * (1.f / 128.f) + EPSF);
            const size_t row = row0 + c;
            const float g0 = bf2f(gp[row * NGL + GOG + h * 128 + lane]), g1 = bf2f(gp[row * NGL + GOG + h * 128 + 64 + lane]);
            ycat[row * DM + DH + h * 128 + lane] = (bf16)f2bf(v0 * rstd * gn[lane] * siluf(g0));
            ycat[row * DM + DH + h * 128 + 64 + lane] = (bf16)f2bf(v1 * rstd * gn[64 + lane] * siluf(g1)); }
        __syncthreads();
    }
}

__device__ __forceinline__ float hy_sconv(const bf16* hyT, int ch, int col, float w0, float w1, float w2, float cb) {
    const int tt = col & 63; const bf16* p = hyT + (size_t)ch * MLAT + col;
    const float h0 = bf2f(p[0]), hm = tt > 0 ? bf2f(p[-1]) : 0.f, hp = tt < 63 ? bf2f(p[1]) : 0.f;
    return cb + w0 * hm + w1 * h0 + w2 * hp;
}
__device__ __forceinline__ void hyena_conv(const Args& a, unsigned char* lds) {
    float* KL = (float*)lds;
    bf16* Z = (bf16*)(lds + 32768);
    float* RED = (float*)(lds + 32768 + 65536);
    const int tid = threadIdx.x, lane = tid & 63, wave = tid >> 6;
    const bf16* hyT = (const bf16*)(a.ws + WS_HYT); bf16* yT = (bf16*)(a.ws + WS_YT);
    const float* Kraw = (const float*)(a.ws + WS_KRAW); const float* SSQ = (const float*)(a.ws + WS_SSQ);
    const float* cw = a.in[I_CONVW]; const float* cbv = a.in[I_CONVB];
    for (int c = blockIdx.x; c < DH; c += gridDim.x) {
        { const float part = SSQ[(tid >> 1) * 1024 + (tid & 1) * 512 + c]; const float ws = wave_sum(part); if (lane == 0) RED[wave] = ws; }
        __syncthreads();
        float tot = 0.f;
#pragma unroll
        for (int i = 0; i < 8; ++i) tot += RED[i];
        const float sc = rsqrtf(tot + EPSF);
        for (int i = tid; i < 8192; i += NTHR) KL[i] = Kraw[(size_t)c * 8192 + i] * sc;
        { const int c1 = DH + c, c2 = 2 * DH + c;
          const float a0 = cw[c1], a1 = cw[NHY + c1], a2 = cw[2 * NHY + c1], ab = cbv[c1], b0 = cw[c2], b1 = cw[NHY + c2], b2 = cw[2 * NHY + c2], bb = cbv[c2];
          for (int i = tid; i < MLAT; i += NTHR) Z[i] = (bf16)f2bf(hy_sconv(hyT, c1, i, a0, a1, a2, ab) * hy_sconv(hyT, c2, i, b0, b1, b2, bb)); }
        __syncthreads();
        float acc[8][8];
#pragma unroll
        for (int j = 0; j < 8; ++j)
#pragma unroll
            for (int b = 0; b < 8; ++b) acc[j][b] = 0.f;
        const unsigned* Z2 = (const unsigned*)Z;
        for (int s2 = 0; s2 < 2048; ++s2) { float zl[8], zh[8];
#pragma unroll
            for (int b = 0; b < 8; ++b) { const unsigned zz = Z2[b * 2048 + s2]; zl[b] = bf2f(zz & 0xffffu); zh[b] = bf2f(zz >> 16); }
#pragma unroll
            for (int j = 0; j < 8; ++j) { const int base = tid + 512 * j - 2 * s2 + 4096; const float k0 = KL[base], k1 = KL[base - 1];
#pragma unroll
                for (int b = 0; b < 8; ++b) acc[j][b] += k0 * zl[b] + k1 * zh[b]; } }
        { const float w0 = cw[c], w1 = cw[NHY + c], w2 = cw[2 * NHY + c], wb = cbv[c], hb = a.in[I_HBIAS][c];
#pragma unroll
          for (int j = 0; j < 8; ++j)
#pragma unroll
              for (int b = 0; b < 8; ++b) { const int col = b * SEQ + tid + 512 * j; const float x0 = hy_sconv(hyT, c, col, w0, w1, w2, wb);
                  yT[(size_t)c * MLAT + col] = (bf16)f2bf(x0 * (acc[j][b] + hb * bf2f(Z[col]))); } }
        __syncthreads();
    }
}
__device__ __forceinline__ void hyena_transpose(const Args& a, unsigned char* lds) {
    const int tid = threadIdx.x, lane = tid & 63, wave = tid >> 6;
    bf16* scr = (bf16*)(lds + wave * 16384);
    const bf16* yT = (const bf16*)(a.ws + WS_YT); bf16* ycat = (bf16*)(a.ws + WS_YCAT);
    const int gw = blockIdx.x * NWAVES + wave, NGW = gridDim.x * NWAVES;
    for (int t = gw; t < (DH / 64) * (MLAT / 64); t += NGW) { const int cb = t & 7, tb = t >> 3, c0 = cb * 64, k0 = tb * 64;
        for (int r = 0; r < 64; ++r) scr[r * 66 + lane] = yT[(size_t)(c0 + r) * MLAT + k0 + lane];
        LDS_WAIT(); asm volatile("" ::: "memory");
        for (int r = 0; r < 64; ++r) ycat[(size_t)(k0 + r) * DM + c0 + lane] = scr[lane * 66 + r];
        LDS_WAIT(); asm volatile("" ::: "memory"); }
}

constexpr int NPHASE = 11;
__global__ void __launch_bounds__(NTHR, 2) fwd_kernel(Args a) {
    extern __shared__ __attribute__((aligned(16))) unsigned char lds[];
    cg::grid_group grid = cg::this_grid();
    const int lo = a.ph_lo, hi = a.ph_hi;
#define IN(k) (lo <= (k) && (k) < hi)
#define SEAM(k) do { if (IN(k) && IN((k) + 1)) grid.sync(); } while (0)
    unsigned char* ws = a.ws;
    PG8_LAS unsigned char* ldsg = (PG8_LAS unsigned char*)lds;
    if (IN(0)) { p0_prologue(a, lds); } SEAM(0);
    if (IN(1)) { norm_mod_rows(a, a.in[I_X], a.in[I_CTX], MALL, a.in[I_NMIX], MOD_SC1, MOD_SH1, (bf16*)(ws + WS_XN)); } SEAM(1);
    if (IN(2)) {
        { pg8::Gemm g{(const pg8::bf16_t*)(ws + WS_WIN), (const pg8::bf16_t*)(ws + WS_XN), NHY, MLAT, DM}; pg8::StaticOrder S; S.init(NHY, MLAT, gridDim.x, blockIdx.x);
          pg8::EpiBf16<0> E{(pg8::bf16_t*)(ws + WS_HYT), MLAT};
          pg8::gemm_phase<pg8::EpiBf16<0>, pg8::StaticOrder, true, true>(ldsg, g, S, E); }
        __syncthreads();
        { pg8::Gemm g{(const pg8::bf16_t*)(ws + WS_XN), (const pg8::bf16_t*)(ws + WS_WIN) + (size_t)NHY * DM, MALL, NGL, DM}; pg8::StaticOrder S; S.init(MALL, NGL, gridDim.x, blockIdx.x);
          pg8::EpiBf16<0> E{(pg8::bf16_t*)(ws + WS_GPROJ), NGL};
          pg8::gemm_phase<pg8::EpiBf16<0>, pg8::StaticOrder, true, true>(ldsg, g, S, E); }
    } SEAM(2);
    if (IN(3)) { gla_local(a, lds); __syncthreads(); hyena_conv(a, lds); } SEAM(3);
    if (IN(4)) { gla_scan(a); } SEAM(4);
    if (IN(5)) { gla_out(a, lds); __syncthreads(); hyena_transpose(a, lds); } SEAM(5);
    if (IN(6)) { pg8::Gemm g{(const pg8::bf16_t*)(ws + WS_YCAT), (const pg8::bf16_t*)(ws + WS_WOUT), MLAT, DM, DM}; pg8::StaticOrder S; S.init(MLAT, DM, gridDim.x, blockIdx.x);
        pg8::EpiResid E{a.in[I_X], a.out, DM, (const float*)(ws + WS_MOD) + MOD_G1, SEQ, MODW};
        pg8::gemm_phase<pg8::EpiResid, pg8::StaticOrder, true, true>(ldsg, g, S, E); } SEAM(6);
    if (IN(7)) { norm_mod_rows(a, a.out, a.out, MLAT, a.in[I_NMLP], MOD_SC2, MOD_SH2, (bf16*)(ws + WS_XN)); } SEAM(7);
    if (IN(8)) { pg8::Gemm g{(const pg8::bf16_t*)(ws + WS_XN), (const pg8::bf16_t*)(ws + WS_W1), MLAT, FF, DM}; pg8::StaticOrder S; S.init(MLAT, FF, gridDim.x, blockIdx.x);
        pg8::EpiBf16<1> E{(pg8::bf16_t*)(ws + WS_HID), FF};
        pg8::gemm_phase<pg8::EpiBf16<1>, pg8::StaticOrder, true, true>(ldsg, g, S, E); } SEAM(8);
    if (IN(9)) { pg8::Gemm g{(const pg8::bf16_t*)(ws + WS_HID), (const pg8::bf16_t*)(ws + WS_W2), MLAT, DM, FF}; pg8::StaticOrder S; S.init(MLAT, DM, gridDim.x, blockIdx.x);
        pg8::EpiResid E{a.out, a.out, DM, (const float*)(ws + WS_MOD) + MOD_G2, SEQ, MODW};
        pg8::gemm_phase<pg8::EpiResid, pg8::StaticOrder, true, true>(ldsg, g, S, E); } SEAM(9);
    if (IN(10)) { final_norm_rows(a); }
#undef IN
#undef SEAM
}

#ifndef N_LAUNCH_MODE
#define N_LAUNCH_MODE 0
#endif
extern "C" void kernel_launch(void* const* d_in, const int* in_sizes, int n_in, void* d_out, int out_size, void* d_ws, size_t ws_size, hipStream_t stream) {
    static int grid = 0;
    if (grid == 0) {
        if (n_in != 29 || out_size != MLAT * DM || ws_size < WS_END) { fprintf(stderr, "kernel_launch: unexpected shapes (n_in %d out %d ws %zu)\n", n_in, out_size, ws_size); grid = -1; return; }
        int dev = 0, cus = 0, per_cu = 0;
        if (hipGetDevice(&dev) != hipSuccess || hipDeviceGetAttribute(&cus, hipDeviceAttributeMultiprocessorCount, dev) != hipSuccess) { grid = -1; return; }
        if (hipFuncSetAttribute((const void*)fwd_kernel, hipFuncAttributeMaxDynamicSharedMemorySize, LDS_BYTES) != hipSuccess) { fprintf(stderr, "kernel_launch: hipFuncSetAttribute failed\n"); grid = -1; return; }
        if (hipOccupancyMaxActiveBlocksPerMultiprocessor(&per_cu, (const void*)fwd_kernel, NTHR, LDS_BYTES) != hipSuccess || per_cu < 1) { fprintf(stderr, "kernel_launch: occupancy query says %d blocks per CU\n", per_cu); (void)hipGetLastError(); grid = -1; return; }
        grid = cus;
    }
    if (grid < 0) return;
    Args a{};
    for (int i = 0; i < 29; ++i) a.in[i] = (const float*)d_in[i];
    a.out = (float*)d_out; a.ws = (unsigned char*)d_ws;
#if N_LAUNCH_MODE == 0
    for (int p = 0; p < NPHASE; ++p) { a.ph_lo = p; a.ph_hi = p + 1; hipLaunchKernelGGL(fwd_kernel, dim3(grid), dim3(NTHR), LDS_BYTES, stream, a); }
#else
    a.ph_lo = 0; a.ph_hi = NPHASE;
    void* args[] = {&a};
    hipError_t e = hipLaunchCooperativeKernel((const void*)fwd_kernel, dim3(grid), dim3(NTHR), args, LDS_BYTES, stream);
    if (e != hipSuccess) fprintf(stderr, "cooperative launch failed: %s (grid %d)\n", hipGetErrorString(e), grid);
#endif
}
```

```cpp
#include <hip/hip_runtime.h>
#include <hip/hip_cooperative_groups.h>
#include <cstdio>
#include <cstdint>
#include <cmath>
namespace cg = cooperative_groups;
namespace pg8 {
#define PG8_LAS __attribute__((address_space(3)))
typedef unsigned short bf16_t;
typedef short bf16x8 __attribute__((ext_vector_type(8)));
typedef float f32x4 __attribute__((ext_vector_type(4)));
typedef unsigned u32x4 __attribute__((ext_vector_type(4)));
constexpr int BM = 256, BK = 64, HALF = 128, HTB = HALF * BK * 2  , STAGE_BYTES = 8 * HTB, NXCD = 8, WGM = 8;

__host__ __device__ __forceinline__ int lds_byte(int r, int c) { const int st = (r >> 4) * 2 + (c >> 5), rr = r & 15, cc = c & 31, ob = rr * 64 + cc * 2; return st * 1024 + (ob ^ (((ob >> 9) & 1) << 5)); }
__host__ __device__ __forceinline__ void stage_rc(int b, int& R, int& C) { const int st = b / 1024, sb = b % 1024, swz = sb ^ (((sb >> 9) & 1) << 5); R = (st >> 1) * 16 + swz / 64; C = (st & 1) * 32 + (swz % 64) / 2; }
__host__ __device__ __forceinline__ int perm32(int rho) { const int n = rho >> 4, i = rho & 15; return 8 * (i >> 2) + 4 * n + (i & 3); }

struct Unit { int pm, pn; };
struct Gemm { const bf16_t* A; const bf16_t* Bt; int M, N, K; };

struct StaticOrder {
    int nM, nN, nwg, G, c;
    __host__ __device__ void init(int M, int N, int G_, int c_) { nM = M / BM; nN = N / BM; nwg = nM * nN; G = G_; c = c_; }
    __host__ __device__ bool next(int i, Unit& u) const {
        const long L = (long)i * G + c; if (L >= nwg) return false;
        int wgid = (int)L; { const int q = nwg / NXCD, r = nwg % NXCD, xcd = wgid % NXCD, off = wgid / NXCD; wgid = (xcd < r ? xcd * (q + 1) : r * (q + 1) + (xcd - r) * q) + off; }
        const int nig = WGM * nN, gid = wgid / nig, fm = gid * WGM, gsz = (nM - fm) < WGM ? (nM - fm) : WGM;
        u.pm = fm + ((wgid % nig) % gsz); u.pn = (wgid % nig) / gsz; return true;
    }
    __device__ __forceinline__ void a_ready(const Unit&) const {}
    __device__ __forceinline__ void done(const Unit&) const {}
};


__device__ __forceinline__ unsigned cvt_pk_bf16(float lo, float hi) { unsigned r; asm volatile("v_cvt_pk_bf16_f32 %0, %1, %2" : "=v"(r) : "v"(lo), "v"(hi)); return r; }

template <int ACT> struct EpiBf16 {
    static constexpr bool PERM = true, AFTER_DRAIN = false;
    bf16_t* O; int ldc;
    __device__ __forceinline__ void operator()(const f32x4 (&acc)[2][2][4][2], const Unit& u, int wr, int wc, int fr, int fq) const {
        const int row0 = u.pm * BM + wr * 64 + fr; const int col0 = u.pn * BM + wc * 32 + 8 * fq;
#pragma unroll
        for (int ai = 0; ai < 2; ++ai)
#pragma unroll
            for (int m = 0; m < 4; ++m) { bf16_t* rowp = O + (size_t)(row0 + ai * HALF + m * 16) * ldc + col0;
#pragma unroll
                for (int bj = 0; bj < 2; ++bj) { f32x4 v0 = acc[ai][bj][m][0], v1 = acc[ai][bj][m][1];
                    if (ACT == 1) {
#pragma unroll
                        for (int q = 0; q < 4; ++q) { const float a0 = fmaxf(v0[q], 0.f), a1 = fmaxf(v1[q], 0.f); v0[q] = a0 * a0; v1[q] = a1 * a1; } }
                    u32x4 w; w.x = cvt_pk_bf16(v0[0], v0[1]); w.y = cvt_pk_bf16(v0[2], v0[3]); w.z = cvt_pk_bf16(v1[0], v1[1]); w.w = cvt_pk_bf16(v1[2], v1[3]);
                    *(u32x4*)(rowp + bj * HALF) = w; } }
    }
};
struct EpiResid {
    static constexpr bool PERM = false, AFTER_DRAIN = false;
    const float* base; float* out; int ldc; const float* gate; int rows_per_gate; int gate_stride;
    __device__ __forceinline__ void operator()(const f32x4 (&acc)[2][2][4][2], const Unit& u, int wr, int wc, int fr, int fq) const {
        const int row0 = u.pm * BM + wr * 64 + fr, col0 = u.pn * BM + wc * 32 + 4 * fq;
        const float* gp = gate + (size_t)((u.pm * BM) / rows_per_gate) * gate_stride + col0;
        f32x4 gv[2][2];
#pragma unroll
        for (int bj = 0; bj < 2; ++bj)
#pragma unroll
            for (int n = 0; n < 2; ++n) gv[bj][n] = *(const f32x4*)(gp + bj * HALF + n * 16);
#pragma unroll
        for (int ai = 0; ai < 2; ++ai)
#pragma unroll
            for (int m = 0; m < 4; ++m) { const size_t off = (size_t)(row0 + ai * HALF + m * 16) * ldc + col0;
#pragma unroll
                for (int bj = 0; bj < 2; ++bj)
#pragma unroll
                    for (int n = 0; n < 2; ++n) { const f32x4 bs = *(const f32x4*)(base + off + bj * HALF + n * 16);
                        *(f32x4*)(out + off + bj * HALF + n * 16) = bs + gv[bj][n] * acc[ai][bj][m][n]; } }
    }
};

template <class Epi, class Sched, bool ALIGN_EPI = false, bool SP2 = false>
__device__ __forceinline__ void gemm_phase(PG8_LAS unsigned char* lds, const Gemm g, const Sched& S, const Epi& E) {
    const int tid = threadIdx.x, wid = __builtin_amdgcn_readfirstlane(tid >> 6), lane = tid & 63, wr = wid >> 2, wc = wid & 3, fr = lane & 15, fq = lane >> 4;
    const int K = g.K, nt = K / BK;
    unsigned voffA[2], voffB[2];
#pragma unroll
    for (int i = 0; i < 2; ++i) { int R, C; stage_rc(tid * 16 + i * 8192, R, C); const int Rb = Epi::PERM ? ((R & ~31) + perm32(R & 31)) : R;
        voffA[i] = (unsigned)(R * K + C) * 2u; voffB[i] = (unsigned)(Rb * K + C) * 2u; }
    const size_t kstep = (size_t)(BK * 2);
    const size_t hstep = (size_t)HALF * K * 2;
    const size_t tstep = 2 * hstep;
    const unsigned ldsw = (unsigned)wid * 1024u;
    const int aoff = lds_byte(wr * 64 + fr, fq * 8), boff = lds_byte(wc * 32 + fr, fq * 8);
#define PG8_SA(b, h) (((b) * 2 + (h)) * HTB)
#define PG8_SB(b, h) ((4 + (b) * 2 + (h)) * HTB)
#define PG8_STAGE(bufoff, gbase, voff) do { _Pragma("unroll") for (int _i = 0; _i < 2; ++_i) \
        __builtin_amdgcn_global_load_lds((const unsigned*)((const char*)(gbase) + (voff)[_i]), (PG8_LAS unsigned*)(lds + (bufoff) + ldsw + _i * 8192), 16, 0, 0); } while (0)
#define PG8_LDA(dst, b, h) do { _Pragma("unroll") for (int m = 0; m < 4; ++m) _Pragma("unroll") for (int k = 0; k < 2; ++k) dst[m][k] = *(const PG8_LAS bf16x8*)(lds + PG8_SA(b, h) + aoff + m * 2048 + k * 1024); } while (0)
#define PG8_LDB(dst, b, h) do { _Pragma("unroll") for (int n = 0; n < 2; ++n) _Pragma("unroll") for (int k = 0; k < 2; ++k) dst[n][k] = *(const PG8_LAS bf16x8*)(lds + PG8_SB(b, h) + boff + n * 2048 + k * 1024); } while (0)
#define PG8_MMA(ai, bj, At, Bt) do { __builtin_amdgcn_s_setprio(1); _Pragma("unroll") for (int m = 0; m < 4; ++m) _Pragma("unroll") for (int n = 0; n < 2; ++n) _Pragma("unroll") for (int k = 0; k < 2; ++k) \
        acc[ai][bj][m][n] = __builtin_amdgcn_mfma_f32_16x16x32_bf16(Bt[n][k], At[m][k], acc[ai][bj][m][n], 0, 0, 0); __builtin_amdgcn_s_setprio(0); } while (0)
#define PG8_WAIT_V(n) asm volatile("s_waitcnt vmcnt(" #n ")" ::: "memory")
#define PG8_WAIT_L(n) asm volatile("s_waitcnt lgkmcnt(" #n ")" ::: "memory")
#define PG8_BAR __builtin_amdgcn_s_barrier()
#define PG8_SCHED __builtin_amdgcn_sched_barrier(0)
    Unit cur, nxt; int ui = 0;
    if (!S.next(0, cur)) return;
    f32x4 acc[2][2][4][2];
#pragma unroll
    for (int a = 0; a < 2; ++a)
#pragma unroll
        for (int b = 0; b < 2; ++b)
#pragma unroll
            for (int m = 0; m < 4; ++m)
#pragma unroll
                for (int n = 0; n < 2; ++n) acc[a][b][m][n] = (f32x4){0.f, 0.f, 0.f, 0.f};
    bf16x8 At[4][2], B0[2][2], B1[2][2];
    const char* cA = (const char*)g.A + (size_t)cur.pm * tstep; const char* cB = (const char*)g.Bt + (size_t)cur.pn * tstep;
    S.a_ready(cur);
    if constexpr (SP2) {
        PG8_STAGE(PG8_SB(0, 0), cB, voffB); PG8_STAGE(PG8_SB(0, 1), cB + hstep, voffB); PG8_STAGE(PG8_SA(0, 0), cA, voffA); PG8_STAGE(PG8_SA(0, 1), cA + hstep, voffA);
        if (wr == 1) PG8_BAR;
        PG8_WAIT_V(2); PG8_BAR;
        PG8_STAGE(PG8_SB(1, 0), cB + kstep, voffB); PG8_STAGE(PG8_SA(1, 0), cA + kstep, voffA); PG8_STAGE(PG8_SB(1, 1), cB + hstep + kstep, voffB);
        PG8_WAIT_V(6); PG8_BAR;
    } else {
        PG8_STAGE(PG8_SB(0, 0), cB, voffB); PG8_STAGE(PG8_SA(0, 0), cA, voffA); PG8_STAGE(PG8_SB(0, 1), cB + hstep, voffB); PG8_STAGE(PG8_SA(0, 1), cA + hstep, voffA);
        if (wr == 1) PG8_BAR;
        PG8_WAIT_V(4); PG8_BAR;
        PG8_STAGE(PG8_SB(1, 0), cB + kstep, voffB); PG8_STAGE(PG8_SA(1, 0), cA + kstep, voffA); PG8_STAGE(PG8_SB(1, 1), cB + hstep + kstep, voffB);
        PG8_WAIT_V(6); PG8_BAR;
    }
    for (;;) {
        const bool has_next = S.next(ui + 1, nxt);
        const char* nA = has_next ? (const char*)g.A + (size_t)nxt.pm * tstep : cA; const char* nB = has_next ? (const char*)g.Bt + (size_t)nxt.pn * tstep : cB;
        for (int t = 0; t < nt; t += 2) {
            const bool last = (t == nt - 2);
            const char* a1 = cA + (size_t)(t + 1) * kstep;
            const char* a2 = last ? nA : cA + (size_t)(t + 2) * kstep; const char* b2 = last ? nB : cB + (size_t)(t + 2) * kstep;
            const char* a3 = a2 + kstep; const char* b3 = b2 + kstep;
            if (last && has_next) S.a_ready(nxt);
            if constexpr (SP2) {
            PG8_LDB(B0, 0, 0); PG8_LDB(B1, 0, 1); PG8_SCHED; PG8_LDA(At, 0, 0); PG8_STAGE(PG8_SA(1, 1), a1 + hstep, voffA);
            PG8_WAIT_V(8); PG8_WAIT_L(0); PG8_BAR; PG8_MMA(0, 0, At, B0); PG8_MMA(0, 1, At, B1); PG8_BAR; PG8_SCHED;
            PG8_LDA(At, 0, 1); PG8_STAGE(PG8_SB(0, 0), b2, voffB); PG8_STAGE(PG8_SB(0, 1), b2 + hstep, voffB); PG8_STAGE(PG8_SA(0, 0), a2, voffA);
            PG8_WAIT_V(8); PG8_WAIT_L(0); PG8_BAR; PG8_MMA(1, 0, At, B0); PG8_MMA(1, 1, At, B1); PG8_BAR; PG8_SCHED;
            PG8_LDB(B0, 1, 0); PG8_LDB(B1, 1, 1); PG8_SCHED; PG8_LDA(At, 1, 0); PG8_STAGE(PG8_SA(0, 1), a2 + hstep, voffA);
            PG8_WAIT_V(8); PG8_WAIT_L(0); PG8_BAR; PG8_MMA(0, 0, At, B0); PG8_MMA(0, 1, At, B1); PG8_BAR; PG8_SCHED;
            PG8_LDA(At, 1, 1); PG8_STAGE(PG8_SB(1, 0), b3, voffB); PG8_STAGE(PG8_SB(1, 1), b3 + hstep, voffB); PG8_STAGE(PG8_SA(1, 0), a3, voffA);
            PG8_WAIT_V(8); PG8_WAIT_L(0); PG8_BAR; PG8_MMA(1, 0, At, B0); PG8_MMA(1, 1, At, B1); PG8_BAR; PG8_SCHED;
            } else {
            PG8_LDB(B0, 0, 0); PG8_SCHED; PG8_LDA(At, 0, 0); PG8_STAGE(PG8_SA(1, 1), a1 + hstep, voffA);
            PG8_WAIT_L(8); PG8_BAR; PG8_WAIT_L(0); PG8_MMA(0, 0, At, B0); PG8_BAR; PG8_SCHED;
            PG8_LDB(B1, 0, 1); PG8_STAGE(PG8_SB(0, 0), b2, voffB);
            PG8_BAR; PG8_WAIT_L(0); PG8_MMA(0, 1, At, B1); PG8_BAR;
            PG8_LDA(At, 0, 1); PG8_STAGE(PG8_SA(0, 0), a2, voffA);
            PG8_BAR; PG8_WAIT_L(0); PG8_MMA(1, 0, At, B0); PG8_BAR; PG8_SCHED;
            PG8_STAGE(PG8_SB(0, 1), b2 + hstep, voffB);
            PG8_WAIT_V(6); PG8_BAR; PG8_MMA(1, 1, At, B1); PG8_BAR;
            PG8_LDB(B0, 1, 0); PG8_SCHED; PG8_LDA(At, 1, 0); PG8_STAGE(PG8_SA(0, 1), a2 + hstep, voffA);
            PG8_WAIT_L(8); PG8_BAR; PG8_WAIT_L(0); PG8_MMA(0, 0, At, B0); PG8_BAR; PG8_SCHED;
            PG8_LDB(B1, 1, 1); PG8_STAGE(PG8_SB(1, 0), b3, voffB);
            PG8_BAR; PG8_WAIT_L(0); PG8_MMA(0, 1, At, B1); PG8_BAR;
            PG8_LDA(At, 1, 1); PG8_STAGE(PG8_SA(1, 0), a3, voffA);
            PG8_BAR; PG8_WAIT_L(0); PG8_MMA(1, 0, At, B0); PG8_BAR; PG8_SCHED;
            PG8_STAGE(PG8_SB(1, 1), b3 + hstep, voffB);
            PG8_WAIT_V(6); PG8_BAR; PG8_MMA(1, 1, At, B1); PG8_BAR;
            }
        }
        if constexpr (ALIGN_EPI) { if (wr == 0) PG8_BAR; }
        if constexpr (!Epi::AFTER_DRAIN) { E(acc, cur, wr, wc, fr, fq); S.done(cur); }
        if (!has_next) break;
#pragma unroll
        for (int a = 0; a < 2; ++a)
#pragma unroll
            for (int b = 0; b < 2; ++b)
#pragma unroll
                for (int m = 0; m < 4; ++m)
#pragma unroll
                    for (int n = 0; n < 2; ++n) acc[a][b][m][n] = (f32x4){0.f, 0.f, 0.f, 0.f};
        cur = nxt; cA = nA; cB = nB; ++ui;
        if constexpr (ALIGN_EPI) { if (wr == 1) PG8_BAR; }
    }
    PG8_WAIT_V(0);
    if constexpr (!ALIGN_EPI) { if (wr == 0) PG8_BAR; }
    PG8_BAR;
    if constexpr (Epi::AFTER_DRAIN) { E.fused(acc, cur, wr, wc, fr, fq, lds, wid, lane); S.done(cur); }
#undef PG8_SA
#undef PG8_SB
#undef PG8_STAGE
#undef PG8_LDA
#undef PG8_LDB
#undef PG8_MMA
#undef PG8_WAIT_V
#undef PG8_WAIT_L
#undef PG8_BAR
#undef PG8_SCHED
}
}

constexpr int NB = 8, SEQ = 4096, DM = 1024, CTXL = 256;
constexpr int MLAT = NB * SEQ, MCTX = NB * CTXL, MALL = MLAT + MCTX;
constexpr int DH = 512, NHY = 1536, NGL = 1792, NINP = NHY + NGL, NIN = 3104, FF = 4096;
constexpr int GQ = 0, GK = 256, GV = 512, GOG = 1024, GGF = 1536;
constexpr int NSIG = 68, NITEM = NB * 4 * 2 * NSIG;
constexpr float EPSF = 1e-6f;
constexpr int MOD_SH1 = 0, MOD_SC1 = 1024, MOD_G1 = 2048, MOD_SH2 = 3072, MOD_SC2 = 4096, MOD_G2 = 5120, MODW = 6144;

constexpr size_t MiB = 1u << 20;
constexpr size_t WS_CTL = 0, WS_MOD = 1 * MiB, WS_SSQ = 2 * MiB, WS_WIN = 4 * MiB, WS_WOUT = 11 * MiB, WS_W1 = 13 * MiB, WS_W2 = 21 * MiB;
constexpr size_t WS_KRAW = 30 * MiB, WS_DEC = 46 * MiB, WS_XN = 48 * MiB  , WS_HYT = 116 * MiB, WS_GPROJ = 212 * MiB;
constexpr size_t WS_YT = 331 * MiB, WS_YCAT = 363 * MiB, WS_HID = 116 * MiB  , WS_END = 427 * MiB;
static_assert(WS_WIN + (size_t)NINP * DM * 2 <= WS_WOUT && WS_W2 + (size_t)DM * FF * 2 <= WS_KRAW && WS_KRAW + (size_t)DH * 8192 * 4 <= WS_DEC, "ws map 1");
static_assert(WS_DEC + (size_t)NITEM * 64 * 4 <= WS_XN && WS_XN + (size_t)MALL * DM * 2 <= WS_HYT && WS_XN + (size_t)NITEM * 8192 * 2 <= WS_HYT, "ws map 2");
static_assert(WS_HYT + (size_t)NHY * MLAT * 2 <= WS_GPROJ && WS_GPROJ + (size_t)MALL * NGL * 2 <= WS_YT && WS_YT + (size_t)DH * MLAT * 2 <= WS_YCAT, "ws map 3");
static_assert(WS_HID + (size_t)MLAT * FF * 2 <= WS_YCAT + (size_t)MLAT * DM * 2 && WS_YCAT + (size_t)MLAT * DM * 2 <= WS_END, "ws map 4");

constexpr int NTHR = 512, NWAVES = 8;
constexpr int LDS_BYTES = 147456;

#define LAS __attribute__((address_space(3)))
typedef unsigned short bf16;
typedef unsigned v4u __attribute__((ext_vector_type(4)));
typedef unsigned v2u __attribute__((ext_vector_type(2)));
typedef float f32x4 __attribute__((ext_vector_type(4)));
#define LDS_WAIT() asm volatile("s_waitcnt lgkmcnt(0)" ::: "memory")

__device__ __forceinline__ unsigned f2bf(float f) { unsigned u = __builtin_bit_cast(unsigned, f); return (u + 0x7fffu + ((u >> 16) & 1u)) >> 16; }
__device__ __forceinline__ unsigned pk2(float lo, float hi) { return f2bf(lo) | (f2bf(hi) << 16); }
__device__ __forceinline__ float bf2f(unsigned h) { return __builtin_bit_cast(float, h << 16); }
__device__ __forceinline__ float wave_sum(float v) {
#pragma unroll
    for (int o = 1; o < 64; o <<= 1) v += __shfl_xor(v, o);
    return v;
}
__device__ __forceinline__ float siluf(float v) { return v / (1.f + __expf(-v)); }
__device__ __forceinline__ float logsigmoidf(float a) { return fminf(a, 0.f) - log1pf(__expf(-fabsf(a))); }

struct Args { const float* in[29]; float* out; unsigned char* ws; int ph_lo, ph_hi; };

enum { I_X = 0, I_C, I_CTX, I_CCTX, I_WADA, I_BADA, I_NMIX, I_NMLP, I_WIN, I_CONVW, I_CONVB, I_FW1, I_FB1, I_FW2, I_FB2, I_FW3, I_FB3, I_FFREQ, I_FWOUT,
       I_HBIAS, I_GKWF, I_GKBF, I_GKWB, I_GKBB, I_GLAN, I_WOUT, I_WM1, I_WM2, I_NFIN };

__device__ __forceinline__ void p0_transpose_item(const float* W, int K, int N, bf16* WT, int row_off, float* scr, int item, int lane) {
    const int nblk = N / 32, kb = item / nblk, nb = item % nblk, k0 = 64 * kb, n0 = 32 * nb;
#pragma unroll 8
    for (int i = 0; i < 32; ++i) { const int kk = 2 * i + (lane >> 5); scr[kk * 33 + (lane & 31)] = W[(size_t)(k0 + kk) * N + n0 + (lane & 31)]; }
    LDS_WAIT(); asm volatile("" ::: "memory");
    const int c = lane & 7;
#pragma unroll
    for (int j = 0; j < 4; ++j) { const int n = (lane >> 3) + 8 * j; const float* s = scr + (8 * c) * 33 + n;
        v4u o; o.x = pk2(s[0 * 33], s[1 * 33]); o.y = pk2(s[2 * 33], s[3 * 33]); o.z = pk2(s[4 * 33], s[5 * 33]); o.w = pk2(s[6 * 33], s[7 * 33]);
        *(v4u*)(WT + (size_t)(row_off + n0 + n) * K + k0 + 8 * c) = o; }
    LDS_WAIT(); asm volatile("" ::: "memory");
}

__device__ __forceinline__ void p0_filter(const Args& a, unsigned char* lds) {
    float* zb = (float*)lds;
    float* h1 = zb + 16 * 33;
    float* h2 = h1 + 16 * 64;
    const int tid = threadIdx.x;
    float* Kraw = (float*)(a.ws + WS_KRAW); float* SSQ = (float*)(a.ws + WS_SSQ);
    const float* w1 = a.in[I_FW1]; const float* b1 = a.in[I_FB1]; const float* w2 = a.in[I_FW2]; const float* b2 = a.in[I_FB2];
    const float* w3 = a.in[I_FW3]; const float* b3 = a.in[I_FB3]; const float* fr = a.in[I_FFREQ]; const float* wo = a.in[I_FWOUT];
    for (int pg = blockIdx.x; pg < 256; pg += gridDim.x) {
        const int p0 = pg * 16;
        for (int i = tid; i < 16 * 33; i += NTHR) { const int pp = i / 33, j = i % 33; const int p = p0 + pp; float val;
            if (j == 0) val = (float)p * (1.0f / 4095.0f);
            else { const int bi = (j - 1) & 15; const float f = 1e-4f + (float)bi * ((15.0f - 1e-4f) / 15.0f); const float w = 6.283185307179586f * (float)p / 4096.0f; const float ang = w * f;
                   val = (j <= 16) ? cosf(ang) : -sinf(ang); }
            zb[i] = val; }
        __syncthreads();
        for (int i = tid; i < 1024; i += NTHR) { const int pp = i >> 6, j = i & 63; float acc = b1[j];
            for (int k = 0; k < 33; ++k) acc += zb[pp * 33 + k] * w1[k * 64 + j];
            h1[i] = sinf(fr[j] * acc); }
        __syncthreads();
        for (int i = tid; i < 1024; i += NTHR) { const int pp = i >> 6, j = i & 63; float acc = b2[j];
            for (int k = 0; k < 64; ++k) acc += h1[pp * 64 + k] * w2[k * 64 + j];
            h2[i] = sinf(fr[j] * acc); }
        __syncthreads();
        for (int i = tid; i < 1024; i += NTHR) { const int pp = i >> 6, j = i & 63; float acc = b3[j];
            for (int k = 0; k < 64; ++k) acc += h2[pp * 64 + k] * w3[k * 64 + j];
            h1[i] = sinf(fr[j] * acc); }
        __syncthreads();
        for (int dir = 0; dir < 2; ++dir) { const int c = tid, o = dir * 512 + c; float acc[16];
#pragma unroll
            for (int pp = 0; pp < 16; ++pp) acc[pp] = 0.f;
            for (int j = 0; j < 64; ++j) { const float w = wo[j * 1024 + o];
#pragma unroll
                for (int pp = 0; pp < 16; ++pp) acc[pp] += h1[pp * 64 + j] * w; }
            const float delta = 3.0701134573253945f + (float)c * ((15.350567286626972f - 3.0701134573253945f) / 511.0f); float ssq = 0.f;
#pragma unroll
            for (int pp = 0; pp < 16; ++pp) { const int p = p0 + pp; const float tn = (float)p * (1.0f / 4095.0f); const float val = acc[pp] * expf(-tn * delta);
                if (dir == 0) { Kraw[(size_t)c * 8192 + 4096 + p] = val; ssq += val * val; }
                else if (p >= 1) { Kraw[(size_t)c * 8192 + 4096 - p] = val; ssq += val * val; } }
            SSQ[pg * 1024 + o] = ssq;
            if (pg == 0 && dir == 0) Kraw[(size_t)c * 8192] = 0.f; }
        __syncthreads();
    }
}

__device__ __forceinline__ void p0_mod(const Args& a, unsigned char* lds) {
    float* sc = (float*)lds;
    float* red = sc + 9 * 1024;
    const int tid = threadIdx.x;
    if ((int)blockIdx.x >= 192) return;
    for (int i = tid; i < 9 * 1024; i += NTHR) { const float v = (i < 8192) ? a.in[I_C][i] : a.in[I_CCTX][i - 8192]; sc[i] = siluf(v); }
    __syncthreads();
    const float* wa = a.in[I_WADA]; const float* ba = a.in[I_BADA]; float* mod = (float*)(a.ws + WS_MOD);
    for (int it = blockIdx.x; it < 192; it += gridDim.x) {
        const int col = tid & 31, ks = tid >> 5, c0 = it * 32; float acc[9];
#pragma unroll
        for (int r = 0; r < 9; ++r) acc[r] = 0.f;
#pragma unroll 4
        for (int k = ks * 64; k < ks * 64 + 64; ++k) { const float w = wa[(size_t)k * MODW + c0 + col];
#pragma unroll
            for (int r = 0; r < 9; ++r) acc[r] += sc[r * 1024 + k] * w; }
#pragma unroll
        for (int r = 0; r < 9; ++r) red[(ks * 9 + r) * 32 + col] = acc[r];
        __syncthreads();
        if (tid < 288) { const int r = tid >> 5, cc = tid & 31; float s = ba[c0 + cc];
            for (int k2 = 0; k2 < 16; ++k2) s += red[(k2 * 9 + r) * 32 + cc];
            mod[r * MODW + c0 + cc] = s; }
        __syncthreads();
    }
}

__device__ __forceinline__ void p0_prologue(const Args& a, unsigned char* lds) {
    const int tid = threadIdx.x, lane = tid & 63, wave = tid >> 6;
    p0_filter(a, lds);
    __syncthreads();
    p0_mod(a, lds);
    __syncthreads();
    { v4u* z = (v4u*)((bf16*)(a.ws + WS_WIN) + (size_t)NIN * DM); const int n16 = (NINP - NIN) * DM * 2 / 16;
      for (int i = blockIdx.x * NTHR + tid; i < n16; i += gridDim.x * NTHR) z[i] = (v4u){0u, 0u, 0u, 0u}; }
    float* scr = (float*)(lds + wave * 16384);
    const int gw = blockIdx.x * NWAVES + wave, NGW = gridDim.x * NWAVES;
    constexpr int I_IN = (DM / 64) * (NIN / 32), I_O = (DM / 64) * (DM / 32), I_1 = (DM / 64) * (FF / 32), I_2 = (FF / 64) * (DM / 32);
    constexpr int NITEMS = I_IN + I_O + I_1 + I_2;
    for (int it = gw; it < NITEMS; it += NGW) {
        int r = it;
        if (r < I_IN) { p0_transpose_item(a.in[I_WIN], DM, NIN, (bf16*)(a.ws + WS_WIN), 0, scr, r, lane); continue; } r -= I_IN;
        if (r < I_O) { p0_transpose_item(a.in[I_WOUT], DM, DM, (bf16*)(a.ws + WS_WOUT), 0, scr, r, lane); continue; } r -= I_O;
        if (r < I_1) { p0_transpose_item(a.in[I_WM1], DM, FF, (bf16*)(a.ws + WS_W1), 0, scr, r, lane); continue; } r -= I_1;
        p0_transpose_item(a.in[I_WM2], FF, DM, (bf16*)(a.ws + WS_W2), 0, scr, r, lane);
    }
}

__device__ __forceinline__ void norm_mod_rows(const Args& a, const float* src_lat, const float* src_ctx, int nrows, const float* g, int sc_off, int sh_off, bf16* dst) {
    const int tid = threadIdx.x, lane = tid & 63, wave = tid >> 6;
    const int gw = blockIdx.x * NWAVES + wave, NGW = gridDim.x * NWAVES;
    const float* mod = (const float*)(a.ws + WS_MOD);
    for (int row = gw; row < nrows; row += NGW) {
        const float* src = row < MLAT ? src_lat + (size_t)row * DM : src_ctx + (size_t)(row - MLAT) * DM;
        const int mrow = row < MLAT ? row / SEQ : 8;
        const f32x4* xr = (const f32x4*)src + lane;
        f32x4 v[4]; float s = 0.f;
#pragma unroll
        for (int j = 0; j < 4; ++j) { v[j] = xr[64 * j]; s += (v[j].x * v[j].x + v[j].y * v[j].y) + (v[j].z * v[j].z + v[j].w * v[j].w); }
        const float rstd = rsqrtf(wave_sum(s) * (1.f / DM) + EPSF);
        unsigned long long* o8 = (unsigned long long*)(dst + (size_t)row * DM) + lane;
#pragma unroll
        for (int j = 0; j < 4; ++j) { const int col = 256 * j + 4 * lane;
            const f32x4 gg = *(const f32x4*)(g + col), scv = *(const f32x4*)(mod + mrow * MODW + sc_off + col), shv = *(const f32x4*)(mod + mrow * MODW + sh_off + col);
            const f32x4 y = (v[j] * rstd * gg) * (scv + 1.f) + shv;
            o8[64 * j] = (unsigned long long)pk2(y.x, y.y) | ((unsigned long long)pk2(y.z, y.w) << 32); }
    }
}
__device__ __forceinline__ void final_norm_rows(const Args& a) {
    const int tid = threadIdx.x, lane = tid & 63, wave = tid >> 6;
    const int gw = blockIdx.x * NWAVES + wave, NGW = gridDim.x * NWAVES;
    const float* g = a.in[I_NFIN];
    for (int row = gw; row < MLAT; row += NGW) {
        f32x4* xr = (f32x4*)(a.out + (size_t)row * DM) + lane;
        f32x4 v[4]; float s = 0.f;
#pragma unroll
        for (int j = 0; j < 4; ++j) { v[j] = xr[64 * j]; s += (v[j].x * v[j].x + v[j].y * v[j].y) + (v[j].z * v[j].z + v[j].w * v[j].w); }
        const float rstd = rsqrtf(wave_sum(s) * (1.f / DM) + EPSF);
#pragma unroll
        for (int j = 0; j < 4; ++j) { const f32x4 gg = *(const f32x4*)(g + 256 * j + 4 * lane); xr[64 * j] = v[j] * rstd * gg; }
    }
}

constexpr int L_GR = 0, L_WG = 1024, L_BG = 2048, L_TOT = 2112, L_BC = 2176, L_KE = L_BC + 4096, L_KI = L_KE + 64 * 65, L_ATT = L_KI + 64 * 65, L_V = L_ATT + 64 * 65, L_S = L_V + 64 * 128, L_END = L_S + 128 * 65;
static_assert(L_END * 4 <= LDS_BYTES, "GLA LDS map");

__device__ __forceinline__ void gla_gate_cumsum(const Args& a, float* L, const bf16* gp, size_t row0, int h, int dir) {
    const int tid = threadIdx.x;
    const float* gkw = a.in[dir ? I_GKWB : I_GKWF]; const float* gkb = a.in[dir ? I_GKBB : I_GKBF];
    for (int i = tid; i < 1024; i += NTHR) { const int tok = i >> 4, r = i & 15; L[L_GR + i] = bf2f(gp[(row0 + tok) * NGL + GGF + dir * 16 + r]); }
    for (int i = tid; i < 1024; i += NTHR) { const int r = i >> 6, d = i & 63; L[L_WG + i] = gkw[r * 256 + h * 64 + d]; }
    if (tid < 64) L[L_BG + tid] = gkb[h * 64 + tid];
    __syncthreads();
    for (int i = tid; i < 4096; i += NTHR) { const int tok = i >> 6, d = i & 63; float acc = L[L_BG + d];
#pragma unroll
        for (int r = 0; r < 16; ++r) acc += L[L_GR + tok * 16 + r] * L[L_WG + r * 64 + d];
        L[L_BC + i] = logsigmoidf(acc) * (1.0f / 16.0f); }
    __syncthreads();
    if (tid < 64) { float run = 0.f;
        if (dir == 0) { for (int tok = 0; tok < 64; ++tok) { run += L[L_BC + tok * 64 + tid]; L[L_BC + tok * 64 + tid] = run; } }
        else { for (int tok = 63; tok >= 0; --tok) { run += L[L_BC + tok * 64 + tid]; L[L_BC + tok * 64 + tid] = run; } }
        L[L_TOT + tid] = run; }
    __syncthreads();
}

__device__ __forceinline__ size_t gla_chunk_row0(int b, int dir, int sig) {
    if (sig < 4) { const int cc = dir == 0 ? sig : 3 - sig; return (size_t)MLAT + b * CTXL + cc * 64; }
    const int n = dir == 0 ? sig - 4 : 67 - sig; return (size_t)b * SEQ + n * 64;
}

__device__ __forceinline__ void gla_local(const Args& a, unsigned char* lds) {
    float* L = (float*)lds; const int tid = threadIdx.x;
    const bf16* gp = (const bf16*)(a.ws + WS_GPROJ); bf16* ST = (bf16*)(a.ws + WS_XN); float* DEC = (float*)(a.ws + WS_DEC);
    for (int item = blockIdx.x; item < NITEM; item += gridDim.x) {
        const int sig = item % NSIG, chain = item / NSIG, dir = chain & 1, h = (chain >> 1) & 3, b = chain >> 3;
        const size_t row0 = gla_chunk_row0(b, dir, sig);
        gla_gate_cumsum(a, L, gp, row0, h, dir);
        for (int i = tid; i < 4096; i += NTHR) { const int tok = i >> 6, d = i & 63;
            L[L_KE + tok * 65 + d] = bf2f(gp[(row0 + tok) * NGL + GK + h * 64 + d]) * __expf(L[L_TOT + d] - L[L_BC + i]); }
        for (int i = tid; i < 8192; i += NTHR) { const int tok = i >> 7, e = i & 127; L[L_V + i] = bf2f(gp[(row0 + tok) * NGL + GV + h * 128 + e]); }
        __syncthreads();
        { const int d = tid & 63, e0 = (tid >> 6) * 16; float acc[16];
#pragma unroll
          for (int i = 0; i < 16; ++i) acc[i] = 0.f;
          for (int tok = 0; tok < 64; ++tok) { const float ke = L[L_KE + tok * 65 + d];
#pragma unroll
              for (int i = 0; i < 16; ++i) acc[i] += L[L_V + tok * 128 + e0 + i] * ke; }
#pragma unroll
          for (int i = 0; i < 16; ++i) ST[(size_t)item * 8192 + (e0 + i) * 64 + d] = (bf16)f2bf(acc[i]);
          if (tid < 64) DEC[item * 64 + tid] = __expf(L[L_TOT + tid]); }
        __syncthreads();
    }
}

__device__ __forceinline__ void gla_scan(const Args& a) {
    bf16* ST = (bf16*)(a.ws + WS_XN); const float* DEC = (const float*)(a.ws + WS_DEC);
    for (int w = blockIdx.x * NTHR + threadIdx.x; w < 64 * 1024; w += gridDim.x * NTHR) {
        const int chain = w >> 10, el = (w & 1023) * 8, d0 = el & 63; float s[8];
#pragma unroll
        for (int i = 0; i < 8; ++i) s[i] = 0.f;
#pragma unroll 4
        for (int sig = 0; sig < NSIG; ++sig) { const size_t item = (size_t)chain * NSIG + sig;
            v4u* p = (v4u*)(ST + item * 8192 + el); const v4u dsv = *p;
            const f32x4 d0v = *(const f32x4*)(DEC + item * 64 + d0), d1v = *(const f32x4*)(DEC + item * 64 + d0 + 4);
            v4u o; o.x = pk2(s[0], s[1]); o.y = pk2(s[2], s[3]); o.z = pk2(s[4], s[5]); o.w = pk2(s[6], s[7]); *p = o;
            s[0] = d0v.x * s[0] + bf2f(dsv.x & 0xffffu); s[1] = d0v.y * s[1] + bf2f(dsv.x >> 16);
            s[2] = d0v.z * s[2] + bf2f(dsv.y & 0xffffu); s[3] = d0v.w * s[3] + bf2f(dsv.y >> 16);
            s[4] = d1v.x * s[4] + bf2f(dsv.z & 0xffffu); s[5] = d1v.y * s[5] + bf2f(dsv.z >> 16);
            s[6] = d1v.z * s[6] + bf2f(dsv.w & 0xffffu); s[7] = d1v.w * s[7] + bf2f(dsv.w >> 16); }
    }
}

__device__ __forceinline__ void gla_out(const Args& a, unsigned char* lds) {
    float* L = (float*)lds; const int tid = threadIdx.x, lane = tid & 63, wave = tid >> 6;
    const bf16* gp = (const bf16*)(a.ws + WS_GPROJ); const bf16* ST = (const bf16*)(a.ws + WS_XN); bf16* ycat = (bf16*)(a.ws + WS_YCAT);
    const float* gn = a.in[I_GLAN];
    for (int it = blockIdx.x; it < NB * 4 * 64; it += gridDim.x) {
        const int n = it & 63, h = (it >> 6) & 3, b = it >> 8; const size_t row0 = (size_t)b * SEQ + n * 64;
        const int e = tid & 127, c0 = (tid >> 7) * 16; float o[16];
#pragma unroll
        for (int i = 0; i < 16; ++i) o[i] = 0.f;
        for (int dir = 0; dir < 2; ++dir) {
            gla_gate_cumsum(a, L, gp, row0, h, dir);
            const int sig = dir == 0 ? n + 4 : 67 - n; const size_t item = (size_t)((b * 4 + h) * 2 + dir) * NSIG + sig;
            for (int i = tid; i < 4096; i += NTHR) { const int tok = i >> 6, d = i & 63; const float bc = L[L_BC + i];
                L[L_KE + tok * 65 + d] = bf2f(gp[(row0 + tok) * NGL + GQ + h * 64 + d]) * 0.125f * __expf(bc);
                L[L_KI + tok * 65 + d] = bf2f(gp[(row0 + tok) * NGL + GK + h * 64 + d]) * __expf(-bc); }
            if (dir == 0) for (int i = tid; i < 8192; i += NTHR) { const int tok = i >> 7, ee = i & 127; L[L_V + i] = bf2f(gp[(row0 + tok) * NGL + GV + h * 128 + ee]); }
            for (int i = tid; i < 8192; i += NTHR) { const int ee = i >> 6, d = i & 63; L[L_S + ee * 65 + d] = bf2f(ST[item * 8192 + i]); }
            __syncthreads();
            { const int s = tid & 63, ca = (tid >> 6) * 8; float acc[8];
#pragma unroll
              for (int i = 0; i < 8; ++i) acc[i] = 0.f;
              for (int d = 0; d < 64; ++d) { const float ki = L[L_KI + s * 65 + d];
#pragma unroll
                  for (int i = 0; i < 8; ++i) acc[i] += L[L_KE + (ca + i) * 65 + d] * ki; }
#pragma unroll
              for (int i = 0; i < 8; ++i) { const int c = ca + i; const bool keep = dir == 0 ? (s <= c) : (s >= c); L[L_ATT + c * 65 + s] = keep ? acc[i] : 0.f; } }
            __syncthreads();
            for (int s = 0; s < 64; ++s) { const float vv = L[L_V + s * 128 + e];
#pragma unroll
                for (int i = 0; i < 16; ++i) o[i] += L[L_ATT + (c0 + i) * 65 + s] * vv; }
            for (int d = 0; d < 64; ++d) { const float sv = L[L_S + e * 65 + d];
#pragma unroll
                for (int i = 0; i < 16; ++i) o[i] += L[L_KE + (c0 + i) * 65 + d] * sv; }
            __syncthreads();
        }
        float* OB = L + L_KE;
#pragma unroll
        for (int i = 0; i < 16; ++i) OB[(c0 + i) * 128 + e] = o[i];
        __syncthreads();
        for (int j = 0; j < 8; ++j) { const int c = wave * 8 + j; const float v0 = OB[c * 128 + lane], v1 = OB[c * 128 + 64 + lane];
            const float rstd = rsqrtf(wave_sum(v0 * v0 + v1 * v1) * (1.f / 128.f) + EPSF);
            const size_t row = row0 + c;
            const float g0 = bf2f(gp[row * NGL + GOG + h * 128 + lane]), g1 = bf2f(gp[row * NGL + GOG + h * 128 + 64 + lane]);
            ycat[row * DM + DH + h * 128 + lane] = (bf16)f2bf(v0 * rstd * gn[lane] * siluf(g0));
            ycat[row * DM + DH + h * 128 + 64 + lane] = (bf16)f2bf(v1 * rstd * gn[64 + lane] * siluf(g1)); }
        __syncthreads();
    }
}

__device__ __forceinline__ float hy_sconv(const bf16* hyT, int ch, int col, float w0, float w1, float w2, float cb) {
    const int tt = col & 63; const bf16* p = hyT + (size_t)ch * MLAT + col;
    const float h0 = bf2f(p[0]), hm = tt > 0 ? bf2f(p[-1]) : 0.f, hp = tt < 63 ? bf2f(p[1]) : 0.f;
    return cb + w0 * hm + w1 * h0 + w2 * hp;
}
__device__ __forceinline__ void hyena_conv(const Args& a, unsigned char* lds) {
    float* KL = (float*)lds;
    bf16* Z = (bf16*)(lds + 32768);
    float* RED = (float*)(lds + 32768 + 65536);
    const int tid = threadIdx.x, lane = tid & 63, wave = tid >> 6;
    const bf16* hyT = (const bf16*)(a.ws + WS_HYT); bf16* yT = (bf16*)(a.ws + WS_YT);
    const float* Kraw = (const float*)(a.ws + WS_KRAW); const float* SSQ = (const float*)(a.ws + WS_SSQ);
    const float* cw = a.in[I_CONVW]; const float* cbv = a.in[I_CONVB];
    for (int c = blockIdx.x; c < DH; c += gridDim.x) {
        { const float part = SSQ[(tid >> 1) * 1024 + (tid & 1) * 512 + c]; const float ws = wave_sum(part); if (lane == 0) RED[wave] = ws; }
        __syncthreads();
        float tot = 0.f;
#pragma unroll
        for (int i = 0; i < 8; ++i) tot += RED[i];
        const float sc = rsqrtf(tot + EPSF);
        for (int i = tid; i < 8192; i += NTHR) KL[i] = Kraw[(size_t)c * 8192 + i] * sc;
        { const int c1 = DH + c, c2 = 2 * DH + c;
          const float a0 = cw[c1], a1 = cw[NHY + c1], a2 = cw[2 * NHY + c1], ab = cbv[c1], b0 = cw[c2], b1 = cw[NHY + c2], b2 = cw[2 * NHY + c2], bb = cbv[c2];
          for (int i = tid; i < MLAT; i += NTHR) Z[i] = (bf16)f2bf(hy_sconv(hyT, c1, i, a0, a1, a2, ab) * hy_sconv(hyT, c2, i, b0, b1, b2, bb)); }
        __syncthreads();
        float acc[8][8];
#pragma unroll
        for (int j = 0; j < 8; ++j)
#pragma unroll
            for (int b = 0; b < 8; ++b) acc[j][b] = 0.f;
        const unsigned* Z2 = (const unsigned*)Z;
        for (int s2 = 0; s2 < 2048; ++s2) { float zl[8], zh[8];
#pragma unroll
            for (int b = 0; b < 8; ++b) { const unsigned zz = Z2[b * 2048 + s2]; zl[b] = bf2f(zz & 0xffffu); zh[b] = bf2f(zz >> 16); }
#pragma unroll
            for (int j = 0; j < 8; ++j) { const int base = tid + 512 * j - 2 * s2 + 4096; const float k0 = KL[base], k1 = KL[base - 1];
#pragma unroll
                for (int b = 0; b < 8; ++b) acc[j][b] += k0 * zl[b] + k1 * zh[b]; } }
        { const float w0 = cw[c], w1 = cw[NHY + c], w2 = cw[2 * NHY + c], wb = cbv[c], hb = a.in[I_HBIAS][c];
#pragma unroll
          for (int j = 0; j < 8; ++j)
#pragma unroll
              for (int b = 0; b < 8; ++b) { const int col = b * SEQ + tid + 512 * j; const float x0 = hy_sconv(hyT, c, col, w0, w1, w2, wb);
                  yT[(size_t)c * MLAT + col] = (bf16)f2bf(x0 * (acc[j][b] + hb * bf2f(Z[col]))); } }
        __syncthreads();
    }
}
__device__ __forceinline__ void hyena_transpose(const Args& a, unsigned char* lds) {
    const int tid = threadIdx.x, lane = tid & 63, wave = tid >> 6;
    bf16* scr = (bf16*)(lds + wave * 16384);
    const bf16* yT = (const bf16*)(a.ws + WS_YT); bf16* ycat = (bf16*)(a.ws + WS_YCAT);
    const int gw = blockIdx.x * NWAVES + wave, NGW = gridDim.x * NWAVES;
    for (int t = gw; t < (DH / 64) * (MLAT / 64); t += NGW) { const int cb = t & 7, tb = t >> 3, c0 = cb * 64, k0 = tb * 64;
        for (int r = 0; r < 64; ++r) scr[r * 66 + lane] = yT[(size_t)(c0 + r) * MLAT + k0 + lane];
        LDS_WAIT(); asm volatile("" ::: "memory");
        for (int r = 0; r < 64; ++r) ycat[(size_t)(k0 + r) * DM + c0 + lane] = scr[lane * 66 + r];
        LDS_WAIT(); asm volatile("" ::: "memory"); }
}

constexpr int NPHASE = 11;
__global__ void __launch_bounds__(NTHR, 2) fwd_kernel(Args a) {
    extern __shared__ __attribute__((aligned(16))) unsigned char lds[];
    cg::grid_group grid = cg::this_grid();
    const int lo = a.ph_lo, hi = a.ph_hi;
#define IN(k) (lo <= (k) && (k) < hi)
#define SEAM(k) do { if (IN(k) && IN((k) + 1)) grid.sync(); } while (0)
    unsigned char* ws = a.ws;
    PG8_LAS unsigned char* ldsg = (PG8_LAS unsigned char*)lds;
    if (IN(0)) { p0_prologue(a, lds); } SEAM(0);
    if (IN(1)) { norm_mod_rows(a, a.in[I_X], a.in[I_CTX], MALL, a.in[I_NMIX], MOD_SC1, MOD_SH1, (bf16*)(ws + WS_XN)); } SEAM(1);
    if (IN(2)) {
        { pg8::Gemm g{(const pg8::bf16_t*)(ws + WS_WIN), (const pg8::bf16_t*)(ws + WS_XN), NHY, MLAT, DM}; pg8::StaticOrder S; S.init(NHY, MLAT, gridDim.x, blockIdx.x);
          pg8::EpiBf16<0> E{(pg8::bf16_t*)(ws + WS_HYT), MLAT};
          pg8::gemm_phase<pg8::EpiBf16<0>, pg8::StaticOrder, true, true>(ldsg, g, S, E); }
        __syncthreads();
        { pg8::Gemm g{(const pg8::bf16_t*)(ws + WS_XN), (const pg8::bf16_t*)(ws + WS_WIN) + (size_t)NHY * DM, MALL, NGL, DM}; pg8::StaticOrder S; S.init(MALL, NGL, gridDim.x, blockIdx.x);
          pg8::EpiBf16<0> E{(pg8::bf16_t*)(ws + WS_GPROJ), NGL};
          pg8::gemm_phase<pg8::EpiBf16<0>, pg8::StaticOrder, true, true>(ldsg, g, S, E); }
    } SEAM(2);
    if (IN(3)) { gla_local(a, lds); __syncthreads(); hyena_conv(a, lds); } SEAM(3);
    if (IN(4)) { gla_scan(a); } SEAM(4);
    if (IN(5)) { gla_out(a, lds); __syncthreads(); hyena_transpose(a, lds); } SEAM(5);
    if (IN(6)) { pg8::Gemm g{(const pg8::bf16_t*)(ws + WS_YCAT), (const pg8::bf16_t*)(ws + WS_WOUT), MLAT, DM, DM}; pg8::StaticOrder S; S.init(MLAT, DM, gridDim.x, blockIdx.x);
        pg8::EpiResid E{a.in[I_X], a.out, DM, (const float*)(ws + WS_MOD) + MOD_G1, SEQ, MODW};
        pg8::gemm_phase<pg8::EpiResid, pg8::StaticOrder, true, true>(ldsg, g, S, E); } SEAM(6);
    if (IN(7)) { norm_mod_rows(a, a.out, a.out, MLAT, a.in[I_NMLP], MOD_SC2, MOD_SH2, (bf16*)(ws + WS_XN)); } SEAM(7);
    if (IN(8)) { pg8::Gemm g{(const pg8::bf16_t*)(ws + WS_XN), (const pg8::bf16_t*)(ws + WS_W1), MLAT, FF, DM}; pg8::StaticOrder S; S.init(MLAT, FF, gridDim.x, blockIdx.x);
        pg8::EpiBf16<1> E{(pg8::bf16_t*)(ws + WS_HID), FF};
        pg8::gemm_phase<pg8::EpiBf16<1>, pg8::StaticOrder, true, true>(ldsg, g, S, E); } SEAM(8);
    if (IN(9)) { pg8::Gemm g{(const pg8::bf16_t*)(ws + WS_HID), (const pg8::bf16_t*)(ws + WS_W2), MLAT, DM, FF}; pg8::StaticOrder S; S.init(MLAT, DM, gridDim.x, blockIdx.x);
        pg8::EpiResid E{a.out, a.out, DM, (const float*)(ws + WS_MOD) + MOD_G2, SEQ, MODW};
        pg8::gemm_phase<pg8::EpiResid, pg8::StaticOrder, true, true>(ldsg, g, S, E); } SEAM(9);
    if (IN(10)) { final_norm_rows(a); }
#undef IN
#undef SEAM
}

#ifndef N_LAUNCH_MODE
#define N_LAUNCH_MODE 1
#endif
extern "C" void kernel_launch(void* const* d_in, const int* in_sizes, int n_in, void* d_out, int out_size, void* d_ws, size_t ws_size, hipStream_t stream) {
    static int grid = 0;
    if (grid == 0) {
        if (n_in != 29 || out_size != MLAT * DM || ws_size < WS_END) { fprintf(stderr, "kernel_launch: unexpected shapes (n_in %d out %d ws %zu)\n", n_in, out_size, ws_size); grid = -1; return; }
        int dev = 0, cus = 0, per_cu = 0;
        if (hipGetDevice(&dev) != hipSuccess || hipDeviceGetAttribute(&cus, hipDeviceAttributeMultiprocessorCount, dev) != hipSuccess) { grid = -1; return; }
        if (hipFuncSetAttribute((const void*)fwd_kernel, hipFuncAttributeMaxDynamicSharedMemorySize, LDS_BYTES) != hipSuccess) { fprintf(stderr, "kernel_launch: hipFuncSetAttribute failed\n"); grid = -1; return; }
        if (hipOccupancyMaxActiveBlocksPerMultiprocessor(&per_cu, (const void*)fwd_kernel, NTHR, LDS_BYTES) != hipSuccess || per_cu < 1) { fprintf(stderr, "kernel_launch: occupancy query says %d blocks per CU\n", per_cu); (void)hipGetLastError(); grid = -1; return; }
        grid = cus;
    }
    if (grid < 0) return;
    Args a{};
    for (int i = 0; i < 29; ++i) a.in[i] = (const float*)d_in[i];
    a.out = (float*)d_out; a.ws = (unsigned char*)d_ws;
#if N_LAUNCH_MODE == 0
    for (int p = 0; p < NPHASE; ++p) { a.ph_lo = p; a.ph_hi = p + 1; hipLaunchKernelGGL(fwd_kernel, dim3(grid), dim3(NTHR), LDS_BYTES, stream, a); }
#else
    a.ph_lo = 0; a.ph_hi = NPHASE;
    void* args[] = {&a};
    hipError_t e = hipLaunchCooperativeKernel((const void*)fwd_kernel, dim3(grid), dim3(NTHR), args, LDS_BYTES, stream);
    if (e != hipSuccess) fprintf(stderr, "cooperative launch failed: %s (grid %d)\n", hipGetErrorString(e), grid);
#endif
}
```

```cpp
#include <hip/hip_runtime.h>
#include <hip/hip_cooperative_groups.h>
#include <cstdio>
#include <cstdint>
#include <cmath>
namespace cg = cooperative_groups;
namespace pg8 {
#define PG8_LAS __attribute__((address_space(3)))
typedef unsigned short bf16_t;
typedef short bf16x8 __attribute__((ext_vector_type(8)));
typedef float f32x4 __attribute__((ext_vector_type(4)));
typedef unsigned u32x4 __attribute__((ext_vector_type(4)));
constexpr int BM = 256, BK = 64, HALF = 128, HTB = HALF * BK * 2  , STAGE_BYTES = 8 * HTB, NXCD = 8, WGM = 8;

__host__ __device__ __forceinline__ int lds_byte(int r, int c) { const int st = (r >> 4) * 2 + (c >> 5), rr = r & 15, cc = c & 31, ob = rr * 64 + cc * 2; return st * 1024 + (ob ^ (((ob >> 9) & 1) << 5)); }
__host__ __device__ __forceinline__ void stage_rc(int b, int& R, int& C) { const int st = b / 1024, sb = b % 1024, swz = sb ^ (((sb >> 9) & 1) << 5); R = (st >> 1) * 16 + swz / 64; C = (st & 1) * 32 + (swz % 64) / 2; }
__host__ __device__ __forceinline__ int perm32(int rho) { const int n = rho >> 4, i = rho & 15; return 8 * (i >> 2) + 4 * n + (i & 3); }

struct Unit { int pm, pn; };
struct Gemm { const bf16_t* A; const bf16_t* Bt; int M, N, K; };

struct StaticOrder {
    int nM, nN, nwg, G, c;
    __host__ __device__ void init(int M, int N, int G_, int c_) { nM = M / BM; nN = N / BM; nwg = nM * nN; G = G_; c = c_; }
    __host__ __device__ bool next(int i, Unit& u) const {
        const long L = (long)i * G + c; if (L >= nwg) return false;
        int wgid = (int)L; { const int q = nwg / NXCD, r = nwg % NXCD, xcd = wgid % NXCD, off = wgid / NXCD; wgid = (xcd < r ? xcd * (q + 1) : r * (q + 1) + (xcd - r) * q) + off; }
        const int nig = WGM * nN, gid = wgid / nig, fm = gid * WGM, gsz = (nM - fm) < WGM ? (nM - fm) : WGM;
        u.pm = fm + ((wgid % nig) % gsz); u.pn = (wgid % nig) / gsz; return true;
    }
    __device__ __forceinline__ void a_ready(const Unit&) const {}
    __device__ __forceinline__ void done(const Unit&) const {}
};


__device__ __forceinline__ unsigned cvt_pk_bf16(float lo, float hi) { unsigned r; asm volatile("v_cvt_pk_bf16_f32 %0, %1, %2" : "=v"(r) : "v"(lo), "v"(hi)); return r; }

template <int ACT> struct EpiBf16 {
    static constexpr bool PERM = true, AFTER_DRAIN = false;
    bf16_t* O; int ldc;
    __device__ __forceinline__ void operator()(const f32x4 (&acc)[2][2][4][2], const Unit& u, int wr, int wc, int fr, int fq) const {
        const int row0 = u.pm * BM + wr * 64 + fr; const int col0 = u.pn * BM + wc * 32 + 8 * fq;
#pragma unroll
        for (int ai = 0; ai < 2; ++ai)
#pragma unroll
            for (int m = 0; m < 4; ++m) { bf16_t* rowp = O + (size_t)(row0 + ai * HALF + m * 16) * ldc + col0;
#pragma unroll
                for (int bj = 0; bj < 2; ++bj) { f32x4 v0 = acc[ai][bj][m][0], v1 = acc[ai][bj][m][1];
                    if (ACT == 1) {
#pragma unroll
                        for (int q = 0; q < 4; ++q) { const float a0 = fmaxf(v0[q], 0.f), a1 = fmaxf(v1[q], 0.f); v0[q] = a0 * a0; v1[q] = a1 * a1; } }
                    u32x4 w; w.x = cvt_pk_bf16(v0[0], v0[1]); w.y = cvt_pk_bf16(v0[2], v0[3]); w.z = cvt_pk_bf16(v1[0], v1[1]); w.w = cvt_pk_bf16(v1[2], v1[3]);
                    *(u32x4*)(rowp + bj * HALF) = w; } }
    }
};
struct EpiResid {
    static constexpr bool PERM = false, AFTER_DRAIN = false;
    const float* base; float* out; int ldc; const float* gate; int rows_per_gate; int gate_stride;
    __device__ __forceinline__ void operator()(const f32x4 (&acc)[2][2][4][2], const Unit& u, int wr, int wc, int fr, int fq) const {
        const int row0 = u.pm * BM + wr * 64 + fr, col0 = u.pn * BM + wc * 32 + 4 * fq;
        const float* gp = gate + (size_t)((u.pm * BM) / rows_per_gate) * gate_stride + col0;
        f32x4 gv[2][2];
#pragma unroll
        for (int bj = 0; bj < 2; ++bj)
#pragma unroll
            for (int n = 0; n < 2; ++n) gv[bj][n] = *(const f32x4*)(gp + bj * HALF + n * 16);
#pragma unroll
        for (int ai = 0; ai < 2; ++ai)
#pragma unroll
            for (int m = 0; m < 4; ++m) { const size_t off = (size_t)(row0 + ai * HALF + m * 16) * ldc + col0;
#pragma unroll
                for (int bj = 0; bj < 2; ++bj)
#pragma unroll
                    for (int n = 0; n < 2; ++n) { const f32x4 bs = *(const f32x4*)(base + off + bj * HALF + n * 16);
                        *(f32x4*)(out + off + bj * HALF + n * 16) = bs + gv[bj][n] * acc[ai][bj][m][n]; } }
    }
};

template <class Epi, class Sched, bool ALIGN_EPI = false, bool SP2 = false>
__device__ __forceinline__ void gemm_phase(PG8_LAS unsigned char* lds, const Gemm g, const Sched& S, const Epi& E) {
    const int tid = threadIdx.x, wid = __builtin_amdgcn_readfirstlane(tid >> 6), lane = tid & 63, wr = wid >> 2, wc = wid & 3, fr = lane & 15, fq = lane >> 4;
    const int K = g.K, nt = K / BK;
    unsigned voffA[2], voffB[2];
#pragma unroll
    for (int i = 0; i < 2; ++i) { int R, C; stage_rc(tid * 16 + i * 8192, R, C); const int Rb = Epi::PERM ? ((R & ~31) + perm32(R & 31)) : R;
        voffA[i] = (unsigned)(R * K + C) * 2u; voffB[i] = (unsigned)(Rb * K + C) * 2u; }
    const size_t kstep = (size_t)(BK * 2);
    const size_t hstep = (size_t)HALF * K * 2;
    const size_t tstep = 2 * hstep;
    const unsigned ldsw = (unsigned)wid * 1024u;
    const int aoff = lds_byte(wr * 64 + fr, fq * 8), boff = lds_byte(wc * 32 + fr, fq * 8);
#define PG8_SA(b, h) (((b) * 2 + (h)) * HTB)
#define PG8_SB(b, h) ((4 + (b) * 2 + (h)) * HTB)
#define PG8_STAGE(bufoff, gbase, voff) do { _Pragma("unroll") for (int _i = 0; _i < 2; ++_i) \
        __builtin_amdgcn_global_load_lds((const unsigned*)((const char*)(gbase) + (voff)[_i]), (PG8_LAS unsigned*)(lds + (bufoff) + ldsw + _i * 8192), 16, 0, 0); } while (0)
#define PG8_LDA(dst, b, h) do { _Pragma("unroll") for (int m = 0; m < 4; ++m) _Pragma("unroll") for (int k = 0; k < 2; ++k) dst[m][k] = *(const PG8_LAS bf16x8*)(lds + PG8_SA(b, h) + aoff + m * 2048 + k * 1024); } while (0)
#define PG8_LDB(dst, b, h) do { _Pragma("unroll") for (int n = 0; n < 2; ++n) _Pragma("unroll") for (int k = 0; k < 2; ++k) dst[n][k] = *(const PG8_LAS bf16x8*)(lds + PG8_SB(b, h) + boff + n * 2048 + k * 1024); } while (0)
#define PG8_MMA(ai, bj, At, Bt) do { __builtin_amdgcn_s_setprio(1); _Pragma("unroll") for (int m = 0; m < 4; ++m) _Pragma("unroll") for (int n = 0; n < 2; ++n) _Pragma("unroll") for (int k = 0; k < 2; ++k) \
        acc[ai][bj][m][n] = __builtin_amdgcn_mfma_f32_16x16x32_bf16(Bt[n][k], At[m][k], acc[ai][bj][m][n], 0, 0, 0); __builtin_amdgcn_s_setprio(0); } while (0)
#define PG8_WAIT_V(n) asm volatile("s_waitcnt vmcnt(" #n ")" ::: "memory")
#define PG8_WAIT_L(n) asm volatile("s_waitcnt lgkmcnt(" #n ")" ::: "memory")
#define PG8_BAR __builtin_amdgcn_s_barrier()
#define PG8_SCHED __builtin_amdgcn_sched_barrier(0)
    Unit cur, nxt; int ui = 0;
    if (!S.next(0, cur)) return;
    f32x4 acc[2][2][4][2];
#pragma unroll
    for (int a = 0; a < 2; ++a)
#pragma unroll
        for (int b = 0; b < 2; ++b)
#pragma unroll
            for (int m = 0; m < 4; ++m)
#pragma unroll
                for (int n = 0; n < 2; ++n) acc[a][b][m][n] = (f32x4){0.f, 0.f, 0.f, 0.f};
    bf16x8 At[4][2], B0[2][2], B1[2][2];
    const char* cA = (const char*)g.A + (size_t)cur.pm * tstep; const char* cB = (const char*)g.Bt + (size_t)cur.pn * tstep;
    S.a_ready(cur);
    if constexpr (SP2) {
        PG8_STAGE(PG8_SB(0, 0), cB, voffB); PG8_STAGE(PG8_SB(0, 1), cB + hstep, voffB); PG8_STAGE(PG8_SA(0, 0), cA, voffA); PG8_STAGE(PG8_SA(0, 1), cA + hstep, voffA);
        if (wr == 1) PG8_BAR;
        PG8_WAIT_V(2); PG8_BAR;
        PG8_STAGE(PG8_SB(1, 0), cB + kstep, voffB); PG8_STAGE(PG8_SA(1, 0), cA + kstep, voffA); PG8_STAGE(PG8_SB(1, 1), cB + hstep + kstep, voffB);
        PG8_WAIT_V(6); PG8_BAR;
    } else {
        PG8_STAGE(PG8_SB(0, 0), cB, voffB); PG8_STAGE(PG8_SA(0, 0), cA, voffA); PG8_STAGE(PG8_SB(0, 1), cB + hstep, voffB); PG8_STAGE(PG8_SA(0, 1), cA + hstep, voffA);
        if (wr == 1) PG8_BAR;
        PG8_WAIT_V(4); PG8_BAR;
        PG8_STAGE(PG8_SB(1, 0), cB + kstep, voffB); PG8_STAGE(PG8_SA(1, 0), cA + kstep, voffA); PG8_STAGE(PG8_SB(1, 1), cB + hstep + kstep, voffB);
        PG8_WAIT_V(6); PG8_BAR;
    }
    for (;;) {
        const bool has_next = S.next(ui + 1, nxt);
        const char* nA = has_next ? (const char*)g.A + (size_t)nxt.pm * tstep : cA; const char* nB = has_next ? (const char*)g.Bt + (size_t)nxt.pn * tstep : cB;
        for (int t = 0; t < nt; t += 2) {
            const bool last = (t == nt - 2);
            const char* a1 = cA + (size_t)(t + 1) * kstep;
            const char* a2 = last ? nA : cA + (size_t)(t + 2) * kstep; const char* b2 = last ? nB : cB + (size_t)(t + 2) * kstep;
            const char* a3 = a2 + kstep; const char* b3 = b2 + kstep;
            if (last && has_next) S.a_ready(nxt);
            if constexpr (SP2) {
            PG8_LDB(B0, 0, 0); PG8_LDB(B1, 0, 1); PG8_SCHED; PG8_LDA(At, 0, 0); PG8_STAGE(PG8_SA(1, 1), a1 + hstep, voffA);
            PG8_WAIT_V(8); PG8_WAIT_L(0); PG8_BAR; PG8_MMA(0, 0, At, B0); PG8_MMA(0, 1, At, B1); PG8_BAR; PG8_SCHED;
            PG8_LDA(At, 0, 1); PG8_STAGE(PG8_SB(0, 0), b2, voffB); PG8_STAGE(PG8_SB(0, 1), b2 + hstep, voffB); PG8_STAGE(PG8_SA(0, 0), a2, voffA);
            PG8_WAIT_V(8); PG8_WAIT_L(0); PG8_BAR; PG8_MMA(1, 0, At, B0); PG8_MMA(1, 1, At, B1); PG8_BAR; PG8_SCHED;
            PG8_LDB(B0, 1, 0); PG8_LDB(B1, 1, 1); PG8_SCHED; PG8_LDA(At, 1, 0); PG8_STAGE(PG8_SA(0, 1), a2 + hstep, voffA);
            PG8_WAIT_V(8); PG8_WAIT_L(0); PG8_BAR; PG8_MMA(0, 0, At, B0); PG8_MMA(0, 1, At, B1); PG8_BAR; PG8_SCHED;
            PG8_LDA(At, 1, 1); PG8_STAGE(PG8_SB(1, 0), b3, voffB); PG8_STAGE(PG8_SB(1, 1), b3 + hstep, voffB); PG8_STAGE(PG8_SA(1, 0), a3, voffA);
            PG8_WAIT_V(8); PG8_WAIT_L(0); PG8_BAR; PG8_MMA(1, 0, At, B0); PG8_MMA(1, 1, At, B1); PG8_BAR; PG8_SCHED;
            } else {
            PG8_LDB(B0, 0, 0); PG8_SCHED; PG8_LDA(At, 0, 0); PG8_STAGE(PG8_SA(1, 1), a1 + hstep, voffA);
            PG8_WAIT_L(8); PG8_BAR; PG8_WAIT_L(0); PG8_MMA(0, 0, At, B0); PG8_BAR; PG8_SCHED;
            PG8_LDB(B1, 0, 1); PG8_STAGE(PG8_SB(0, 0), b2, voffB);
            PG8_BAR; PG8_WAIT_L(0); PG8_MMA(0, 1, At, B1); PG8_BAR;
            PG8_LDA(At, 0, 1); PG8_STAGE(PG8_SA(0, 0), a2, voffA);
            PG8_BAR; PG8_WAIT_L(0); PG8_MMA(1, 0, At, B0); PG8_BAR; PG8_SCHED;
            PG8_STAGE(PG8_SB(0, 1), b2 + hstep, voffB);
            PG8_WAIT_V(6); PG8_BAR; PG8_MMA(1, 1, At, B1); PG8_BAR;
            PG8_LDB(B0, 1, 0); PG8_SCHED; PG8_LDA(At, 1, 0); PG8_STAGE(PG8_SA(0, 1), a2 + hstep, voffA);
            PG8_WAIT_L(8); PG8_BAR; PG8_WAIT_L(0); PG8_MMA(0, 0, At, B0); PG8_BAR; PG8_SCHED;
            PG8_LDB(B1, 1, 1); PG8_STAGE(PG8_SB(1, 0), b3, voffB);
            PG8_BAR; PG8_WAIT_L(0); PG8_MMA(0, 1, At, B1); PG8_BAR;
            PG8_LDA(At, 1, 1); PG8_STAGE(PG8_SA(1, 0), a3, voffA);
            PG8_BAR; PG8_WAIT_L(0); PG8_MMA(1, 0, At, B0); PG8_BAR; PG8_SCHED;
            PG8_STAGE(PG8_SB(1, 1), b3 + hstep, voffB);
            PG8_WAIT_V(6); PG8_BAR; PG8_MMA(1, 1, At, B1); PG8_BAR;
            }
        }
        if constexpr (ALIGN_EPI) { if (wr == 0) PG8_BAR; }
        if constexpr (!Epi::AFTER_DRAIN) { E(acc, cur, wr, wc, fr, fq); S.done(cur); }
        if (!has_next) break;
#pragma unroll
        for (int a = 0; a < 2; ++a)
#pragma unroll
            for (int b = 0; b < 2; ++b)
#pragma unroll
                for (int m = 0; m < 4; ++m)
#pragma unroll
                    for (int n = 0; n < 2; ++n) acc[a][b][m][n] = (f32x4){0.f, 0.f, 0.f, 0.f};
        cur = nxt; cA = nA; cB = nB; ++ui;
        if constexpr (ALIGN_EPI) { if (wr == 1) PG8_BAR; }
    }
    PG8_WAIT_V(0);
    if constexpr (!ALIGN_EPI) { if (wr == 0) PG8_BAR; }
    PG8_BAR;
    if constexpr (Epi::AFTER_DRAIN) { E.fused(acc, cur, wr, wc, fr, fq, lds, wid, lane); S.done(cur); }
#undef PG8_SA
#undef PG8_SB
#undef PG8_STAGE
#undef PG8_LDA
#undef PG8_LDB
#undef PG8_MMA
#undef PG8_WAIT_V
#undef PG8_WAIT_L
#undef PG8_BAR
#undef PG8_SCHED
}
}

constexpr int NB = 8, SEQ = 4096, DM = 1024, CTXL = 256;
constexpr int MLAT = NB * SEQ, MCTX = NB * CTXL, MALL = MLAT + MCTX;
constexpr int DH = 512, NHY = 1536, NGL = 1792, NINP = NHY + NGL, NIN = 3104, FF = 4096;
constexpr int GQ = 0, GK = 256, GV = 512, GOG = 1024, GGF = 1536;
constexpr int NSIG = 68, NITEM = NB * 4 * 2 * NSIG;
constexpr float EPSF = 1e-6f;
constexpr int MOD_SH1 = 0, MOD_SC1 = 1024, MOD_G1 = 2048, MOD_SH2 = 3072, MOD_SC2 = 4096, MOD_G2 = 5120, MODW = 6144;

constexpr size_t MiB = 1u << 20;
constexpr size_t WS_CTL = 0, WS_MOD = 1 * MiB, WS_SSQ = 2 * MiB, WS_WIN = 4 * MiB, WS_WOUT = 11 * MiB, WS_W1 = 13 * MiB, WS_W2 = 21 * MiB;
constexpr size_t WS_KRAW = 30 * MiB, WS_DEC = 46 * MiB, WS_XN = 48 * MiB  , WS_HYT = 116 * MiB, WS_GPROJ = 212 * MiB;
constexpr size_t WS_YT = 331 * MiB, WS_YCAT = 363 * MiB, WS_HID = 116 * MiB  , WS_END = 427 * MiB;
static_assert(WS_WIN + (size_t)NINP * DM * 2 <= WS_WOUT && WS_W2 + (size_t)DM * FF * 2 <= WS_KRAW && WS_KRAW + (size_t)DH * 8192 * 4 <= WS_DEC, "ws map 1");
static_assert(WS_DEC + (size_t)NITEM * 64 * 4 <= WS_XN && WS_XN + (size_t)MALL * DM * 2 <= WS_HYT && WS_XN + (size_t)NITEM * 8192 * 2 <= WS_HYT, "ws map 2");
static_assert(WS_HYT + (size_t)NHY * MLAT * 2 <= WS_GPROJ && WS_GPROJ + (size_t)MALL * NGL * 2 <= WS_YT && WS_YT + (size_t)DH * MLAT * 2 <= WS_YCAT, "ws map 3");
static_assert(WS_HID + (size_t)MLAT * FF * 2 <= WS_YCAT + (size_t)MLAT * DM * 2 && WS_YCAT + (size_t)MLAT * DM * 2 <= WS_END, "ws map 4");

constexpr int NTHR = 512, NWAVES = 8;
constexpr int LDS_BYTES = 147456;

#define LAS __attribute__((address_space(3)))
typedef unsigned short bf16;
typedef unsigned v4u __attribute__((ext_vector_type(4)));
typedef unsigned v2u __attribute__((ext_vector_type(2)));
typedef float f32x4 __attribute__((ext_vector_type(4)));
#define LDS_WAIT() asm volatile("s_waitcnt lgkmcnt(0)" ::: "memory")

__device__ __forceinline__ unsigned f2bf(float f) { unsigned u = __builtin_bit_cast(unsigned, f); return (u + 0x7fffu + ((u >> 16) & 1u)) >> 16; }
__device__ __forceinline__ unsigned pk2(float lo, float hi) { return f2bf(lo) | (f2bf(hi) << 16); }
__device__ __forceinline__ float bf2f(unsigned h) { return __builtin_bit_cast(float, h << 16); }
__device__ __forceinline__ float wave_sum(float v) {
#pragma unroll
    for (int o = 1; o < 64; o <<= 1) v += __shfl_xor(v, o);
    return v;
}
__device__ __forceinline__ float siluf(float v) { return v / (1.f + __expf(-v)); }
__device__ __forceinline__ float logsigmoidf(float a) { return fminf(a, 0.f) - log1pf(__expf(-fabsf(a))); }

struct Args { const float* in[29]; float* out; unsigned char* ws; int ph_lo, ph_hi; };

enum { I_X = 0, I_C, I_CTX, I_CCTX, I_WADA, I_BADA, I_NMIX, I_NMLP, I_WIN, I_CONVW, I_CONVB, I_FW1, I_FB1, I_FW2, I_FB2, I_FW3, I_FB3, I_FFREQ, I_FWOUT,
       I_HBIAS, I_GKWF, I_GKBF, I_GKWB, I_GKBB, I_GLAN, I_WOUT, I_WM1, I_WM2, I_NFIN };

__device__ __forceinline__ void p0_transpose_item(const float* W, int K, int N, bf16* WT, int row_off, float* scr, int item, int lane) {
    const int nblk = N / 32, kb = item / nblk, nb = item % nblk, k0 = 64 * kb, n0 = 32 * nb;
#pragma unroll 8
    for (int i = 0; i < 32; ++i) { const int kk = 2 * i + (lane >> 5); scr[kk * 33 + (lane & 31)] = W[(size_t)(k0 + kk) * N + n0 + (lane & 31)]; }
    LDS_WAIT(); asm volatile("" ::: "memory");
    const int c = lane & 7;
#pragma unroll
    for (int j = 0; j < 4; ++j) { const int n = (lane >> 3) + 8 * j; const float* s = scr + (8 * c) * 33 + n;
        v4u o; o.x = pk2(s[0 * 33], s[1 * 33]); o.y = pk2(s[2 * 33], s[3 * 33]); o.z = pk2(s[4 * 33], s[5 * 33]); o.w = pk2(s[6 * 33], s[7 * 33]);
        *(v4u*)(WT + (size_t)(row_off + n0 + n) * K + k0 + 8 * c) = o; }
    LDS_WAIT(); asm volatile("" ::: "memory");
}

__device__ __forceinline__ void p0_filter(const Args& a, unsigned char* lds) {
    float* zb = (float*)lds;
    float* h1 = zb + 16 * 33;
    float* h2 = h1 + 16 * 64;
    const int tid = threadIdx.x;
    float* Kraw = (float*)(a.ws + WS_KRAW); float* SSQ = (float*)(a.ws + WS_SSQ);
    const float* w1 = a.in[I_FW1]; const float* b1 = a.in[I_FB1]; const float* w2 = a.in[I_FW2]; const float* b2 = a.in[I_FB2];
    const float* w3 = a.in[I_FW3]; const float* b3 = a.in[I_FB3]; const float* fr = a.in[I_FFREQ]; const float* wo = a.in[I_FWOUT];
    for (int pg = blockIdx.x; pg < 256; pg += gridDim.x) {
        const int p0 = pg * 16;
        for (int i = tid; i < 16 * 33; i += NTHR) { const int pp = i / 33, j = i % 33; const int p = p0 + pp; float val;
            if (j == 0) val = (float)p * (1.0f / 4095.0f);
            else { const int bi = (j - 1) & 15; const float f = 1e-4f + (float)bi * ((15.0f - 1e-4f) / 15.0f); const float w = 6.283185307179586f * (float)p / 4096.0f; const float ang = w * f;
                   val = (j <= 16) ? cosf(ang) : -sinf(ang); }
            zb[i] = val; }
        __syncthreads();
        for (int i = tid; i < 1024; i += NTHR) { const int pp = i >> 6, j = i & 63; float acc = b1[j];
            for (int k = 0; k < 33; ++k) acc += zb[pp * 33 + k] * w1[k * 64 + j];
            h1[i] = sinf(fr[j] * acc); }
        __syncthreads();
        for (int i = tid; i < 1024; i += NTHR) { const int pp = i >> 6, j = i & 63; float acc = b2[j];
            for (int k = 0; k < 64; ++k) acc += h1[pp * 64 + k] * w2[k * 64 + j];
            h2[i] = sinf(fr[j] * acc); }
        __syncthreads();
        for (int i = tid; i < 1024; i += NTHR) { const int pp = i >> 6, j = i & 63; float acc = b3[j];
            for (int k = 0; k < 64; ++k) acc += h2[pp * 64 + k] * w3[k * 64 + j];
            h1[i] = sinf(fr[j] * acc); }
        __syncthreads();
        for (int dir = 0; dir < 2; ++dir) { const int c = tid, o = dir * 512 + c; float acc[16];
#pragma unroll
            for (int pp = 0; pp < 16; ++pp) acc[pp] = 0.f;
            for (int j = 0; j < 64; ++j) { const float w = wo[j * 1024 + o];
#pragma unroll
                for (int pp = 0; pp < 16; ++pp) acc[pp] += h1[pp * 64 + j] * w; }
            const float delta = 3.0701134573253945f + (float)c * ((15.350567286626972f - 3.0701134573253945f) / 511.0f); float ssq = 0.f;
#pragma unroll
            for (int pp = 0; pp < 16; ++pp) { const int p = p0 + pp; const float tn = (float)p * (1.0f / 4095.0f); const float val = acc[pp] * expf(-tn * delta);
                if (dir == 0) { Kraw[(size_t)c * 8192 + 4096 + p] = val; ssq += val * val; }
                else if (p >= 1) { Kraw[(size_t)c * 8192 + 4096 - p] = val; ssq += val * val; } }
            SSQ[pg * 1024 + o] = ssq;
            if (pg == 0 && dir == 0) Kraw[(size_t)c * 8192] = 0.f; }
        __syncthreads();
    }
}

__device__ __forceinline__ void p0_mod(const Args& a, unsigned char* lds) {
    float* sc = (float*)lds;
    float* red = sc + 9 * 1024;
    const int tid = threadIdx.x;
    if ((int)blockIdx.x >= 192) return;
    for (int i = tid; i < 9 * 1024; i += NTHR) { const float v = (i < 8192) ? a.in[I_C][i] : a.in[I_CCTX][i - 8192]; sc[i] = siluf(v); }
    __syncthreads();
    const float* wa = a.in[I_WADA]; const float* ba = a.in[I_BADA]; float* mod = (float*)(a.ws + WS_MOD);
    for (int it = blockIdx.x; it < 192; it += gridDim.x) {
        const int col = tid & 31, ks = tid >> 5, c0 = it * 32; float acc[9];
#pragma unroll
        for (int r = 0; r < 9; ++r) acc[r] = 0.f;
#pragma unroll 4
        for (int k = ks * 64; k < ks * 64 + 64; ++k) { const float w = wa[(size_t)k * MODW + c0 + col];
#pragma unroll
            for (int r = 0; r < 9; ++r) acc[r] += sc[r * 1024 + k] * w; }
#pragma unroll
        for (int r = 0; r < 9; ++r) red[(ks * 9 + r) * 32 + col] = acc[r];
        __syncthreads();
        if (tid < 288) { const int r = tid >> 5, cc = tid & 31; float s = ba[c0 + cc];
            for (int k2 = 0; k2 < 16; ++k2) s += red[(k2 * 9 + r) * 32 + cc];
            mod[r * MODW + c0 + cc] = s; }
        __syncthreads();
    }
}

__device__ __forceinline__ void p0_prologue(const Args& a, unsigned char* lds) {
    const int tid = threadIdx.x, lane = tid & 63, wave = tid >> 6;
    p0_filter(a, lds);
    __syncthreads();
    p0_mod(a, lds);
    __syncthreads();
    { v4u* z = (v4u*)((bf16*)(a.ws + WS_WIN) + (size_t)NIN * DM); const int n16 = (NINP - NIN) * DM * 2 / 16;
      for (int i = blockIdx.x * NTHR + tid; i < n16; i += gridDim.x * NTHR) z[i] = (v4u){0u, 0u, 0u, 0u}; }
    float* scr = (float*)(lds + wave * 16384);
    const int gw = blockIdx.x * NWAVES + wave, NGW = gridDim.x * NWAVES;
    constexpr int I_IN = (DM / 64) * (NIN / 32), I_O = (DM / 64) * (DM / 32), I_1 = (DM / 64) * (FF / 32), I_2 = (FF / 64) * (DM / 32);
    constexpr int NITEMS = I_IN + I_O + I_1 + I_2;
    for (int it = gw; it < NITEMS; it += NGW) {
        int r = it;
        if (r < I_IN) { p0_transpose_item(a.in[I_WIN], DM, NIN, (bf16*)(a.ws + WS_WIN), 0, scr, r, lane); continue; } r -= I_IN;
        if (r < I_O) { p0_transpose_item(a.in[I_WOUT], DM, DM, (bf16*)(a.ws + WS_WOUT), 0, scr, r, lane); continue; } r -= I_O;
        if (r < I_1) { p0_transpose_item(a.in[I_WM1], DM, FF, (bf16*)(a.ws + WS_W1), 0, scr, r, lane); continue; } r -= I_1;
        p0_transpose_item(a.in[I_WM2], FF, DM, (bf16*)(a.ws + WS_W2), 0, scr, r, lane);
    }
}

__device__ __forceinline__ void norm_mod_rows(const Args& a, const float* src_lat, const float* src_ctx, int nrows, const float* g, int sc_off, int sh_off, bf16* dst) {
    const int tid = threadIdx.x, lane = tid & 63, wave = tid >> 6;
    const int gw = blockIdx.x * NWAVES + wave, NGW = gridDim.x * NWAVES;
    const float* mod = (const float*)(a.ws + WS_MOD);
    for (int row = gw; row < nrows; row += NGW) {
        const float* src = row < MLAT ? src_lat + (size_t)row * DM : src_ctx + (size_t)(row - MLAT) * DM;
        const int mrow = row < MLAT ? row / SEQ : 8;
        const f32x4* xr = (const f32x4*)src + lane;
        f32x4 v[4]; float s = 0.f;
#pragma unroll
        for (int j = 0; j < 4; ++j) { v[j] = xr[64 * j]; s += (v[j].x * v[j].x + v[j].y * v[j].y) + (v[j].z * v[j].z + v[j].w * v[j].w); }
        const float rstd = rsqrtf(wave_sum(s) * (1.f / DM) + EPSF);
        unsigned long long* o8 = (unsigned long long*)(dst + (size_t)row * DM) + lane;
#pragma unroll
        for (int j = 0; j < 4; ++j) { const int col = 256 * j + 4 * lane;
            const f32x4 gg = *(const f32x4*)(g + col), scv = *(const f32x4*)(mod + mrow * MODW + sc_off + col), shv = *(const f32x4*)(mod + mrow * MODW + sh_off + col);
            const f32x4 y = (v[j] * rstd * gg) * (scv + 1.f) + shv;
            o8[64 * j] = (unsigned long long)pk2(y.x, y.y) | ((unsigned long long)pk2(y.z, y.w) << 32); }
    }
}
__device__ __forceinline__ void final_norm_rows(const Args& a) {
    const int tid = threadIdx.x, lane = tid & 63, wave = tid >> 6;
    const int gw = blockIdx.x * NWAVES + wave, NGW = gridDim.x * NWAVES;
    const float* g = a.in[I_NFIN];
    for (int row = gw; row < MLAT; row += NGW) {
        f32x4* xr = (f32x4*)(a.out + (size_t)row * DM) + lane;
        f32x4 v[4]; float s = 0.f;
#pragma unroll
        for (int j = 0; j < 4; ++j) { v[j] = xr[64 * j]; s += (v[j].x * v[j].x + v[j].y * v[j].y) + (v[j].z * v[j].z + v[j].w * v[j].w); }
        const float rstd = rsqrtf(wave_sum(s) * (1.f / DM) + EPSF);
#pragma unroll
        for (int j = 0; j < 4; ++j) { const f32x4 gg = *(const f32x4*)(g + 256 * j + 4 * lane); xr[64 * j] = v[j] * rstd * gg; }
    }
}

constexpr int L_GR = 0, L_WG = 1024, L_BG = 2048, L_TOT = 2112, L_BC = 2176, L_KE = L_BC + 4096, L_KI = L_KE + 64 * 65, L_ATT = L_KI + 64 * 65, L_V = L_ATT + 64 * 65, L_S = L_V + 64 * 128, L_END = L_S + 128 * 65;
static_assert(L_END * 4 <= LDS_BYTES, "GLA LDS map");

__device__ __forceinline__ void gla_gate_cumsum(const Args& a, float* L, const bf16* gp, size_t row0, int h, int dir) {
    const int tid = threadIdx.x;
    const float* gkw = a.in[dir ? I_GKWB : I_GKWF]; const float* gkb = a.in[dir ? I_GKBB : I_GKBF];
    for (int i = tid; i < 1024; i += NTHR) { const int tok = i >> 4, r = i & 15; L[L_GR + i] = bf2f(gp[(row0 + tok) * NGL + GGF + dir * 16 + r]); }
    for (int i = tid; i < 1024; i += NTHR) { const int r = i >> 6, d = i & 63; L[L_WG + i] = gkw[r * 256 + h * 64 + d]; }
    if (tid < 64) L[L_BG + tid] = gkb[h * 64 + tid];
    __syncthreads();
    for (int i = tid; i < 4096; i += NTHR) { const int tok = i >> 6, d = i & 63; float acc = L[L_BG + d];
#pragma unroll
        for (int r = 0; r < 16; ++r) acc += L[L_GR + tok * 16 + r] * L[L_WG + r * 64 + d];
        L[L_BC + i] = logsigmoidf(acc) * (1.0f / 16.0f); }
    __syncthreads();
    if (tid < 64) { float run = 0.f;
        if (dir == 0) { for (int tok = 0; tok < 64; ++tok) { run += L[L_BC + tok * 64 + tid]; L[L_BC + tok * 64 + tid] = run; } }
        else { for (int tok = 63; tok >= 0; --tok) { run += L[L_BC + tok * 64 + tid]; L[L_BC + tok * 64 + tid] = run; } }
        L[L_TOT + tid] = run; }
    __syncthreads();
}

__device__ __forceinline__ size_t gla_chunk_row0(int b, int dir, int sig) {
    if (sig < 4) { const int cc = dir == 0 ? sig : 3 - sig; return (size_t)MLAT + b * CTXL + cc * 64; }
    const int n = dir == 0 ? sig - 4 : 67 - sig; return (size_t)b * SEQ + n * 64;
}

__device__ __forceinline__ void gla_local(const Args& a, unsigned char* lds) {
    float* L = (float*)lds; const int tid = threadIdx.x;
    const bf16* gp = (const bf16*)(a.ws + WS_GPROJ); bf16* ST = (bf16*)(a.ws + WS_XN); float* DEC = (float*)(a.ws + WS_DEC);
    for (int item = blockIdx.x; item < NITEM; item += gridDim.x) {
        const int sig = item % NSIG, chain = item / NSIG, dir = chain & 1, h = (chain >> 1) & 3, b = chain >> 3;
        const size_t row0 = gla_chunk_row0(b, dir, sig);
        gla_gate_cumsum(a, L, gp, row0, h, dir);
        for (int i = tid; i < 4096; i += NTHR) { const int tok = i >> 6, d = i & 63;
            L[L_KE + tok * 65 + d] = bf2f(gp[(row0 + tok) * NGL + GK + h * 64 + d]) * __expf(L[L_TOT + d] - L[L_BC + i]); }
        for (int i = tid; i < 8192; i += NTHR) { const int tok = i >> 7, e = i & 127; L[L_V + i] = bf2f(gp[(row0 + tok) * NGL + GV + h * 128 + e]); }
        __syncthreads();
        { const int d = tid & 63, e0 = (tid >> 6) * 16; float acc[16];
#pragma unroll
          for (int i = 0; i < 16; ++i) acc[i] = 0.f;
          for (int tok = 0; tok < 64; ++tok) { const float ke = L[L_KE + tok * 65 + d];
#pragma unroll
              for (int i = 0; i < 16; ++i) acc[i] += L[L_V + tok * 128 + e0 + i] * ke; }
#pragma unroll
          for (int i = 0; i < 16; ++i) ST[(size_t)item * 8192 + (e0 + i) * 64 + d] = (bf16)f2bf(acc[i]);
          if (tid < 64) DEC[item * 64 + tid] = __expf(L[L_TOT + tid]); }
        __syncthreads();
    }
}

__device__ __forceinline__ void gla_scan(const Args& a) {
    bf16* ST = (bf16*)(a.ws + WS_XN); const float* DEC = (const float*)(a.ws + WS_DEC);
    for (int w = blockIdx.x * NTHR + threadIdx.x; w < 64 * 1024; w += gridDim.x * NTHR) {
        const int chain = w >> 10, el = (w & 1023) * 8, d0 = el & 63; float s[8];
#pragma unroll
        for (int i = 0; i < 8; ++i) s[i] = 0.f;
#pragma unroll 4
        for (int sig = 0; sig < NSIG; ++sig) { const size_t item = (size_t)chain * NSIG + sig;
            v4u* p = (v4u*)(ST + item * 8192 + el); const v4u dsv = *p;
            const f32x4 d0v = *(const f32x4*)(DEC + item * 64 + d0), d1v = *(const f32x4*)(DEC + item * 64 + d0 + 4);
            v4u o; o.x = pk2(s[0], s[1]); o.y = pk2(s[2], s[3]); o.z = pk2(s[4], s[5]); o.w = pk2(s[6], s[7]); *p = o;
            s[0] = d0v.x * s[0] + bf2f(dsv.x & 0xffffu); s[1] = d0v.y * s[1] + bf2f(dsv.x >> 16);
            s[2] = d0v.z * s[2] + bf2f(dsv.y & 0xffffu); s[3] = d0v.w * s[3] + bf2f(dsv.y >> 16);
            s[4] = d1v.x * s[4] + bf2f(dsv.z & 0xffffu); s[5] = d1v.y * s[5] + bf2f(dsv.z >> 16);
            s[6] = d1v.z * s[6] + bf2f(dsv.w & 0xffffu); s[7] = d1v.w * s[7] + bf2f(dsv.w >> 16); }
    }
}

__device__ __forceinline__ void gla_out(const Args& a, unsigned char* lds) {
    float* L = (float*)lds; const int tid = threadIdx.x, lane = tid & 63, wave = tid >> 6;
    const bf16* gp = (const bf16*)(a.ws + WS_GPROJ); const bf16* ST = (const bf16*)(a.ws + WS_XN); bf16* ycat = (bf16*)(a.ws + WS_YCAT);
    const float* gn = a.in[I_GLAN];
    for (int it = blockIdx.x; it < NB * 4 * 64; it += gridDim.x) {
        const int n = it & 63, h = (it >> 6) & 3, b = it >> 8; const size_t row0 = (size_t)b * SEQ + n * 64;
        const int e = tid & 127, c0 = (tid >> 7) * 16; float o[16];
#pragma unroll
        for (int i = 0; i < 16; ++i) o[i] = 0.f;
        for (int dir = 0; dir < 2; ++dir) {
            gla_gate_cumsum(a, L, gp, row0, h, dir);
            const int sig = dir == 0 ? n + 4 : 67 - n; const size_t item = (size_t)((b * 4 + h) * 2 + dir) * NSIG + sig;
            for (int i = tid; i < 4096; i += NTHR) { const int tok = i >> 6, d = i & 63; const float bc = L[L_BC + i];
                L[L_KE + tok * 65 + d] = bf2f(gp[(row0 + tok) * NGL + GQ + h * 64 + d]) * 0.125f * __expf(bc);
                L[L_KI + tok * 65 + d] = bf2f(gp[(row0 + tok) * NGL + GK + h * 64 + d]) * __expf(-bc); }
            if (dir == 0) for (int i = tid; i < 8192; i += NTHR) { const int tok = i >> 7, ee = i & 127; L[L_V + i] = bf2f(gp[(row0 + tok) * NGL + GV + h * 128 + ee]); }
            for (int i = tid; i < 8192; i += NTHR) { const int ee = i >> 6, d = i & 63; L[L_S + ee * 65 + d] = bf2f(ST[item * 8192 + i]); }
            __syncthreads();
            { const int s = tid & 63, ca = (tid >> 6) * 8; float acc[8];
#pragma unroll
              for (int i = 0; i < 8; ++i) acc[i] = 0.f;
              for (int d = 0; d < 64; ++d) { const float ki = L[L_KI + s * 65 + d];
#pragma unroll
                  for (int i = 0; i < 8; ++i) acc[i] += L[L_KE + (ca + i) * 65 + d] * ki; }
#pragma unroll
              for (int i = 0; i < 8; ++i) { const int c = ca + i; const bool keep = dir == 0 ? (s <= c) : (s >= c); L[L_ATT + c * 65 + s] = keep ? acc[i] : 0.f; } }
            __syncthreads();
            for (int s = 0; s < 64; ++s) { const float vv = L[L_V + s * 128 + e];
#pragma unroll
                for (int i = 0; i < 16; ++i) o[i] += L[L_ATT + (c0 + i) * 65 + s] * vv; }
            for (int d = 0; d < 64; ++d) { const float sv = L[L_S + e * 65 + d];
#pragma unroll
                for (int i = 0; i < 16; ++i) o[i] += L[L_KE + (c0 + i) * 65 + d] * sv; }
            __syncthreads();
        }
        float* OB = L + L_KE;
#pragma unroll
        for (int i = 0; i < 16; ++i) OB[(c0 + i) * 128 + e] = o[i];
        __syncthreads();
        for (int j = 0; j < 8; ++j) { const int c = wave * 8 + j; const float v0 = OB[c * 128 + lane], v1 = OB[c * 128 + 64 + lane];
            const float rstd = rsqrtf(wave_sum(v0 * v0 + v1 * v1) * (1.f / 128.f) + EPSF);
            const size_t row = row0 + c;
            const float g0 = bf2f(gp[row * NGL + GOG + h * 128 + lane]), g1 = bf2f(gp[row * NGL + GOG + h * 128 + 64 + lane]);
            ycat[row * DM + DH + h * 128 + lane] = (bf16)f2bf(v0 * rstd * gn[lane] * siluf(g0));
            ycat[row * DM + DH + h * 128 + 64 + lane] = (bf16)f2bf(v1 * rstd * gn[64 + lane] * siluf(g1)); }
        __syncthreads();
    }
}

__device__ __forceinline__ float hy_sconv(const bf16* hyT, int ch, int col, float w0, float w1, float w2, float cb) {
    const int tt = col & 63; const bf16* p = hyT + (size_t)ch * MLAT + col;
    const float h0 = bf2f(p[0]), hm = tt > 0 ? bf2f(p[-1]) : 0.f, hp = tt < 63 ? bf2f(p[1]) : 0.f;
    return cb + w0 * hm + w1 * h0 + w2 * hp;
}
__device__ __forceinline__ void hyena_conv(const Args& a, unsigned char* lds) {
    float* KL = (float*)lds;
    bf16* Z = (bf16*)(lds + 32768);
    float* RED = (float*)(lds + 32768 + 65536);
    const int tid = threadIdx.x, lane = tid & 63, wave = tid >> 6;
    const bf16* hyT = (const bf16*)(a.ws + WS_HYT); bf16* yT = (bf16*)(a.ws + WS_YT);
    const float* Kraw = (const float*)(a.ws + WS_KRAW); const float* SSQ = (const float*)(a.ws + WS_SSQ);
    const float* cw = a.in[I_CONVW]; const float* cbv = a.in[I_CONVB];
    for (int c = blockIdx.x; c < DH; c += gridDim.x) {
        { const float part = SSQ[(tid >> 1) * 1024 + (tid & 1) * 512 + c]; const float ws = wave_sum(part); if (lane == 0) RED[wave] = ws; }
        __syncthreads();
        float tot = 0.f;
#pragma unroll
        for (int i = 0; i < 8; ++i) tot += RED[i];
        const float sc = rsqrtf(tot + EPSF);
        for (int i = tid; i < 8192; i += NTHR) KL[i] = Kraw[(size_t)c * 8192 + i] * sc;
        { const int c1 = DH + c, c2 = 2 * DH + c;
          const float a0 = cw[c1], a1 = cw[NHY + c1], a2 = cw[2 * NHY + c1], ab = cbv[c1], b0 = cw[c2], b1 = cw[NHY + c2], b2 = cw[2 * NHY + c2], bb = cbv[c2];
          for (int i = tid; i < MLAT; i += NTHR) Z[i] = (bf16)f2bf(hy_sconv(hyT, c1, i, a0, a1, a2, ab) * hy_sconv(hyT, c2, i, b0, b1, b2, bb)); }
        __syncthreads();
        float acc[8][8];
#pragma unroll
        for (int j = 0; j < 8; ++j)
#pragma unroll
            for (int b = 0; b < 8; ++b) acc[j][b] = 0.f;
        const unsigned* Z2 = (const unsigned*)Z;
        for (int s2 = 0; s2 < 2048; ++s2) { float zl[8], zh[8];
#pragma unroll
            for (int b = 0; b < 8; ++b) { const unsigned zz = Z2[b * 2048 + s2]; zl[b] = bf2f(zz & 0xffffu); zh[b] = bf2f(zz >> 16); }
#pragma unroll
            for (int j = 0; j < 8; ++j) { const int base = tid + 512 * j - 2 * s2 + 4096; const float k0 = KL[base], k1 = KL[base - 1];
#pragma unroll
                for (int b = 0; b < 8; ++b) acc[j][b] += k0 * zl[b] + k1 * zh[b]; } }
        { const float w0 = cw[c], w1 = cw[NHY + c], w2 = cw[2 * NHY + c], wb = cbv[c], hb = a.in[I_HBIAS][c];
#pragma unroll
          for (int j = 0; j < 8; ++j)
#pragma unroll
              for (int b = 0; b < 8; ++b) { const int col = b * SEQ + tid + 512 * j; const float x0 = hy_sconv(hyT, c, col, w0, w1, w2, wb);
                  yT[(size_t)c * MLAT + col] = (bf16)f2bf(x0 * (acc[j][b] + hb * bf2f(Z[col]))); } }
        __syncthreads();
    }
}
typedef short hbf16x8 __attribute__((ext_vector_type(8)));
typedef float hf32x16 __attribute__((ext_vector_type(16)));
constexpr int HK_COPYB = 16448, HK_OFF = 0, HZ_OFF = 4 * HK_COPYB, HZ_ROWB = 8208, HZERO_OFF = HZ_OFF + 8 * HZ_ROWB, HRED_OFF = HZERO_OFF + 64;
static_assert(HRED_OFF + 64 <= LDS_BYTES && 8 * HZ_ROWB <= 4 * HK_COPYB, "hyena LDS map");
__device__ __forceinline__ void hy_unpack8(const v4u r, float* o) {
    o[0] = bf2f(r.x & 0xffffu); o[1] = bf2f(r.x >> 16); o[2] = bf2f(r.y & 0xffffu); o[3] = bf2f(r.y >> 16);
    o[4] = bf2f(r.z & 0xffffu); o[5] = bf2f(r.z >> 16); o[6] = bf2f(r.w & 0xffffu); o[7] = bf2f(r.w >> 16);
}
__device__ __forceinline__ void hyena_conv_mfma(const Args& a, unsigned char* lds) {
    LAS unsigned char* L = (LAS unsigned char*)lds;
    const int tid = threadIdx.x, lane = tid & 63, wave = __builtin_amdgcn_readfirstlane(tid >> 6), r = lane & 31, h = lane >> 5;
    const bf16* hyT = (const bf16*)(a.ws + WS_HYT); bf16* yT = (bf16*)(a.ws + WS_YT);
    const float* Kraw = (const float*)(a.ws + WS_KRAW); const float* SSQ = (const float*)(a.ws + WS_SSQ);
    const float* cw = a.in[I_CONVW]; const float* cbv = a.in[I_CONVB];
    LAS float* RED = (LAS float*)(L + HRED_OFF);
    for (int c = blockIdx.x; c < DH; c += gridDim.x) {
        { const float part = SSQ[(tid >> 1) * 1024 + (tid & 1) * 512 + c]; const float ws = wave_sum(part); if (lane == 0) RED[wave] = ws; }
        __syncthreads();
        float tot = 0.f;
#pragma unroll
        for (int i = 0; i < 8; ++i) tot += RED[i];
        const float sc = rsqrtf(tot + EPSF);
        for (int idx = tid; idx < 4 * 4096; idx += NTHR) { const int s = idx >> 12, y = (idx & 4095) * 2, x = y + s;
            const float v0 = (x >= 1 && x <= 8191) ? Kraw[(size_t)c * 8192 + 8192 - x] * sc : 0.f;
            const float v1 = (x + 1 <= 8191) ? Kraw[(size_t)c * 8192 + 8191 - x] * sc : 0.f;
            *(LAS unsigned*)(L + HK_OFF + s * HK_COPYB + 2 * y) = pk2(v0, v1); }
        if (tid < 4) ((LAS unsigned*)(L + HZERO_OFF))[tid] = 0u;
        { const int c1 = DH + c, c2 = 2 * DH + c;
          const float a0 = cw[c1], a1 = cw[NHY + c1], a2 = cw[2 * NHY + c1], ab = cbv[c1], b0 = cw[c2], b1 = cw[NHY + c2], b2 = cw[2 * NHY + c2], bb = cbv[c2];
          for (int gi = tid; gi < 4096; gi += NTHR) { const int b = gi >> 9, t0 = (gi & 511) * 8, col = b * SEQ + t0;
              const bf16* p1 = hyT + (size_t)c1 * MLAT + col; const bf16* p2 = hyT + (size_t)c2 * MLAT + col;
              float u[10], w[10];
              hy_unpack8(*(const v4u*)p1, u + 1); hy_unpack8(*(const v4u*)p2, w + 1);
              const bool hl = (t0 & 63) != 0, hr = ((t0 + 8) & 63) != 0;
              u[0] = hl ? bf2f(p1[-1]) : 0.f; w[0] = hl ? bf2f(p2[-1]) : 0.f; u[9] = hr ? bf2f(p1[8]) : 0.f; w[9] = hr ? bf2f(p2[8]) : 0.f;
              float z[8];
#pragma unroll
              for (int i = 0; i < 8; ++i) z[i] = (ab + a0 * u[i] + a1 * u[i + 1] + a2 * u[i + 2]) * (bb + b0 * w[i] + b1 * w[i + 1] + b2 * w[i + 2]);
              v4u o; o.x = pk2(z[0], z[1]); o.y = pk2(z[2], z[3]); o.z = pk2(z[4], z[5]); o.w = pk2(z[6], z[7]);
              *(LAS v4u*)(L + HZ_OFF + b * HZ_ROWB + 2 * t0) = o; } }
        __syncthreads();
        hf32x16 acc[2][2];
#pragma unroll
        for (int m = 0; m < 2; ++m)
#pragma unroll
            for (int n = 0; n < 2; ++n)
#pragma unroll
                for (int i = 0; i < 16; ++i) acc[m][n][i] = 0.f;
        const int I0 = 8 * wave, q = r >> 3, b = r & 7, sh = (-r) & 3;
        const int a_lane = HK_OFF + sh * HK_COPYB + 2 * (4096 - r + 8 * h - sh);
        const int b_lane = HZ_OFF + b * HZ_ROWB + 16 * h;
        for (int d = I0 - 63; d <= I0 + 7; ++d) {
            const int J0 = I0 + q - d, J1 = J0 + 4;
            const bool ok0 = (unsigned)J0 < 64u, ok1 = (unsigned)J1 < 64u;
            const int abase = a_lane - 128 * d, bb0 = ok0 ? b_lane + 128 * J0 : HZERO_OFF, bb1 = ok1 ? b_lane + 128 * J1 : HZERO_OFF;
#pragma unroll
            for (int kk = 0; kk < 4; ++kk) {
                hbf16x8 af[2], bf[2];
#pragma unroll
                for (int m = 0; m < 2; ++m) { const int ad = abase - 64 * m + 32 * kk;
                    const v2u lo = *(const LAS v2u*)(L + ad), hi = *(const LAS v2u*)(L + ad + 8);
                    af[m] = __builtin_bit_cast(hbf16x8, (v4u){lo.x, lo.y, hi.x, hi.y}); }
                bf[0] = __builtin_bit_cast(hbf16x8, *(const LAS v4u*)(L + bb0 + (ok0 ? 32 * kk : 0)));
                bf[1] = __builtin_bit_cast(hbf16x8, *(const LAS v4u*)(L + bb1 + (ok1 ? 32 * kk : 0)));
#pragma unroll
                for (int m = 0; m < 2; ++m)
#pragma unroll
                    for (int n = 0; n < 2; ++n) acc[m][n] = __builtin_amdgcn_mfma_f32_32x32x16_bf16(af[m], bf[n], acc[m][n], 0, 0, 0);
            }
        }
        __syncthreads();
        for (int gi = tid; gi < 4096; gi += NTHR) { const int bb = gi >> 9, t0 = (gi & 511) * 8;
            *(LAS v4u*)(L + HK_OFF + bb * HZ_ROWB + 2 * t0) = *(const v4u*)(hyT + (size_t)c * MLAT + bb * SEQ + t0); }
        __syncthreads();
        { const float w0 = cw[c], w1 = cw[NHY + c], w2 = cw[2 * NHY + c], wb = cbv[c], hb = a.in[I_HBIAS][c];
#pragma unroll
          for (int m = 0; m < 2; ++m)
#pragma unroll
              for (int n = 0; n < 2; ++n)
#pragma unroll
                  for (int g = 0; g < 4; ++g) { const int t0 = 64 * (I0 + 4 * n + q) + 32 * m + 8 * g + 4 * h;
                      const LAS bf16* xp = (const LAS bf16*)(L + HK_OFF + b * HZ_ROWB + 2 * t0);
                      const v2u xr = *(const LAS v2u*)xp; const v2u zr = *(const LAS v2u*)(L + HZ_OFF + b * HZ_ROWB + 2 * t0);
                      float xv[6];
                      xv[0] = (t0 & 63) != 0 ? bf2f(xp[-1]) : 0.f; xv[5] = ((t0 + 4) & 63) != 0 ? bf2f(xp[4]) : 0.f;
                      xv[1] = bf2f(xr.x & 0xffffu); xv[2] = bf2f(xr.x >> 16); xv[3] = bf2f(xr.y & 0xffffu); xv[4] = bf2f(xr.y >> 16);
                      const float zv[4] = {bf2f(zr.x & 0xffffu), bf2f(zr.x >> 16), bf2f(zr.y & 0xffffu), bf2f(zr.y >> 16)};
                      float y[4];
#pragma unroll
                      for (int k = 0; k < 4; ++k) y[k] = (wb + w0 * xv[k] + w1 * xv[k + 1] + w2 * xv[k + 2]) * (acc[m][n][4 * g + k] + hb * zv[k]);
                      v2u o; o.x = pk2(y[0], y[1]); o.y = pk2(y[2], y[3]);
                      *(v2u*)(yT + (size_t)c * MLAT + b * SEQ + t0) = o; } }
        __syncthreads();
    }
}
__device__ __forceinline__ void hyena_transpose(const Args& a, unsigned char* lds) {
    const int tid = threadIdx.x, lane = tid & 63, wave = tid >> 6;
    bf16* scr = (bf16*)(lds + wave * 16384);
    const bf16* yT = (const bf16*)(a.ws + WS_YT); bf16* ycat = (bf16*)(a.ws + WS_YCAT);
    const int gw = blockIdx.x * NWAVES + wave, NGW = gridDim.x * NWAVES;
    for (int t = gw; t < (DH / 64) * (MLAT / 64); t += NGW) { const int cb = t & 7, tb = t >> 3, c0 = cb * 64, k0 = tb * 64;
        for (int r = 0; r < 64; ++r) scr[r * 66 + lane] = yT[(size_t)(c0 + r) * MLAT + k0 + lane];
        LDS_WAIT(); asm volatile("" ::: "memory");
        for (int r = 0; r < 64; ++r) ycat[(size_t)(k0 + r) * DM + c0 + lane] = scr[lane * 66 + r];
        LDS_WAIT(); asm volatile("" ::: "memory"); }
}

constexpr int NPHASE = 11;
__global__ void __launch_bounds__(NTHR, 2) fwd_kernel(Args a) {
    extern __shared__ __attribute__((aligned(16))) unsigned char lds[];
    cg::grid_group grid = cg::this_grid();
    const int lo = a.ph_lo, hi = a.ph_hi;
#define IN(k) (lo <= (k) && (k) < hi)
#define SEAM(k) do { if (IN(k) && IN((k) + 1)) grid.sync(); } while (0)
    unsigned char* ws = a.ws;
    PG8_LAS unsigned char* ldsg = (PG8_LAS unsigned char*)lds;
    if (IN(0)) { p0_prologue(a, lds); } SEAM(0);
    if (IN(1)) { norm_mod_rows(a, a.in[I_X], a.in[I_CTX], MALL, a.in[I_NMIX], MOD_SC1, MOD_SH1, (bf16*)(ws + WS_XN)); } SEAM(1);
    if (IN(2)) {
        { pg8::Gemm g{(const pg8::bf16_t*)(ws + WS_WIN), (const pg8::bf16_t*)(ws + WS_XN), NHY, MLAT, DM}; pg8::StaticOrder S; S.init(NHY, MLAT, gridDim.x, blockIdx.x);
          pg8::EpiBf16<0> E{(pg8::bf16_t*)(ws + WS_HYT), MLAT};
          pg8::gemm_phase<pg8::EpiBf16<0>, pg8::StaticOrder, true, true>(ldsg, g, S, E); }
        __syncthreads();
        { pg8::Gemm g{(const pg8::bf16_t*)(ws + WS_XN), (const pg8::bf16_t*)(ws + WS_WIN) + (size_t)NHY * DM, MALL, NGL, DM}; pg8::StaticOrder S; S.init(MALL, NGL, gridDim.x, blockIdx.x);
          pg8::EpiBf16<0> E{(pg8::bf16_t*)(ws + WS_GPROJ), NGL};
          pg8::gemm_phase<pg8::EpiBf16<0>, pg8::StaticOrder, true, true>(ldsg, g, S, E); }
    } SEAM(2);
    if (IN(3)) { gla_local(a, lds); __syncthreads(); hyena_conv_mfma(a, lds); } SEAM(3);
    if (IN(4)) { gla_scan(a); } SEAM(4);
    if (IN(5)) { gla_out(a, lds); __syncthreads(); hyena_transpose(a, lds); } SEAM(5);
    if (IN(6)) { pg8::Gemm g{(const pg8::bf16_t*)(ws + WS_YCAT), (const pg8::bf16_t*)(ws + WS_WOUT), MLAT, DM, DM}; pg8::StaticOrder S; S.init(MLAT, DM, gridDim.x, blockIdx.x);
        pg8::EpiResid E{a.in[I_X], a.out, DM, (const float*)(ws + WS_MOD) + MOD_G1, SEQ, MODW};
        pg8::gemm_phase<pg8::EpiResid, pg8::StaticOrder, true, true>(ldsg, g, S, E); } SEAM(6);
    if (IN(7)) { norm_mod_rows(a, a.out, a.out, MLAT, a.in[I_NMLP], MOD_SC2, MOD_SH2, (bf16*)(ws + WS_XN)); } SEAM(7);
    if (IN(8)) { pg8::Gemm g{(const pg8::bf16_t*)(ws + WS_XN), (const pg8::bf16_t*)(ws + WS_W1), MLAT, FF, DM}; pg8::StaticOrder S; S.init(MLAT, FF, gridDim.x, blockIdx.x);
        pg8::EpiBf16<1> E{(pg8::bf16_t*)(ws + WS_HID), FF};
        pg8::gemm_phase<pg8::EpiBf16<1>, pg8::StaticOrder, true, true>(ldsg, g, S, E); } SEAM(8);
    if (IN(9)) { pg8::Gemm g{(const pg8::bf16_t*)(ws + WS_HID), (const pg8::bf16_t*)(ws + WS_W2), MLAT, DM, FF}; pg8::StaticOrder S; S.init(MLAT, DM, gridDim.x, blockIdx.x);
        pg8::EpiResid E{a.out, a.out, DM, (const float*)(ws + WS_MOD) + MOD_G2, SEQ, MODW};
        pg8::gemm_phase<pg8::EpiResid, pg8::StaticOrder, true, true>(ldsg, g, S, E); } SEAM(9);
    if (IN(10)) { final_norm_rows(a); }
#undef IN
#undef SEAM
}

#ifndef N_LAUNCH_MODE
#define N_LAUNCH_MODE 1
#endif
extern "C" void kernel_launch(void* const* d_in, const int* in_sizes, int n_in, void* d_out, int out_size, void* d_ws, size_t ws_size, hipStream_t stream) {
    static int grid = 0;
    if (grid == 0) {
        if (n_in != 29 || out_size != MLAT * DM || ws_size < WS_END) { fprintf(stderr, "kernel_launch: unexpected shapes (n_in %d out %d ws %zu)\n", n_in, out_size, ws_size); grid = -1; return; }
        int dev = 0, cus = 0, per_cu = 0;
        if (hipGetDevice(&dev) != hipSuccess || hipDeviceGetAttribute(&cus, hipDeviceAttributeMultiprocessorCount, dev) != hipSuccess) { grid = -1; return; }
        if (hipFuncSetAttribute((const void*)fwd_kernel, hipFuncAttributeMaxDynamicSharedMemorySize, LDS_BYTES) != hipSuccess) { fprintf(stderr, "kernel_launch: hipFuncSetAttribute failed\n"); grid = -1; return; }
        if (hipOccupancyMaxActiveBlocksPerMultiprocessor(&per_cu, (const void*)fwd_kernel, NTHR, LDS_BYTES) != hipSuccess || per_cu < 1) { fprintf(stderr, "kernel_launch: occupancy query says %d blocks per CU\n", per_cu); (void)hipGetLastError(); grid = -1; return; }
        grid = cus;
    }
    if (grid < 0) return;
    Args a{};
    for (int i = 0; i < 29; ++i) a.in[i] = (const float*)d_in[i];
    a.out = (float*)d_out; a.ws = (unsigned char*)d_ws;
#if N_LAUNCH_MODE == 0
    for (int p = 0; p < NPHASE; ++p) { a.ph_lo = p; a.ph_hi = p + 1; hipLaunchKernelGGL(fwd_kernel, dim3(grid), dim3(NTHR), LDS_BYTES, stream, a); }
#else
    a.ph_lo = 0; a.ph_hi = NPHASE;
    void* args[] = {&a};
    hipError_t e = hipLaunchCooperativeKernel((const void*)fwd_kernel, dim3(grid), dim3(NTHR), args, LDS_BYTES, stream);
    if (e != hipSuccess) fprintf(stderr, "cooperative launch failed: %s (grid %d)\n", hipGetErrorString(e), grid);
#endif
}
```

```cpp
#include <hip/hip_runtime.h>
#include <hip/hip_cooperative_groups.h>
#include <cstdio>
#include <cstdint>
#include <cmath>
namespace cg = cooperative_groups;
namespace pg8 {
#define PG8_LAS __attribute__((address_space(3)))
typedef unsigned short bf16_t;
typedef short bf16x8 __attribute__((ext_vector_type(8)));
typedef float f32x4 __attribute__((ext_vector_type(4)));
typedef unsigned u32x4 __attribute__((ext_vector_type(4)));
constexpr int BM = 256, BK = 64, HALF = 128, HTB = HALF * BK * 2  , STAGE_BYTES = 8 * HTB, NXCD = 8, WGM = 8;

__host__ __device__ __forceinline__ int lds_byte(int r, int c) { const int st = (r >> 4) * 2 + (c >> 5), rr = r & 15, cc = c & 31, ob = rr * 64 + cc * 2; return st * 1024 + (ob ^ (((ob >> 9) & 1) << 5)); }
__host__ __device__ __forceinline__ void stage_rc(int b, int& R, int& C) { const int st = b / 1024, sb = b % 1024, swz = sb ^ (((sb >> 9) & 1) << 5); R = (st >> 1) * 16 + swz / 64; C = (st & 1) * 32 + (swz % 64) / 2; }
__host__ __device__ __forceinline__ int perm32(int rho) { const int n = rho >> 4, i = rho & 15; return 8 * (i >> 2) + 4 * n + (i & 3); }

struct Unit { int pm, pn; };
struct Gemm { const bf16_t* A; const bf16_t* Bt; int M, N, K; };

struct StaticOrder {
    int nM, nN, nwg, G, c;
    __host__ __device__ void init(int M, int N, int G_, int c_) { nM = M / BM; nN = N / BM; nwg = nM * nN; G = G_; c = c_; }
    __host__ __device__ bool next(int i, Unit& u) const {
        const long L = (long)i * G + c; if (L >= nwg) return false;
        int wgid = (int)L; { const int q = nwg / NXCD, r = nwg % NXCD, xcd = wgid % NXCD, off = wgid / NXCD; wgid = (xcd < r ? xcd * (q + 1) : r * (q + 1) + (xcd - r) * q) + off; }
        const int nig = WGM * nN, gid = wgid / nig, fm = gid * WGM, gsz = (nM - fm) < WGM ? (nM - fm) : WGM;
        u.pm = fm + ((wgid % nig) % gsz); u.pn = (wgid % nig) / gsz; return true;
    }
    __device__ __forceinline__ void a_ready(const Unit&) const {}
    __device__ __forceinline__ void done(const Unit&) const {}
};


__device__ __forceinline__ unsigned cvt_pk_bf16(float lo, float hi) { unsigned r; asm volatile("v_cvt_pk_bf16_f32 %0, %1, %2" : "=v"(r) : "v"(lo), "v"(hi)); return r; }

template <int ACT> struct EpiBf16 {
    static constexpr bool PERM = true, AFTER_DRAIN = false;
    bf16_t* O; int ldc;
    __device__ __forceinline__ void operator()(const f32x4 (&acc)[2][2][4][2], const Unit& u, int wr, int wc, int fr, int fq) const {
        const int row0 = u.pm * BM + wr * 64 + fr; const int col0 = u.pn * BM + wc * 32 + 8 * fq;
#pragma unroll
        for (int ai = 0; ai < 2; ++ai)
#pragma unroll
            for (int m = 0; m < 4; ++m) { bf16_t* rowp = O + (size_t)(row0 + ai * HALF + m * 16) * ldc + col0;
#pragma unroll
                for (int bj = 0; bj < 2; ++bj) { f32x4 v0 = acc[ai][bj][m][0], v1 = acc[ai][bj][m][1];
                    if (ACT == 1) {
#pragma unroll
                        for (int q = 0; q < 4; ++q) { const float a0 = fmaxf(v0[q], 0.f), a1 = fmaxf(v1[q], 0.f); v0[q] = a0 * a0; v1[q] = a1 * a1; } }
                    u32x4 w; w.x = cvt_pk_bf16(v0[0], v0[1]); w.y = cvt_pk_bf16(v0[2], v0[3]); w.z = cvt_pk_bf16(v1[0], v1[1]); w.w = cvt_pk_bf16(v1[2], v1[3]);
                    *(u32x4*)(rowp + bj * HALF) = w; } }
    }
};
struct EpiResid {
    static constexpr bool PERM = false, AFTER_DRAIN = false;
    const float* base; float* out; int ldc; const float* gate; int rows_per_gate; int gate_stride;
    __device__ __forceinline__ void operator()(const f32x4 (&acc)[2][2][4][2], const Unit& u, int wr, int wc, int fr, int fq) const {
        const int row0 = u.pm * BM + wr * 64 + fr, col0 = u.pn * BM + wc * 32 + 4 * fq;
        const float* gp = gate + (size_t)((u.pm * BM) / rows_per_gate) * gate_stride + col0;
        f32x4 gv[2][2];
#pragma unroll
        for (int bj = 0; bj < 2; ++bj)
#pragma unroll
            for (int n = 0; n < 2; ++n) gv[bj][n] = *(const f32x4*)(gp + bj * HALF + n * 16);
#pragma unroll
        for (int ai = 0; ai < 2; ++ai)
#pragma unroll
            for (int m = 0; m < 4; ++m) { const size_t off = (size_t)(row0 + ai * HALF + m * 16) * ldc + col0;
#pragma unroll
                for (int bj = 0; bj < 2; ++bj)
#pragma unroll
                    for (int n = 0; n < 2; ++n) { const f32x4 bs = *(const f32x4*)(base + off + bj * HALF + n * 16);
                        *(f32x4*)(out + off + bj * HALF + n * 16) = bs + gv[bj][n] * acc[ai][bj][m][n]; } }
    }
};

template <class Epi, class Sched, bool ALIGN_EPI = false, bool SP2 = false>
__device__ __forceinline__ void gemm_phase(PG8_LAS unsigned char* lds, const Gemm g, const Sched& S, const Epi& E) {
    const int tid = threadIdx.x, wid = __builtin_amdgcn_readfirstlane(tid >> 6), lane = tid & 63, wr = wid >> 2, wc = wid & 3, fr = lane & 15, fq = lane >> 4;
    const int K = g.K, nt = K / BK;
    unsigned voffA[2], voffB[2];
#pragma unroll
    for (int i = 0; i < 2; ++i) { int R, C; stage_rc(tid * 16 + i * 8192, R, C); const int Rb = Epi::PERM ? ((R & ~31) + perm32(R & 31)) : R;
        voffA[i] = (unsigned)(R * K + C) * 2u; voffB[i] = (unsigned)(Rb * K + C) * 2u; }
    const size_t kstep = (size_t)(BK * 2);
    const size_t hstep = (size_t)HALF * K * 2;
    const size_t tstep = 2 * hstep;
    const unsigned ldsw = (unsigned)wid * 1024u;
    const int aoff = lds_byte(wr * 64 + fr, fq * 8), boff = lds_byte(wc * 32 + fr, fq * 8);
#define PG8_SA(b, h) (((b) * 2 + (h)) * HTB)
#define PG8_SB(b, h) ((4 + (b) * 2 + (h)) * HTB)
#define PG8_STAGE(bufoff, gbase, voff) do { _Pragma("unroll") for (int _i = 0; _i < 2; ++_i) \
        __builtin_amdgcn_global_load_lds((const unsigned*)((const char*)(gbase) + (voff)[_i]), (PG8_LAS unsigned*)(lds + (bufoff) + ldsw + _i * 8192), 16, 0, 0); } while (0)
#define PG8_LDA(dst, b, h) do { _Pragma("unroll") for (int m = 0; m < 4; ++m) _Pragma("unroll") for (int k = 0; k < 2; ++k) dst[m][k] = *(const PG8_LAS bf16x8*)(lds + PG8_SA(b, h) + aoff + m * 2048 + k * 1024); } while (0)
#define PG8_LDB(dst, b, h) do { _Pragma("unroll") for (int n = 0; n < 2; ++n) _Pragma("unroll") for (int k = 0; k < 2; ++k) dst[n][k] = *(const PG8_LAS bf16x8*)(lds + PG8_SB(b, h) + boff + n * 2048 + k * 1024); } while (0)
#define PG8_MMA(ai, bj, At, Bt) do { __builtin_amdgcn_s_setprio(1); _Pragma("unroll") for (int m = 0; m < 4; ++m) _Pragma("unroll") for (int n = 0; n < 2; ++n) _Pragma("unroll") for (int k = 0; k < 2; ++k) \
        acc[ai][bj][m][n] = __builtin_amdgcn_mfma_f32_16x16x32_bf16(Bt[n][k], At[m][k], acc[ai][bj][m][n], 0, 0, 0); __builtin_amdgcn_s_setprio(0); } while (0)
#define PG8_WAIT_V(n) asm volatile("s_waitcnt vmcnt(" #n ")" ::: "memory")
#define PG8_WAIT_L(n) asm volatile("s_waitcnt lgkmcnt(" #n ")" ::: "memory")
#define PG8_BAR __builtin_amdgcn_s_barrier()
#define PG8_SCHED __builtin_amdgcn_sched_barrier(0)
    Unit cur, nxt; int ui = 0;
    if (!S.next(0, cur)) return;
    f32x4 acc[2][2][4][2];
#pragma unroll
    for (int a = 0; a < 2; ++a)
#pragma unroll
        for (int b = 0; b < 2; ++b)
#pragma unroll
            for (int m = 0; m < 4; ++m)
#pragma unroll
                for (int n = 0; n < 2; ++n) acc[a][b][m][n] = (f32x4){0.f, 0.f, 0.f, 0.f};
    bf16x8 At[4][2], B0[2][2], B1[2][2];
    const char* cA = (const char*)g.A + (size_t)cur.pm * tstep; const char* cB = (const char*)g.Bt + (size_t)cur.pn * tstep;
    S.a_ready(cur);
    if constexpr (SP2) {
        PG8_STAGE(PG8_SB(0, 0), cB, voffB); PG8_STAGE(PG8_SB(0, 1), cB + hstep, voffB); PG8_STAGE(PG8_SA(0, 0), cA, voffA); PG8_STAGE(PG8_SA(0, 1), cA + hstep, voffA);
        if (wr == 1) PG8_BAR;
        PG8_WAIT_V(2); PG8_BAR;
        PG8_STAGE(PG8_SB(1, 0), cB + kstep, voffB); PG8_STAGE(PG8_SA(1, 0), cA + kstep, voffA); PG8_STAGE(PG8_SB(1, 1), cB + hstep + kstep, voffB);
        PG8_WAIT_V(6); PG8_BAR;
    } else {
        PG8_STAGE(PG8_SB(0, 0), cB, voffB); PG8_STAGE(PG8_SA(0, 0), cA, voffA); PG8_STAGE(PG8_SB(0, 1), cB + hstep, voffB); PG8_STAGE(PG8_SA(0, 1), cA + hstep, voffA);
        if (wr == 1) PG8_BAR;
        PG8_WAIT_V(4); PG8_BAR;
        PG8_STAGE(PG8_SB(1, 0), cB + kstep, voffB); PG8_STAGE(PG8_SA(1, 0), cA + kstep, voffA); PG8_STAGE(PG8_SB(1, 1), cB + hstep + kstep, voffB);
        PG8_WAIT_V(6); PG8_BAR;
    }
    for (;;) {
        const bool has_next = S.next(ui + 1, nxt);
        const char* nA = has_next ? (const char*)g.A + (size_t)nxt.pm * tstep : cA; const char* nB = has_next ? (const char*)g.Bt + (size_t)nxt.pn * tstep : cB;
        for (int t = 0; t < nt; t += 2) {
            const bool last = (t == nt - 2);
            const char* a1 = cA + (size_t)(t + 1) * kstep;
            const char* a2 = last ? nA : cA + (size_t)(t + 2) * kstep; const char* b2 = last ? nB : cB + (size_t)(t + 2) * kstep;
            const char* a3 = a2 + kstep; const char* b3 = b2 + kstep;
            if (last && has_next) S.a_ready(nxt);
            if constexpr (SP2) {
            PG8_LDB(B0, 0, 0); PG8_LDB(B1, 0, 1); PG8_SCHED; PG8_LDA(At, 0, 0); PG8_STAGE(PG8_SA(1, 1), a1 + hstep, voffA);
            PG8_WAIT_V(8); PG8_WAIT_L(0); PG8_BAR; PG8_MMA(0, 0, At, B0); PG8_MMA(0, 1, At, B1); PG8_BAR; PG8_SCHED;
            PG8_LDA(At, 0, 1); PG8_STAGE(PG8_SB(0, 0), b2, voffB); PG8_STAGE(PG8_SB(0, 1), b2 + hstep, voffB); PG8_STAGE(PG8_SA(0, 0), a2, voffA);
            PG8_WAIT_V(8); PG8_WAIT_L(0); PG8_BAR; PG8_MMA(1, 0, At, B0); PG8_MMA(1, 1, At, B1); PG8_BAR; PG8_SCHED;
            PG8_LDB(B0, 1, 0); PG8_LDB(B1, 1, 1); PG8_SCHED; PG8_LDA(At, 1, 0); PG8_STAGE(PG8_SA(0, 1), a2 + hstep, voffA);
            PG8_WAIT_V(8); PG8_WAIT_L(0); PG8_BAR; PG8_MMA(0, 0, At, B0); PG8_MMA(0, 1, At, B1); PG8_BAR; PG8_SCHED;
            PG8_LDA(At, 1, 1); PG8_STAGE(PG8_SB(1, 0), b3, voffB); PG8_STAGE(PG8_SB(1, 1), b3 + hstep, voffB); PG8_STAGE(PG8_SA(1, 0), a3, voffA);
            PG8_WAIT_V(8); PG8_WAIT_L(0); PG8_BAR; PG8_MMA(1, 0, At, B0); PG8_MMA(1, 1, At, B1); PG8_BAR; PG8_SCHED;
            } else {
            PG8_LDB(B0, 0, 0); PG8_SCHED; PG8_LDA(At, 0, 0); PG8_STAGE(PG8_SA(1, 1), a1 + hstep, voffA);
            PG8_WAIT_L(8); PG8_BAR; PG8_WAIT_L(0); PG8_MMA(0, 0, At, B0); PG8_BAR; PG8_SCHED;
            PG8_LDB(B1, 0, 1); PG8_STAGE(PG8_SB(0, 0), b2, voffB);
            PG8_BAR; PG8_WAIT_L(0); PG8_MMA(0, 1, At, B1); PG8_BAR;
            PG8_LDA(At, 0, 1); PG8_STAGE(PG8_SA(0, 0), a2, voffA);
            PG8_BAR; PG8_WAIT_L(0); PG8_MMA(1, 0, At, B0); PG8_BAR; PG8_SCHED;
            PG8_STAGE(PG8_SB(0, 1), b2 + hstep, voffB);
            PG8_WAIT_V(6); PG8_BAR; PG8_MMA(1, 1, At, B1); PG8_BAR;
            PG8_LDB(B0, 1, 0); PG8_SCHED; PG8_LDA(At, 1, 0); PG8_STAGE(PG8_SA(0, 1), a2 + hstep, voffA);
            PG8_WAIT_L(8); PG8_BAR; PG8_WAIT_L(0); PG8_MMA(0, 0, At, B0); PG8_BAR; PG8_SCHED;
            PG8_LDB(B1, 1, 1); PG8_STAGE(PG8_SB(1, 0), b3, voffB);
            PG8_BAR; PG8_WAIT_L(0); PG8_MMA(0, 1, At, B1); PG8_BAR;
            PG8_LDA(At, 1, 1); PG8_STAGE(PG8_SA(1, 0), a3, voffA);
            PG8_BAR; PG8_WAIT_L(0); PG8_MMA(1, 0, At, B0); PG8_BAR; PG8_SCHED;
            PG8_STAGE(PG8_SB(1, 1), b3 + hstep, voffB);
            PG8_WAIT_V(6); PG8_BAR; PG8_MMA(1, 1, At, B1); PG8_BAR;
            }
        }
        if constexpr (ALIGN_EPI) { if (wr == 0) PG8_BAR; }
        if constexpr (!Epi::AFTER_DRAIN) { E(acc, cur, wr, wc, fr, fq); S.done(cur); }
        if (!has_next) break;
#pragma unroll
        for (int a = 0; a < 2; ++a)
#pragma unroll
            for (int b = 0; b < 2; ++b)
#pragma unroll
                for (int m = 0; m < 4; ++m)
#pragma unroll
                    for (int n = 0; n < 2; ++n) acc[a][b][m][n] = (f32x4){0.f, 0.f, 0.f, 0.f};
        cur = nxt; cA = nA; cB = nB; ++ui;
        if constexpr (ALIGN_EPI) { if (wr == 1) PG8_BAR; }
    }
    PG8_WAIT_V(0);
    if constexpr (!ALIGN_EPI) { if (wr == 0) PG8_BAR; }
    PG8_BAR;
    if constexpr (Epi::AFTER_DRAIN) { E.fused(acc, cur, wr, wc, fr, fq, lds, wid, lane); S.done(cur); }
#undef PG8_SA
#undef PG8_SB
#undef PG8_STAGE
#undef PG8_LDA
#undef PG8_LDB
#undef PG8_MMA
#undef PG8_WAIT_V
#undef PG8_WAIT_L
#undef PG8_BAR
#undef PG8_SCHED
}
}

constexpr int NB = 8, SEQ = 4096, DM = 1024, CTXL = 256;
constexpr int MLAT = NB * SEQ, MCTX = NB * CTXL, MALL = MLAT + MCTX;
constexpr int DH = 512, NHY = 1536, NGL = 1792, NINP = NHY + NGL, NIN = 3104, FF = 4096;
constexpr int GQ = 0, GK = 256, GV = 512, GOG = 1024, GGF = 1536;
constexpr int NSIG = 68, NITEM = NB * 4 * 2 * NSIG;
constexpr float EPSF = 1e-6f;
constexpr int MOD_SH1 = 0, MOD_SC1 = 1024, MOD_G1 = 2048, MOD_SH2 = 3072, MOD_SC2 = 4096, MOD_G2 = 5120, MODW = 6144;

constexpr size_t MiB = 1u << 20;
constexpr size_t WS_CTL = 0, WS_MOD = 1 * MiB, WS_SSQ = 2 * MiB, WS_WIN = 4 * MiB, WS_WOUT = 11 * MiB, WS_W1 = 13 * MiB, WS_W2 = 21 * MiB;
constexpr size_t WS_KRAW = 30 * MiB, WS_DEC = 46 * MiB, WS_XN = 48 * MiB  , WS_HYT = 116 * MiB, WS_GPROJ = 212 * MiB;
constexpr size_t WS_YT = 331 * MiB, WS_YCAT = 363 * MiB, WS_HID = 116 * MiB  , WS_END = 427 * MiB;
static_assert(WS_WIN + (size_t)NINP * DM * 2 <= WS_WOUT && WS_W2 + (size_t)DM * FF * 2 <= WS_KRAW && WS_KRAW + (size_t)DH * 8192 * 4 <= WS_DEC, "ws map 1");
static_assert(WS_DEC + (size_t)NITEM * 64 * 4 <= WS_XN && WS_XN + (size_t)MALL * DM * 2 <= WS_HYT && WS_XN + (size_t)NITEM * 8192 * 2 <= WS_HYT, "ws map 2");
static_assert(WS_HYT + (size_t)NHY * MLAT * 2 <= WS_GPROJ && WS_GPROJ + (size_t)MALL * NGL * 2 <= WS_YT && WS_YT + (size_t)DH * MLAT * 2 <= WS_YCAT, "ws map 3");
static_assert(WS_HID + (size_t)MLAT * FF * 2 <= WS_YCAT + (size_t)MLAT * DM * 2 && WS_YCAT + (size_t)MLAT * DM * 2 <= WS_END, "ws map 4");

constexpr int NTHR = 512, NWAVES = 8;
constexpr int LDS_BYTES = 147456;

#define LAS __attribute__((address_space(3)))
typedef unsigned short bf16;
typedef unsigned v4u __attribute__((ext_vector_type(4)));
typedef unsigned v2u __attribute__((ext_vector_type(2)));
typedef float f32x4 __attribute__((ext_vector_type(4)));
#define LDS_WAIT() asm volatile("s_waitcnt lgkmcnt(0)" ::: "memory")

__device__ __forceinline__ unsigned f2bf(float f) { unsigned u = __builtin_bit_cast(unsigned, f); return (u + 0x7fffu + ((u >> 16) & 1u)) >> 16; }
__device__ __forceinline__ unsigned pk2(float lo, float hi) { return f2bf(lo) | (f2bf(hi) << 16); }
__device__ __forceinline__ float bf2f(unsigned h) { return __builtin_bit_cast(float, h << 16); }
__device__ __forceinline__ float wave_sum(float v) {
#pragma unroll
    for (int o = 1; o < 64; o <<= 1) v += __shfl_xor(v, o);
    return v;
}
__device__ __forceinline__ float siluf(float v) { return v / (1.f + __expf(-v)); }
__device__ __forceinline__ float logsigmoidf(float a) { return fminf(a, 0.f) - log1pf(__expf(-fabsf(a))); }

struct Args { const float* in[29]; float* out; unsigned char* ws; int ph_lo, ph_hi; };

enum { I_X = 0, I_C, I_CTX, I_CCTX, I_WADA, I_BADA, I_NMIX, I_NMLP, I_WIN, I_CONVW, I_CONVB, I_FW1, I_FB1, I_FW2, I_FB2, I_FW3, I_FB3, I_FFREQ, I_FWOUT,
       I_HBIAS, I_GKWF, I_GKBF, I_GKWB, I_GKBB, I_GLAN, I_WOUT, I_WM1, I_WM2, I_NFIN };

__device__ __forceinline__ void p0_transpose_item(const float* W, int K, int N, bf16* WT, int row_off, float* scr, int item, int lane) {
    const int nblk = N / 32, kb = item / nblk, nb = item % nblk, k0 = 64 * kb, n0 = 32 * nb;
#pragma unroll 8
    for (int i = 0; i < 32; ++i) { const int kk = 2 * i + (lane >> 5); scr[kk * 33 + (lane & 31)] = W[(size_t)(k0 + kk) * N + n0 + (lane & 31)]; }
    LDS_WAIT(); asm volatile("" ::: "memory");
    const int c = lane & 7;
#pragma unroll
    for (int j = 0; j < 4; ++j) { const int n = (lane >> 3) + 8 * j; const float* s = scr + (8 * c) * 33 + n;
        v4u o; o.x = pk2(s[0 * 33], s[1 * 33]); o.y = pk2(s[2 * 33], s[3 * 33]); o.z = pk2(s[4 * 33], s[5 * 33]); o.w = pk2(s[6 * 33], s[7 * 33]);
        *(v4u*)(WT + (size_t)(row_off + n0 + n) * K + k0 + 8 * c) = o; }
    LDS_WAIT(); asm volatile("" ::: "memory");
}

__device__ __forceinline__ void p0_filter(const Args& a, unsigned char* lds) {
    float* zb = (float*)lds;
    float* h1 = zb + 16 * 33;
    float* h2 = h1 + 16 * 64;
    const int tid = threadIdx.x;
    float* Kraw = (float*)(a.ws + WS_KRAW); float* SSQ = (float*)(a.ws + WS_SSQ);
    const float* w1 = a.in[I_FW1]; const float* b1 = a.in[I_FB1]; const float* w2 = a.in[I_FW2]; const float* b2 = a.in[I_FB2];
    const float* w3 = a.in[I_FW3]; const float* b3 = a.in[I_FB3]; const float* fr = a.in[I_FFREQ]; const float* wo = a.in[I_FWOUT];
    for (int pg = blockIdx.x; pg < 256; pg += gridDim.x) {
        const int p0 = pg * 16;
        for (int i = tid; i < 16 * 33; i += NTHR) { const int pp = i / 33, j = i % 33; const int p = p0 + pp; float val;
            if (j == 0) val = (float)p * (1.0f / 4095.0f);
            else { const int bi = (j - 1) & 15; const float f = 1e-4f + (float)bi * ((15.0f - 1e-4f) / 15.0f); const float w = 6.283185307179586f * (float)p / 4096.0f; const float ang = w * f;
                   val = (j <= 16) ? cosf(ang) : -sinf(ang); }
            zb[i] = val; }
        __syncthreads();
        for (int i = tid; i < 1024; i += NTHR) { const int pp = i >> 6, j = i & 63; float acc = b1[j];
            for (int k = 0; k < 33; ++k) acc += zb[pp * 33 + k] * w1[k * 64 + j];
            h1[i] = sinf(fr[j] * acc); }
        __syncthreads();
        for (int i = tid; i < 1024; i += NTHR) { const int pp = i >> 6, j = i & 63; float acc = b2[j];
            for (int k = 0; k < 64; ++k) acc += h1[pp * 64 + k] * w2[k * 64 + j];
            h2[i] = sinf(fr[j] * acc); }
        __syncthreads();
        for (int i = tid; i < 1024; i += NTHR) { const int pp = i >> 6, j = i & 63; float acc = b3[j];
            for (int k = 0; k < 64; ++k) acc += h2[pp * 64 + k] * w3[k * 64 + j];
            h1[i] = sinf(fr[j] * acc); }
        __syncthreads();
        for (int dir = 0; dir < 2; ++dir) { const int c = tid, o = dir * 512 + c; float acc[16];
#pragma unroll
            for (int pp = 0; pp < 16; ++pp) acc[pp] = 0.f;
            for (int j = 0; j < 64; ++j) { const float w = wo[j * 1024 + o];
#pragma unroll
                for (int pp = 0; pp < 16; ++pp) acc[pp] += h1[pp * 64 + j] * w; }
            const float delta = 3.0701134573253945f + (float)c * ((15.350567286626972f - 3.0701134573253945f) / 511.0f); float ssq = 0.f;
#pragma unroll
            for (int pp = 0; pp < 16; ++pp) { const int p = p0 + pp; const float tn = (float)p * (1.0f / 4095.0f); const float val = acc[pp] * expf(-tn * delta);
                if (dir == 0) { Kraw[(size_t)c * 8192 + 4096 + p] = val; ssq += val * val; }
                else if (p >= 1) { Kraw[(size_t)c * 8192 + 4096 - p] = val; ssq += val * val; } }
            SSQ[pg * 1024 + o] = ssq;
            if (pg == 0 && dir == 0) Kraw[(size_t)c * 8192] = 0.f; }
        __syncthreads();
    }
}

__device__ __forceinline__ void p0_mod(const Args& a, unsigned char* lds) {
    float* sc = (float*)lds;
    float* red = sc + 9 * 1024;
    const int tid = threadIdx.x;
    if ((int)blockIdx.x >= 192) return;
    for (int i = tid; i < 9 * 1024; i += NTHR) { const float v = (i < 8192) ? a.in[I_C][i] : a.in[I_CCTX][i - 8192]; sc[i] = siluf(v); }
    __syncthreads();
    const float* wa = a.in[I_WADA]; const float* ba = a.in[I_BADA]; float* mod = (float*)(a.ws + WS_MOD);
    for (int it = blockIdx.x; it < 192; it += gridDim.x) {
        const int col = tid & 31, ks = tid >> 5, c0 = it * 32; float acc[9];
#pragma unroll
        for (int r = 0; r < 9; ++r) acc[r] = 0.f;
#pragma unroll 4
        for (int k = ks * 64; k < ks * 64 + 64; ++k) { const float w = wa[(size_t)k * MODW + c0 + col];
#pragma unroll
            for (int r = 0; r < 9; ++r) acc[r] += sc[r * 1024 + k] * w; }
#pragma unroll
        for (int r = 0; r < 9; ++r) red[(ks * 9 + r) * 32 + col] = acc[r];
        __syncthreads();
        if (tid < 288) { const int r = tid >> 5, cc = tid & 31; float s = ba[c0 + cc];
            for (int k2 = 0; k2 < 16; ++k2) s += red[(k2 * 9 + r) * 32 + cc];
            mod[r * MODW + c0 + cc] = s; }
        __syncthreads();
    }
}

__device__ __forceinline__ void p0_prologue(const Args& a, unsigned char* lds) {
    const int tid = threadIdx.x, lane = tid & 63, wave = tid >> 6;
    p0_filter(a, lds);
    __syncthreads();
    p0_mod(a, lds);
    __syncthreads();
    { v4u* z = (v4u*)((bf16*)(a.ws + WS_WIN) + (size_t)NIN * DM); const int n16 = (NINP - NIN) * DM * 2 / 16;
      for (int i = blockIdx.x * NTHR + tid; i < n16; i += gridDim.x * NTHR) z[i] = (v4u){0u, 0u, 0u, 0u}; }
    float* scr = (float*)(lds + wave * 16384);
    const int gw = blockIdx.x * NWAVES + wave, NGW = gridDim.x * NWAVES;
    constexpr int I_IN = (DM / 64) * (NIN / 32), I_O = (DM / 64) * (DM / 32), I_1 = (DM / 64) * (FF / 32), I_2 = (FF / 64) * (DM / 32);
    constexpr int NITEMS = I_IN + I_O + I_1 + I_2;
    for (int it = gw; it < NITEMS; it += NGW) {
        int r = it;
        if (r < I_IN) { p0_transpose_item(a.in[I_WIN], DM, NIN, (bf16*)(a.ws + WS_WIN), 0, scr, r, lane); continue; } r -= I_IN;
        if (r < I_O) { p0_transpose_item(a.in[I_WOUT], DM, DM, (bf16*)(a.ws + WS_WOUT), 0, scr, r, lane); continue; } r -= I_O;
        if (r < I_1) { p0_transpose_item(a.in[I_WM1], DM, FF, (bf16*)(a.ws + WS_W1), 0, scr, r, lane); continue; } r -= I_1;
        p0_transpose_item(a.in[I_WM2], FF, DM, (bf16*)(a.ws + WS_W2), 0, scr, r, lane);
    }
}

__device__ __forceinline__ void norm_mod_rows(const Args& a, const float* src_lat, const float* src_ctx, int nrows, const float* g, int sc_off, int sh_off, bf16* dst) {
    const int tid = threadIdx.x, lane = tid & 63, wave = tid >> 6;
    const int gw = blockIdx.x * NWAVES + wave, NGW = gridDim.x * NWAVES;
    const float* mod = (const float*)(a.ws + WS_MOD);
    for (int row = gw; row < nrows; row += NGW) {
        const float* src = row < MLAT ? src_lat + (size_t)row * DM : src_ctx + (size_t)(row - MLAT) * DM;
        const int mrow = row < MLAT ? row / SEQ : 8;
        const f32x4* xr = (const f32x4*)src + lane;
        f32x4 v[4]; float s = 0.f;
#pragma unroll
        for (int j = 0; j < 4; ++j) { v[j] = xr[64 * j]; s += (v[j].x * v[j].x + v[j].y * v[j].y) + (v[j].z * v[j].z + v[j].w * v[j].w); }
        const float rstd = rsqrtf(wave_sum(s) * (1.f / DM) + EPSF);
        unsigned long long* o8 = (unsigned long long*)(dst + (size_t)row * DM) + lane;
#pragma unroll
        for (int j = 0; j < 4; ++j) { const int col = 256 * j + 4 * lane;
            const f32x4 gg = *(const f32x4*)(g + col), scv = *(const f32x4*)(mod + mrow * MODW + sc_off + col), shv = *(const f32x4*)(mod + mrow * MODW + sh_off + col);
            const f32x4 y = (v[j] * rstd * gg) * (scv + 1.f) + shv;
            o8[64 * j] = (unsigned long long)pk2(y.x, y.y) | ((unsigned long long)pk2(y.z, y.w) << 32); }
    }
}
__device__ __forceinline__ void final_norm_rows(const Args& a) {
    const int tid = threadIdx.x, lane = tid & 63, wave = tid >> 6;
    const int gw = blockIdx.x * NWAVES + wave, NGW = gridDim.x * NWAVES;
    const float* g = a.in[I_NFIN];
    for (int row = gw; row < MLAT; row += NGW) {
        f32x4* xr = (f32x4*)(a.out + (size_t)row * DM) + lane;
        f32x4 v[4]; float s = 0.f;
#pragma unroll
        for (int j = 0; j < 4; ++j) { v[j] = xr[64 * j]; s += (v[j].x * v[j].x + v[j].y * v[j].y) + (v[j].z * v[j].z + v[j].w * v[j].w); }
        const float rstd = rsqrtf(wave_sum(s) * (1.f / DM) + EPSF);
#pragma unroll
        for (int j = 0; j < 4; ++j) { const f32x4 gg = *(const f32x4*)(g + 256 * j + 4 * lane); xr[64 * j] = v[j] * rstd * gg; }
    }
}

constexpr int L_GR = 0, L_WG = 1024, L_BG = 2048, L_TOT = 2112, L_BC = 2176, L_KE = L_BC + 4096, L_KI = L_KE + 64 * 65, L_ATT = L_KI + 64 * 65, L_V = L_ATT + 64 * 65, L_S = L_V + 64 * 128, L_END = L_S + 128 * 65;
static_assert(L_END * 4 <= LDS_BYTES, "GLA LDS map");

__device__ __forceinline__ void gla_gate_cumsum(const Args& a, float* L, const bf16* gp, size_t row0, int h, int dir) {
    const int tid = threadIdx.x;
    const float* gkw = a.in[dir ? I_GKWB : I_GKWF]; const float* gkb = a.in[dir ? I_GKBB : I_GKBF];
    for (int i = tid; i < 1024; i += NTHR) { const int tok = i >> 4, r = i & 15; L[L_GR + i] = bf2f(gp[(row0 + tok) * NGL + GGF + dir * 16 + r]); }
    for (int i = tid; i < 1024; i += NTHR) { const int r = i >> 6, d = i & 63; L[L_WG + i] = gkw[r * 256 + h * 64 + d]; }
    if (tid < 64) L[L_BG + tid] = gkb[h * 64 + tid];
    __syncthreads();
    for (int i = tid; i < 4096; i += NTHR) { const int tok = i >> 6, d = i & 63; float acc = L[L_BG + d];
#pragma unroll
        for (int r = 0; r < 16; ++r) acc += L[L_GR + tok * 16 + r] * L[L_WG + r * 64 + d];
        L[L_BC + i] = logsigmoidf(acc) * (1.0f / 16.0f); }
    __syncthreads();
    if (tid < 64) { float run = 0.f;
        if (dir == 0) { for (int tok = 0; tok < 64; ++tok) { run += L[L_BC + tok * 64 + tid]; L[L_BC + tok * 64 + tid] = run; } }
        else { for (int tok = 63; tok >= 0; --tok) { run += L[L_BC + tok * 64 + tid]; L[L_BC + tok * 64 + tid] = run; } }
        L[L_TOT + tid] = run; }
    __syncthreads();
}

__device__ __forceinline__ size_t gla_chunk_row0(int b, int dir, int sig) {
    if (sig < 4) { const int cc = dir == 0 ? sig : 3 - sig; return (size_t)MLAT + b * CTXL + cc * 64; }
    const int n = dir == 0 ? sig - 4 : 67 - sig; return (size_t)b * SEQ + n * 64;
}

__device__ __forceinline__ void gla_local(const Args& a, unsigned char* lds) {
    float* L = (float*)lds; const int tid = threadIdx.x;
    const bf16* gp = (const bf16*)(a.ws + WS_GPROJ); bf16* ST = (bf16*)(a.ws + WS_XN); float* DEC = (float*)(a.ws + WS_DEC);
    for (int item = blockIdx.x; item < NITEM; item += gridDim.x) {
        const int sig = item % NSIG, chain = item / NSIG, dir = chain & 1, h = (chain >> 1) & 3, b = chain >> 3;
        const size_t row0 = gla_chunk_row0(b, dir, sig);
        gla_gate_cumsum(a, L, gp, row0, h, dir);
        for (int i = tid; i < 4096; i += NTHR) { const int tok = i >> 6, d = i & 63;
            L[L_KE + tok * 65 + d] = bf2f(gp[(row0 + tok) * NGL + GK + h * 64 + d]) * __expf(L[L_TOT + d] - L[L_BC + i]); }
        for (int i = tid; i < 8192; i += NTHR) { const int tok = i >> 7, e = i & 127; L[L_V + i] = bf2f(gp[(row0 + tok) * NGL + GV + h * 128 + e]); }
        __syncthreads();
        { const int d = tid & 63, e0 = (tid >> 6) * 16; float acc[16];
#pragma unroll
          for (int i = 0; i < 16; ++i) acc[i] = 0.f;
          for (int tok = 0; tok < 64; ++tok) { const float ke = L[L_KE + tok * 65 + d];
#pragma unroll
              for (int i = 0; i < 16; ++i) acc[i] += L[L_V + tok * 128 + e0 + i] * ke; }
#pragma unroll
          for (int i = 0; i < 16; ++i) ST[(size_t)item * 8192 + (e0 + i) * 64 + d] = (bf16)f2bf(acc[i]);
          if (tid < 64) DEC[item * 64 + tid] = __expf(L[L_TOT + tid]); }
        __syncthreads();
    }
}

__device__ __forceinline__ void gla_scan(const Args& a) {
    bf16* ST = (bf16*)(a.ws + WS_XN); const float* DEC = (const float*)(a.ws + WS_DEC);
    for (int w = blockIdx.x * NTHR + threadIdx.x; w < 64 * 1024; w += gridDim.x * NTHR) {
        const int chain = w >> 10, el = (w & 1023) * 8, d0 = el & 63; float s[8];
#pragma unroll
        for (int i = 0; i < 8; ++i) s[i] = 0.f;
#pragma unroll 4
        for (int sig = 0; sig < NSIG; ++sig) { const size_t item = (size_t)chain * NSIG + sig;
            v4u* p = (v4u*)(ST + item * 8192 + el); const v4u dsv = *p;
            const f32x4 d0v = *(const f32x4*)(DEC + item * 64 + d0), d1v = *(const f32x4*)(DEC + item * 64 + d0 + 4);
            v4u o; o.x = pk2(s[0], s[1]); o.y = pk2(s[2], s[3]); o.z = pk2(s[4], s[5]); o.w = pk2(s[6], s[7]); *p = o;
            s[0] = d0v.x * s[0] + bf2f(dsv.x & 0xffffu); s[1] = d0v.y * s[1] + bf2f(dsv.x >> 16);
            s[2] = d0v.z * s[2] + bf2f(dsv.y & 0xffffu); s[3] = d0v.w * s[3] + bf2f(dsv.y >> 16);
            s[4] = d1v.x * s[4] + bf2f(dsv.z & 0xffffu); s[5] = d1v.y * s[5] + bf2f(dsv.z >> 16);
            s[6] = d1v.z * s[6] + bf2f(dsv.w & 0xffffu); s[7] = d1v.w * s[7] + bf2f(dsv.w >> 16); }
    }
}

__device__ __forceinline__ void gla_out(const Args& a, unsigned char* lds) {
    float* L = (float*)lds; const int tid = threadIdx.x, lane = tid & 63, wave = tid >> 6;
    const bf16* gp = (const bf16*)(a.ws + WS_GPROJ); const bf16* ST = (const bf16*)(a.ws + WS_XN); bf16* ycat = (bf16*)(a.ws + WS_YCAT);
    const float* gn = a.in[I_GLAN];
    for (int it = blockIdx.x; it < NB * 4 * 64; it += gridDim.x) {
        const int n = it & 63, h = (it >> 6) & 3, b = it >> 8; const size_t row0 = (size_t)b * SEQ + n * 64;
        const int e = tid & 127, c0 = (tid >> 7) * 16; float o[16];
#pragma unroll
        for (int i = 0; i < 16; ++i) o[i] = 0.f;
        for (int dir = 0; dir < 2; ++dir) {
            gla_gate_cumsum(a, L, gp, row0, h, dir);
            const int sig = dir == 0 ? n + 4 : 67 - n; const size_t item = (size_t)((b * 4 + h) * 2 + dir) * NSIG + sig;
            for (int i = tid; i < 4096; i += NTHR) { const int tok = i >> 6, d = i & 63; const float bc = L[L_BC + i];
                L[L_KE + tok * 65 + d] = bf2f(gp[(row0 + tok) * NGL + GQ + h * 64 + d]) * 0.125f * __expf(bc);
                L[L_KI + tok * 65 + d] = bf2f(gp[(row0 + tok) * NGL + GK + h * 64 + d]) * __expf(-bc); }
            if (dir == 0) for (int i = tid; i < 8192; i += NTHR) { const int tok = i >> 7, ee = i & 127; L[L_V + i] = bf2f(gp[(row0 + tok) * NGL + GV + h * 128 + ee]); }
            for (int i = tid; i < 8192; i += NTHR) { const int ee = i >> 6, d = i & 63; L[L_S + ee * 65 + d] = bf2f(ST[item * 8192 + i]); }
            __syncthreads();
            { const int s = tid & 63, ca = (tid >> 6) * 8; float acc[8];
#pragma unroll
              for (int i = 0; i < 8; ++i) acc[i] = 0.f;
              for (int d = 0; d < 64; ++d) { const float ki = L[L_KI + s * 65 + d];
#pragma unroll
                  for (int i = 0; i < 8; ++i) acc[i] += L[L_KE + (ca + i) * 65 + d] * ki; }
#pragma unroll
              for (int i = 0; i < 8; ++i) { const int c = ca + i; const bool keep = dir == 0 ? (s <= c) : (s >= c); L[L_ATT + c * 65 + s] = keep ? acc[i] : 0.f; } }
            __syncthreads();
            for (int s = 0; s < 64; ++s) { const float vv = L[L_V + s * 128 + e];
#pragma unroll
                for (int i = 0; i < 16; ++i) o[i] += L[L_ATT + (c0 + i) * 65 + s] * vv; }
            for (int d = 0; d < 64; ++d) { const float sv = L[L_S + e * 65 + d];
#pragma unroll
                for (int i = 0; i < 16; ++i) o[i] += L[L_KE + (c0 + i) * 65 + d] * sv; }
            __syncthreads();
        }
        float* OB = L + L_KE;
#pragma unroll
        for (int i = 0; i < 16; ++i) OB[(c0 + i) * 128 + e] = o[i];
        __syncthreads();
        for (int j = 0; j < 8; ++j) { const int c = wave * 8 + j; const float v0 = OB[c * 128 + lane], v1 = OB[c * 128 + 64 + lane];
            const float rstd = rsqrtf(wave_sum(v0 * v0 + v1 * v1) * (1.f / 128.f) + EPSF);
            const size_t row = row0 + c;
            const float g0 = bf2f(gp[row * NGL + GOG + h * 128 + lane]), g1 = bf2f(gp[row * NGL + GOG + h * 128 + 64 + lane]);
            ycat[row * DM + DH + h * 128 + lane] = (bf16)f2bf(v0 * rstd * gn[lane] * siluf(g0));
            ycat[row * DM + DH + h * 128 + 64 + lane] = (bf16)f2bf(v1 * rstd * gn[64 + lane] * siluf(g1)); }
        __syncthreads();
    }
}

typedef short gbf16x8 __attribute__((ext_vector_type(8)));
typedef float gf32x16 __attribute__((ext_vector_type(16)));
constexpr int GL_ROWB = 144;
constexpr int GL_GR = 0;
constexpr int GL_WG = GL_GR + 64 * 17 * 4;
constexpr int GL_BG = GL_WG + 4096;
constexpr int GL_TOT = GL_BG + 256;
constexpr int GL_BCT = GL_TOT + 256;
constexpr int GL_QI = GL_BCT + 64 * 65 * 4;
constexpr int GL_KI = GL_QI + 2 * 64 * GL_ROWB;
constexpr int GL_ATT = GL_KI + 2 * 64 * GL_ROWB;
constexpr int GL_VT = GL_ATT + 2 * 64 * GL_ROWB;
constexpr int GL_OB = GL_VT + 128 * GL_ROWB;
constexpr int GL_END = GL_OB + 64 * 132 * 4;
static_assert(GL_END <= LDS_BYTES && GL_GR % 16 == 0 && GL_QI % 16 == 0 && GL_KI % 16 == 0 && GL_ATT % 16 == 0 && GL_VT % 16 == 0 && GL_OB % 16 == 0, "GLA LDS map");

__device__ __forceinline__ void gla_gates(const Args& a, LAS unsigned char* L, const bf16* gp, size_t row0, int h, int dir) {
    const int tid = threadIdx.x;
    LAS float* GR = (LAS float*)(L + GL_GR); LAS float* WG = (LAS float*)(L + GL_WG); LAS float* BG = (LAS float*)(L + GL_BG); LAS float* TOT = (LAS float*)(L + GL_TOT); LAS float* BCT = (LAS float*)(L + GL_BCT);
    const float* gkw = a.in[dir ? I_GKWB : I_GKWF]; const float* gkb = a.in[dir ? I_GKBB : I_GKBF];
    for (int i = tid; i < 1024; i += NTHR) { const int tok = i >> 4, r = i & 15; GR[tok * 17 + r] = bf2f(gp[(row0 + tok) * NGL + GGF + dir * 16 + r]); }
    for (int i = tid; i < 1024; i += NTHR) { const int r = i >> 6, d = i & 63; WG[i] = gkw[r * 256 + h * 64 + d]; }
    if (tid < 64) BG[tid] = gkb[h * 64 + tid];
    __syncthreads();
    for (int i = tid; i < 4096; i += NTHR) { const int tok = i & 63, d = i >> 6; float acc = BG[d];
#pragma unroll
        for (int r = 0; r < 16; ++r) acc += GR[tok * 17 + r] * WG[r * 64 + d];
        BCT[d * 65 + tok] = logsigmoidf(acc) * (1.0f / 16.0f); }
    __syncthreads();
    { const int d = tid >> 3, seg = tid & 7; float v[8]; float run = 0.f;
#pragma unroll
      for (int j = 0; j < 8; ++j) { const int tp = seg * 8 + j, tok = dir ? 63 - tp : tp; run += BCT[d * 65 + tok]; v[j] = run; }
      float inc = run;
#pragma unroll
      for (int o = 1; o < 8; o <<= 1) { const float t = __shfl_up(inc, o, 8); if (seg >= o) inc += t; }
      const float excl = inc - run;
#pragma unroll
      for (int j = 0; j < 8; ++j) { const int tp = seg * 8 + j, tok = dir ? 63 - tp : tp; BCT[d * 65 + tok] = v[j] + excl; }
      if (seg == 7) TOT[d] = inc; }
    __syncthreads();
}
__device__ __forceinline__ void gla_fill_vt(LAS unsigned char* L, const bf16* gp, size_t row0, int h) {
    const int tid = threadIdx.x, s = tid & 63;
#pragma unroll
    for (int it = 0; it < 2; ++it) { const int eg = (tid >> 6) + 8 * it;
        const v4u r = *(const v4u*)(gp + (row0 + s) * NGL + GV + h * 128 + eg * 8);
        LAS bf16* vt = (LAS bf16*)(L + GL_VT) + (eg * 8) * 72 + s;
        vt[0 * 72] = (bf16)(r.x & 0xffffu); vt[1 * 72] = (bf16)(r.x >> 16); vt[2 * 72] = (bf16)(r.y & 0xffffu); vt[3 * 72] = (bf16)(r.y >> 16);
        vt[4 * 72] = (bf16)(r.z & 0xffffu); vt[5 * 72] = (bf16)(r.z >> 16); vt[6 * 72] = (bf16)(r.w & 0xffffu); vt[7 * 72] = (bf16)(r.w >> 16); }
}
__device__ __forceinline__ gbf16x8 gl_frag(const LAS unsigned char* p) { return __builtin_bit_cast(gbf16x8, *(const LAS v4u*)p); }

__device__ __forceinline__ size_t gla_item(int b, int h, int dir, int ck) {
    const int sig = ck < 4 ? (dir == 0 ? ck : 3 - ck) : (dir == 0 ? ck : 71 - ck);
    return (size_t)((b * 4 + h) * 2 + dir) * NSIG + sig;
}
__device__ __forceinline__ void gla_local_mfma(const Args& a, unsigned char* lds) {
    LAS unsigned char* L = (LAS unsigned char*)lds;
    const int tid = threadIdx.x, lane = tid & 63, wave = __builtin_amdgcn_readfirstlane(tid >> 6), r = lane & 31, hh = lane >> 5;
    const bf16* gp = (const bf16*)(a.ws + WS_GPROJ); bf16* ST = (bf16*)(a.ws + WS_XN); float* DEC = (float*)(a.ws + WS_DEC);
    LAS float* TOT = (LAS float*)(L + GL_TOT); LAS float* BCT = (LAS float*)(L + GL_BCT);
    for (int ci = blockIdx.x; ci < NB * 4 * NSIG; ci += gridDim.x) {
        const int ck = ci % NSIG, h = (ci / NSIG) & 3, b = ci / (NSIG * 4);
        const size_t row0 = ck < 4 ? (size_t)MLAT + b * CTXL + ck * 64 : (size_t)b * SEQ + (ck - 4) * 64;
        for (int dir = 0; dir < 2; ++dir) {
            const size_t item_d = gla_item(b, h, dir, ck);
            gla_gates(a, L, gp, row0, h, dir);
            { const int s = tid & 63, dg = tid >> 6; const v4u kr = *(const v4u*)(gp + (row0 + s) * NGL + GK + h * 64 + dg * 8);
              float kv[8]; kv[0] = bf2f(kr.x & 0xffffu); kv[1] = bf2f(kr.x >> 16); kv[2] = bf2f(kr.y & 0xffffu); kv[3] = bf2f(kr.y >> 16); kv[4] = bf2f(kr.z & 0xffffu); kv[5] = bf2f(kr.z >> 16); kv[6] = bf2f(kr.w & 0xffffu); kv[7] = bf2f(kr.w >> 16);
              LAS bf16* ke = (LAS bf16*)(L + GL_QI + dir * 64 * GL_ROWB);
#pragma unroll
              for (int i = 0; i < 8; ++i) { const int d = dg * 8 + i; ke[d * 72 + s] = (bf16)f2bf(kv[i] * __expf(TOT[d] - BCT[d * 65 + s])); } }
            if (tid < 64) DEC[item_d * 64 + tid] = __expf(TOT[tid]);
            if (dir == 0) gla_fill_vt(L, gp, row0, h);
            __syncthreads();
        }
#pragma unroll
        for (int j = 0; j < 2; ++j) { const int tile = 2 * wave + j, dir = tile >> 3, mt = (tile >> 1) & 3, nt = tile & 1;
            gf32x16 acc;
#pragma unroll
            for (int i = 0; i < 16; ++i) acc[i] = 0.f;
            const LAS unsigned char* ap = L + GL_VT + (mt * 32 + r) * GL_ROWB + 16 * hh;
            const LAS unsigned char* bp = L + GL_QI + dir * 64 * GL_ROWB + (nt * 32 + r) * GL_ROWB + 16 * hh;
#pragma unroll
            for (int kk = 0; kk < 4; ++kk) acc = __builtin_amdgcn_mfma_f32_32x32x16_bf16(gl_frag(ap + 32 * kk), gl_frag(bp + 32 * kk), acc, 0, 0, 0);
            bf16* sp = ST + gla_item(b, h, dir, ck) * 8192 + nt * 32 + r;
#pragma unroll
            for (int i = 0; i < 16; ++i) { const int e = mt * 32 + (i & 3) + 8 * (i >> 2) + 4 * hh; sp[e * 64] = (bf16)f2bf(acc[i]); } }
        __syncthreads();
    }
}

__device__ __forceinline__ void gla_out_mfma(const Args& a, unsigned char* lds) {
    LAS unsigned char* L = (LAS unsigned char*)lds;
    const int tid = threadIdx.x, lane = tid & 63, wave = __builtin_amdgcn_readfirstlane(tid >> 6), r = lane & 31, hh = lane >> 5;
    const bf16* gp = (const bf16*)(a.ws + WS_GPROJ); const bf16* ST = (const bf16*)(a.ws + WS_XN); bf16* ycat = (bf16*)(a.ws + WS_YCAT);
    const float* gn = a.in[I_GLAN];
    LAS float* BCT = (LAS float*)(L + GL_BCT); LAS float* OB = (LAS float*)(L + GL_OB);
    for (int it = blockIdx.x; it < NB * 4 * 64; it += gridDim.x) {
        const int n = it & 63, h = (it >> 6) & 3, b = it >> 8; const size_t row0 = (size_t)b * SEQ + n * 64;
        for (int dir = 0; dir < 2; ++dir) {
            gla_gates(a, L, gp, row0, h, dir);
            { const int s = tid & 63, dg = tid >> 6;
              const v4u qr = *(const v4u*)(gp + (row0 + s) * NGL + GQ + h * 64 + dg * 8), kr = *(const v4u*)(gp + (row0 + s) * NGL + GK + h * 64 + dg * 8);
              float qv[8], kv[8];
              qv[0] = bf2f(qr.x & 0xffffu); qv[1] = bf2f(qr.x >> 16); qv[2] = bf2f(qr.y & 0xffffu); qv[3] = bf2f(qr.y >> 16); qv[4] = bf2f(qr.z & 0xffffu); qv[5] = bf2f(qr.z >> 16); qv[6] = bf2f(qr.w & 0xffffu); qv[7] = bf2f(qr.w >> 16);
              kv[0] = bf2f(kr.x & 0xffffu); kv[1] = bf2f(kr.x >> 16); kv[2] = bf2f(kr.y & 0xffffu); kv[3] = bf2f(kr.y >> 16); kv[4] = bf2f(kr.z & 0xffffu); kv[5] = bf2f(kr.z >> 16); kv[6] = bf2f(kr.w & 0xffffu); kv[7] = bf2f(kr.w >> 16);
              float qo[8], ko[8];
#pragma unroll
              for (int i = 0; i < 8; ++i) { const float bc = BCT[(dg * 8 + i) * 65 + s]; qo[i] = qv[i] * 0.125f * __expf(bc); ko[i] = kv[i] * __expf(-bc); }
              v4u qw, kw; qw.x = pk2(qo[0], qo[1]); qw.y = pk2(qo[2], qo[3]); qw.z = pk2(qo[4], qo[5]); qw.w = pk2(qo[6], qo[7]);
              kw.x = pk2(ko[0], ko[1]); kw.y = pk2(ko[2], ko[3]); kw.z = pk2(ko[4], ko[5]); kw.w = pk2(ko[6], ko[7]);
              *(LAS v4u*)(L + GL_QI + dir * 64 * GL_ROWB + s * GL_ROWB + dg * 16) = qw;
              *(LAS v4u*)(L + GL_KI + dir * 64 * GL_ROWB + s * GL_ROWB + dg * 16) = kw; }
            if (dir == 0) gla_fill_vt(L, gp, row0, h);
            __syncthreads();
        }
        { const int dir = wave >> 2, mt = (wave >> 1) & 1, nt = wave & 1;
          gf32x16 acc;
#pragma unroll
          for (int i = 0; i < 16; ++i) acc[i] = 0.f;
          const LAS unsigned char* ap = L + GL_QI + dir * 64 * GL_ROWB + (mt * 32 + r) * GL_ROWB + 16 * hh;
          const LAS unsigned char* bp = L + GL_KI + dir * 64 * GL_ROWB + (nt * 32 + r) * GL_ROWB + 16 * hh;
#pragma unroll
          for (int kk = 0; kk < 4; ++kk) acc = __builtin_amdgcn_mfma_f32_32x32x16_bf16(gl_frag(ap + 32 * kk), gl_frag(bp + 32 * kk), acc, 0, 0, 0);
          LAS bf16* at = (LAS bf16*)(L + GL_ATT + dir * 64 * GL_ROWB); const int s = nt * 32 + r;
#pragma unroll
          for (int i = 0; i < 16; ++i) { const int c = mt * 32 + (i & 3) + 8 * (i >> 2) + 4 * hh; const bool keep = dir == 0 ? (s <= c) : (s >= c);
              at[c * 72 + s] = (bf16)f2bf(keep ? acc[i] : 0.f); } }
        __syncthreads();
        { const int mt = wave >> 2, nt = wave & 3;
          gf32x16 acc;
#pragma unroll
          for (int i = 0; i < 16; ++i) acc[i] = 0.f;
#pragma unroll
          for (int dir = 0; dir < 2; ++dir) {
              const int sig = dir == 0 ? n + 4 : 67 - n; const size_t item = (size_t)((b * 4 + h) * 2 + dir) * NSIG + sig;
              const LAS unsigned char* ap = L + GL_ATT + dir * 64 * GL_ROWB + (mt * 32 + r) * GL_ROWB + 16 * hh;
              const LAS unsigned char* bp = L + GL_VT + (nt * 32 + r) * GL_ROWB + 16 * hh;
#pragma unroll
              for (int kk = 0; kk < 4; ++kk) acc = __builtin_amdgcn_mfma_f32_32x32x16_bf16(gl_frag(ap + 32 * kk), gl_frag(bp + 32 * kk), acc, 0, 0, 0);
              const LAS unsigned char* qp = L + GL_QI + dir * 64 * GL_ROWB + (mt * 32 + r) * GL_ROWB + 16 * hh;
              const bf16* sp = ST + item * 8192 + (nt * 32 + r) * 64 + 8 * hh;
#pragma unroll
              for (int kk = 0; kk < 4; ++kk) acc = __builtin_amdgcn_mfma_f32_32x32x16_bf16(gl_frag(qp + 32 * kk), __builtin_bit_cast(gbf16x8, *(const v4u*)(sp + 16 * kk)), acc, 0, 0, 0);
          }
#pragma unroll
          for (int i = 0; i < 16; ++i) { const int c = mt * 32 + (i & 3) + 8 * (i >> 2) + 4 * hh; OB[c * 132 + nt * 32 + r] = acc[i]; } }
        __syncthreads();
        for (int j = 0; j < 8; ++j) { const int c = wave * 8 + j; const float v0 = OB[c * 132 + lane], v1 = OB[c * 132 + 64 + lane];
            const float rstd = rsqrtf(wave_sum(v0 * v0 + v1 * v1) * (1.f / 128.f) + EPSF);
            const size_t row = row0 + c;
            const float g0 = bf2f(gp[row * NGL + GOG + h * 128 + lane]), g1 = bf2f(gp[row * NGL + GOG + h * 128 + 64 + lane]);
            ycat[row * DM + DH + h * 128 + lane] = (bf16)f2bf(v0 * rstd * gn[lane] * siluf(g0));
            ycat[row * DM + DH + h * 128 + 64 + lane] = (bf16)f2bf(v1 * rstd * gn[64 + lane] * siluf(g1)); }
        __syncthreads();
    }
}

__device__ __forceinline__ float hy_sconv(const bf16* hyT, int ch, int col, float w0, float w1, float w2, float cb) {
    const int tt = col & 63; const bf16* p = hyT + (size_t)ch * MLAT + col;
    const float h0 = bf2f(p[0]), hm = tt > 0 ? bf2f(p[-1]) : 0.f, hp = tt < 63 ? bf2f(p[1]) : 0.f;
    return cb + w0 * hm + w1 * h0 + w2 * hp;
}
__device__ __forceinline__ void hyena_conv(const Args& a, unsigned char* lds) {
    float* KL = (float*)lds;
    bf16* Z = (bf16*)(lds + 32768);
    float* RED = (float*)(lds + 32768 + 65536);
    const int tid = threadIdx.x, lane = tid & 63, wave = tid >> 6;
    const bf16* hyT = (const bf16*)(a.ws + WS_HYT); bf16* yT = (bf16*)(a.ws + WS_YT);
    const float* Kraw = (const float*)(a.ws + WS_KRAW); const float* SSQ = (const float*)(a.ws + WS_SSQ);
    const float* cw = a.in[I_CONVW]; const float* cbv = a.in[I_CONVB];
    for (int c = blockIdx.x; c < DH; c += gridDim.x) {
        { const float part = SSQ[(tid >> 1) * 1024 + (tid & 1) * 512 + c]; const float ws = wave_sum(part); if (lane == 0) RED[wave] = ws; }
        __syncthreads();
        float tot = 0.f;
#pragma unroll
        for (int i = 0; i < 8; ++i) tot += RED[i];
        const float sc = rsqrtf(tot + EPSF);
        for (int i = tid; i < 8192; i += NTHR) KL[i] = Kraw[(size_t)c * 8192 + i] * sc;
        { const int c1 = DH + c, c2 = 2 * DH + c;
          const float a0 = cw[c1], a1 = cw[NHY + c1], a2 = cw[2 * NHY + c1], ab = cbv[c1], b0 = cw[c2], b1 = cw[NHY + c2], b2 = cw[2 * NHY + c2], bb = cbv[c2];
          for (int i = tid; i < MLAT; i += NTHR) Z[i] = (bf16)f2bf(hy_sconv(hyT, c1, i, a0, a1, a2, ab) * hy_sconv(hyT, c2, i, b0, b1, b2, bb)); }
        __syncthreads();
        float acc[8][8];
#pragma unroll
        for (int j = 0; j < 8; ++j)
#pragma unroll
            for (int b = 0; b < 8; ++b) acc[j][b] = 0.f;
        const unsigned* Z2 = (const unsigned*)Z;
        for (int s2 = 0; s2 < 2048; ++s2) { float zl[8], zh[8];
#pragma unroll
            for (int b = 0; b < 8; ++b) { const unsigned zz = Z2[b * 2048 + s2]; zl[b] = bf2f(zz & 0xffffu); zh[b] = bf2f(zz >> 16); }
#pragma unroll
            for (int j = 0; j < 8; ++j) { const int base = tid + 512 * j - 2 * s2 + 4096; const float k0 = KL[base], k1 = KL[base - 1];
#pragma unroll
                for (int b = 0; b < 8; ++b) acc[j][b] += k0 * zl[b] + k1 * zh[b]; } }
        { const float w0 = cw[c], w1 = cw[NHY + c], w2 = cw[2 * NHY + c], wb = cbv[c], hb = a.in[I_HBIAS][c];
#pragma unroll
          for (int j = 0; j < 8; ++j)
#pragma unroll
              for (int b = 0; b < 8; ++b) { const int col = b * SEQ + tid + 512 * j; const float x0 = hy_sconv(hyT, c, col, w0, w1, w2, wb);
                  yT[(size_t)c * MLAT + col] = (bf16)f2bf(x0 * (acc[j][b] + hb * bf2f(Z[col]))); } }
        __syncthreads();
    }
}
typedef short hbf16x8 __attribute__((ext_vector_type(8)));
typedef float hf32x16 __attribute__((ext_vector_type(16)));
constexpr int HK_COPYB = 16448, HK_OFF = 0, HZ_OFF = 4 * HK_COPYB, HZ_ROWB = 8208, HZERO_OFF = HZ_OFF + 8 * HZ_ROWB, HRED_OFF = HZERO_OFF + 64;
static_assert(HRED_OFF + 64 <= LDS_BYTES && 8 * HZ_ROWB <= 4 * HK_COPYB, "hyena LDS map");
__device__ __forceinline__ void hy_unpack8(const v4u r, float* o) {
    o[0] = bf2f(r.x & 0xffffu); o[1] = bf2f(r.x >> 16); o[2] = bf2f(r.y & 0xffffu); o[3] = bf2f(r.y >> 16);
    o[4] = bf2f(r.z & 0xffffu); o[5] = bf2f(r.z >> 16); o[6] = bf2f(r.w & 0xffffu); o[7] = bf2f(r.w >> 16);
}
__device__ __forceinline__ void hyena_conv_mfma(const Args& a, unsigned char* lds) {
    LAS unsigned char* L = (LAS unsigned char*)lds;
    const int tid = threadIdx.x, lane = tid & 63, wave = __builtin_amdgcn_readfirstlane(tid >> 6), r = lane & 31, h = lane >> 5;
    const bf16* hyT = (const bf16*)(a.ws + WS_HYT); bf16* yT = (bf16*)(a.ws + WS_YT);
    const float* Kraw = (const float*)(a.ws + WS_KRAW); const float* SSQ = (const float*)(a.ws + WS_SSQ);
    const float* cw = a.in[I_CONVW]; const float* cbv = a.in[I_CONVB];
    LAS float* RED = (LAS float*)(L + HRED_OFF);
    for (int c = blockIdx.x; c < DH; c += gridDim.x) {
        { const float part = SSQ[(tid >> 1) * 1024 + (tid & 1) * 512 + c]; const float ws = wave_sum(part); if (lane == 0) RED[wave] = ws; }
        __syncthreads();
        float tot = 0.f;
#pragma unroll
        for (int i = 0; i < 8; ++i) tot += RED[i];
        const float sc = rsqrtf(tot + EPSF);
        for (int idx = tid; idx < 4 * 4096; idx += NTHR) { const int s = idx >> 12, y = (idx & 4095) * 2, x = y + s;
            const float v0 = (x >= 1 && x <= 8191) ? Kraw[(size_t)c * 8192 + 8192 - x] * sc : 0.f;
            const float v1 = (x + 1 <= 8191) ? Kraw[(size_t)c * 8192 + 8191 - x] * sc : 0.f;
            *(LAS unsigned*)(L + HK_OFF + s * HK_COPYB + 2 * y) = pk2(v0, v1); }
        if (tid < 4) ((LAS unsigned*)(L + HZERO_OFF))[tid] = 0u;
        { const int c1 = DH + c, c2 = 2 * DH + c;
          const float a0 = cw[c1], a1 = cw[NHY + c1], a2 = cw[2 * NHY + c1], ab = cbv[c1], b0 = cw[c2], b1 = cw[NHY + c2], b2 = cw[2 * NHY + c2], bb = cbv[c2];
          for (int gi = tid; gi < 4096; gi += NTHR) { const int b = gi >> 9, t0 = (gi & 511) * 8, col = b * SEQ + t0;
              const bf16* p1 = hyT + (size_t)c1 * MLAT + col; const bf16* p2 = hyT + (size_t)c2 * MLAT + col;
              float u[10], w[10];
              hy_unpack8(*(const v4u*)p1, u + 1); hy_unpack8(*(const v4u*)p2, w + 1);
              const bool hl = (t0 & 63) != 0, hr = ((t0 + 8) & 63) != 0;
              u[0] = hl ? bf2f(p1[-1]) : 0.f; w[0] = hl ? bf2f(p2[-1]) : 0.f; u[9] = hr ? bf2f(p1[8]) : 0.f; w[9] = hr ? bf2f(p2[8]) : 0.f;
              float z[8];
#pragma unroll
              for (int i = 0; i < 8; ++i) z[i] = (ab + a0 * u[i] + a1 * u[i + 1] + a2 * u[i + 2]) * (bb + b0 * w[i] + b1 * w[i + 1] + b2 * w[i + 2]);
              v4u o; o.x = pk2(z[0], z[1]); o.y = pk2(z[2], z[3]); o.z = pk2(z[4], z[5]); o.w = pk2(z[6], z[7]);
              *(LAS v4u*)(L + HZ_OFF + b * HZ_ROWB + 2 * t0) = o; } }
        __syncthreads();
        hf32x16 acc[2][2];
#pragma unroll
        for (int m = 0; m < 2; ++m)
#pragma unroll
            for (int n = 0; n < 2; ++n)
#pragma unroll
                for (int i = 0; i < 16; ++i) acc[m][n][i] = 0.f;
        const int I0 = 8 * wave, q = r >> 3, b = r & 7, sh = (-r) & 3;
        const int a_lane = HK_OFF + sh * HK_COPYB + 2 * (4096 - r + 8 * h - sh);
        const int b_lane = HZ_OFF + b * HZ_ROWB + 16 * h;
        for (int d = I0 - 63; d <= I0 + 7; ++d) {
            const int J0 = I0 + q - d, J1 = J0 + 4;
            const bool ok0 = (unsigned)J0 < 64u, ok1 = (unsigned)J1 < 64u;
            const int abase = a_lane - 128 * d, bb0 = ok0 ? b_lane + 128 * J0 : HZERO_OFF, bb1 = ok1 ? b_lane + 128 * J1 : HZERO_OFF;
#pragma unroll
            for (int kk = 0; kk < 4; ++kk) {
                hbf16x8 af[2], bf[2];
#pragma unroll
                for (int m = 0; m < 2; ++m) { const int ad = abase - 64 * m + 32 * kk;
                    const v2u lo = *(const LAS v2u*)(L + ad), hi = *(const LAS v2u*)(L + ad + 8);
                    af[m] = __builtin_bit_cast(hbf16x8, (v4u){lo.x, lo.y, hi.x, hi.y}); }
                bf[0] = __builtin_bit_cast(hbf16x8, *(const LAS v4u*)(L + bb0 + (ok0 ? 32 * kk : 0)));
                bf[1] = __builtin_bit_cast(hbf16x8, *(const LAS v4u*)(L + bb1 + (ok1 ? 32 * kk : 0)));
#pragma unroll
                for (int m = 0; m < 2; ++m)
#pragma unroll
                    for (int n = 0; n < 2; ++n) acc[m][n] = __builtin_amdgcn_mfma_f32_32x32x16_bf16(af[m], bf[n], acc[m][n], 0, 0, 0);
            }
        }
        __syncthreads();
        for (int gi = tid; gi < 4096; gi += NTHR) { const int bb = gi >> 9, t0 = (gi & 511) * 8;
            *(LAS v4u*)(L + HK_OFF + bb * HZ_ROWB + 2 * t0) = *(const v4u*)(hyT + (size_t)c * MLAT + bb * SEQ + t0); }
        __syncthreads();
        { const float w0 = cw[c], w1 = cw[NHY + c], w2 = cw[2 * NHY + c], wb = cbv[c], hb = a.in[I_HBIAS][c];
#pragma unroll
          for (int m = 0; m < 2; ++m)
#pragma unroll
              for (int n = 0; n < 2; ++n)
#pragma unroll
                  for (int g = 0; g < 4; ++g) { const int t0 = 64 * (I0 + 4 * n + q) + 32 * m + 8 * g + 4 * h;
                      const LAS bf16* xp = (const LAS bf16*)(L + HK_OFF + b * HZ_ROWB + 2 * t0);
                      const v2u xr = *(const LAS v2u*)xp; const v2u zr = *(const LAS v2u*)(L + HZ_OFF + b * HZ_ROWB + 2 * t0);
                      float xv[6];
                      xv[0] = (t0 & 63) != 0 ? bf2f(xp[-1]) : 0.f; xv[5] = ((t0 + 4) & 63) != 0 ? bf2f(xp[4]) : 0.f;
                      xv[1] = bf2f(xr.x & 0xffffu); xv[2] = bf2f(xr.x >> 16); xv[3] = bf2f(xr.y & 0xffffu); xv[4] = bf2f(xr.y >> 16);
                      const float zv[4] = {bf2f(zr.x & 0xffffu), bf2f(zr.x >> 16), bf2f(zr.y & 0xffffu), bf2f(zr.y >> 16)};
                      float y[4];
#pragma unroll
                      for (int k = 0; k < 4; ++k) y[k] = (wb + w0 * xv[k] + w1 * xv[k + 1] + w2 * xv[k + 2]) * (acc[m][n][4 * g + k] + hb * zv[k]);
                      v2u o; o.x = pk2(y[0], y[1]); o.y = pk2(y[2], y[3]);
                      *(v2u*)(yT + (size_t)c * MLAT + b * SEQ + t0) = o; } }
        __syncthreads();
    }
}
__device__ __forceinline__ void hyena_transpose(const Args& a, unsigned char* lds) {
    const int tid = threadIdx.x, lane = tid & 63, wave = tid >> 6;
    bf16* scr = (bf16*)(lds + wave * 16384);
    const bf16* yT = (const bf16*)(a.ws + WS_YT); bf16* ycat = (bf16*)(a.ws + WS_YCAT);
    const int gw = blockIdx.x * NWAVES + wave, NGW = gridDim.x * NWAVES;
    for (int t = gw; t < (DH / 64) * (MLAT / 64); t += NGW) { const int cb = t & 7, tb = t >> 3, c0 = cb * 64, k0 = tb * 64;
        for (int r = 0; r < 64; ++r) scr[r * 66 + lane] = yT[(size_t)(c0 + r) * MLAT + k0 + lane];
        LDS_WAIT(); asm volatile("" ::: "memory");
        for (int r = 0; r < 64; ++r) ycat[(size_t)(k0 + r) * DM + c0 + lane] = scr[lane * 66 + r];
        LDS_WAIT(); asm volatile("" ::: "memory"); }
}

constexpr int NPHASE = 11;
__global__ void __launch_bounds__(NTHR, 2) fwd_kernel(Args a) {
    extern __shared__ __attribute__((aligned(16))) unsigned char lds[];
    cg::grid_group grid = cg::this_grid();
    const int lo = a.ph_lo, hi = a.ph_hi;
#define IN(k) (lo <= (k) && (k) < hi)
#define SEAM(k) do { if (IN(k) && IN((k) + 1)) grid.sync(); } while (0)
    unsigned char* ws = a.ws;
    PG8_LAS unsigned char* ldsg = (PG8_LAS unsigned char*)lds;
    if (IN(0)) { p0_prologue(a, lds); } SEAM(0);
    if (IN(1)) { norm_mod_rows(a, a.in[I_X], a.in[I_CTX], MALL, a.in[I_NMIX], MOD_SC1, MOD_SH1, (bf16*)(ws + WS_XN)); } SEAM(1);
    if (IN(2)) {
        { pg8::Gemm g{(const pg8::bf16_t*)(ws + WS_WIN), (const pg8::bf16_t*)(ws + WS_XN), NHY, MLAT, DM}; pg8::StaticOrder S; S.init(NHY, MLAT, gridDim.x, blockIdx.x);
          pg8::EpiBf16<0> E{(pg8::bf16_t*)(ws + WS_HYT), MLAT};
          pg8::gemm_phase<pg8::EpiBf16<0>, pg8::StaticOrder, true, true>(ldsg, g, S, E); }
        __syncthreads();
        { pg8::Gemm g{(const pg8::bf16_t*)(ws + WS_XN), (const pg8::bf16_t*)(ws + WS_WIN) + (size_t)NHY * DM, MALL, NGL, DM}; pg8::StaticOrder S; S.init(MALL, NGL, gridDim.x, blockIdx.x);
          pg8::EpiBf16<0> E{(pg8::bf16_t*)(ws + WS_GPROJ), NGL};
          pg8::gemm_phase<pg8::EpiBf16<0>, pg8::StaticOrder, true, true>(ldsg, g, S, E); }
    } SEAM(2);
    if (IN(3)) { gla_local_mfma(a, lds); __syncthreads(); hyena_conv_mfma(a, lds); } SEAM(3);
    if (IN(4)) { gla_scan(a); } SEAM(4);
    if (IN(5)) { gla_out_mfma(a, lds); __syncthreads(); hyena_transpose(a, lds); } SEAM(5);
    if (IN(6)) { pg8::Gemm g{(const pg8::bf16_t*)(ws + WS_YCAT), (const pg8::bf16_t*)(ws + WS_WOUT), MLAT, DM, DM}; pg8::StaticOrder S; S.init(MLAT, DM, gridDim.x, blockIdx.x);
        pg8::EpiResid E{a.in[I_X], a.out, DM, (const float*)(ws + WS_MOD) + MOD_G1, SEQ, MODW};
        pg8::gemm_phase<pg8::EpiResid, pg8::StaticOrder, true, true>(ldsg, g, S, E); } SEAM(6);
    if (IN(7)) { norm_mod_rows(a, a.out, a.out, MLAT, a.in[I_NMLP], MOD_SC2, MOD_SH2, (bf16*)(ws + WS_XN)); } SEAM(7);
    if (IN(8)) { pg8::Gemm g{(const pg8::bf16_t*)(ws + WS_XN), (const pg8::bf16_t*)(ws + WS_W1), MLAT, FF, DM}; pg8::StaticOrder S; S.init(MLAT, FF, gridDim.x, blockIdx.x);
        pg8::EpiBf16<1> E{(pg8::bf16_t*)(ws + WS_HID), FF};
        pg8::gemm_phase<pg8::EpiBf16<1>, pg8::StaticOrder, true, true>(ldsg, g, S, E); } SEAM(8);
    if (IN(9)) { pg8::Gemm g{(const pg8::bf16_t*)(ws + WS_HID), (const pg8::bf16_t*)(ws + WS_W2), MLAT, DM, FF}; pg8::StaticOrder S; S.init(MLAT, DM, gridDim.x, blockIdx.x);
        pg8::EpiResid E{a.out, a.out, DM, (const float*)(ws + WS_MOD) + MOD_G2, SEQ, MODW};
        pg8::gemm_phase<pg8::EpiResid, pg8::StaticOrder, true, true>(ldsg, g, S, E); } SEAM(9);
    if (IN(10)) { final_norm_rows(a); }
#undef IN
#undef SEAM
}

#ifndef N_LAUNCH_MODE
#define N_LAUNCH_MODE 1
#endif
extern "C" void kernel_launch(void* const* d_in, const int* in_sizes, int n_in, void* d_out, int out_size, void* d_ws, size_t ws_size, hipStream_t stream) {
    static int grid = 0;
    if (grid == 0) {
        if (n_in != 29 || out_size != MLAT * DM || ws_size < WS_END) { fprintf(stderr, "kernel_launch: unexpected shapes (n_in %d out %d ws %zu)\n", n_in, out_size, ws_size); grid = -1; return; }
        int dev = 0, cus = 0, per_cu = 0;
        if (hipGetDevice(&dev) != hipSuccess || hipDeviceGetAttribute(&cus, hipDeviceAttributeMultiprocessorCount, dev) != hipSuccess) { grid = -1; return; }
        if (hipFuncSetAttribute((const void*)fwd_kernel, hipFuncAttributeMaxDynamicSharedMemorySize, LDS_BYTES) != hipSuccess) { fprintf(stderr, "kernel_launch: hipFuncSetAttribute failed\n"); grid = -1; return; }
        if (hipOccupancyMaxActiveBlocksPerMultiprocessor(&per_cu, (const void*)fwd_kernel, NTHR, LDS_BYTES) != hipSuccess || per_cu < 1) { fprintf(stderr, "kernel_launch: occupancy query says %d blocks per CU\n", per_cu); (void)hipGetLastError(); grid = -1; return; }
        grid = cus;
    }
    if (grid < 0) return;
    Args a{};
    for (int i = 0; i < 29; ++i) a.in[i] = (const float*)d_in[i];
    a.out = (float*)d_out; a.ws = (unsigned char*)d_ws;
#if N_LAUNCH_MODE == 0
    for (int p = 0; p < NPHASE; ++p) { a.ph_lo = p; a.ph_hi = p + 1; hipLaunchKernelGGL(fwd_kernel, dim3(grid), dim3(NTHR), LDS_BYTES, stream, a); }
#else
    a.ph_lo = 0; a.ph_hi = NPHASE;
    void* args[] = {&a};
    hipError_t e = hipLaunchCooperativeKernel((const void*)fwd_kernel, dim3(grid), dim3(NTHR), args, LDS_BYTES, stream);
    if (e != hipSuccess) fprintf(stderr, "cooperative launch failed: %s (grid %d)\n", hipGetErrorString(e), grid);
#endif
}
```

```cpp
#include <hip/hip_runtime.h>
#include <hip/hip_cooperative_groups.h>
#include <cstdio>
#include <cstdint>
#include <cmath>
namespace cg = cooperative_groups;
namespace pg8 {
#define PG8_LAS __attribute__((address_space(3)))
typedef unsigned short bf16_t;
typedef short bf16x8 __attribute__((ext_vector_type(8)));
typedef float f32x4 __attribute__((ext_vector_type(4)));
typedef unsigned u32x4 __attribute__((ext_vector_type(4)));
constexpr int BM = 256, BK = 64, HALF = 128, HTB = HALF * BK * 2  , STAGE_BYTES = 8 * HTB, NXCD = 8, WGM = 8;

__host__ __device__ __forceinline__ int lds_byte(int r, int c) { const int st = (r >> 4) * 2 + (c >> 5), rr = r & 15, cc = c & 31, ob = rr * 64 + cc * 2; return st * 1024 + (ob ^ (((ob >> 9) & 1) << 5)); }
__host__ __device__ __forceinline__ void stage_rc(int b, int& R, int& C) { const int st = b / 1024, sb = b % 1024, swz = sb ^ (((sb >> 9) & 1) << 5); R = (st >> 1) * 16 + swz / 64; C = (st & 1) * 32 + (swz % 64) / 2; }
__host__ __device__ __forceinline__ int perm32(int rho) { const int n = rho >> 4, i = rho & 15; return 8 * (i >> 2) + 4 * n + (i & 3); }

struct Unit { int pm, pn; };
struct Gemm { const bf16_t* A; const bf16_t* Bt; int M, N, K; };

struct StaticOrder {
    int nM, nN, nwg, G, c;
    __host__ __device__ void init(int M, int N, int G_, int c_) { nM = M / BM; nN = N / BM; nwg = nM * nN; G = G_; c = c_; }
    __host__ __device__ bool next(int i, Unit& u) const {
        const long L = (long)i * G + c; if (L >= nwg) return false;
        int wgid = (int)L; { const int q = nwg / NXCD, r = nwg % NXCD, xcd = wgid % NXCD, off = wgid / NXCD; wgid = (xcd < r ? xcd * (q + 1) : r * (q + 1) + (xcd - r) * q) + off; }
        const int nig = WGM * nN, gid = wgid / nig, fm = gid * WGM, gsz = (nM - fm) < WGM ? (nM - fm) : WGM;
        u.pm = fm + ((wgid % nig) % gsz); u.pn = (wgid % nig) / gsz; return true;
    }
    __device__ __forceinline__ void a_ready(const Unit&) const {}
    __device__ __forceinline__ void done(const Unit&) const {}
};


__device__ __forceinline__ unsigned cvt_pk_bf16(float lo, float hi) { unsigned r; asm volatile("v_cvt_pk_bf16_f32 %0, %1, %2" : "=v"(r) : "v"(lo), "v"(hi)); return r; }

template <int ACT> struct EpiBf16 {
    static constexpr bool PERM = true, AFTER_DRAIN = false;
    bf16_t* O; int ldc;
    __device__ __forceinline__ void operator()(const f32x4 (&acc)[2][2][4][2], const Unit& u, int wr, int wc, int fr, int fq) const {
        const int row0 = u.pm * BM + wr * 64 + fr; const int col0 = u.pn * BM + wc * 32 + 8 * fq;
#pragma unroll
        for (int ai = 0; ai < 2; ++ai)
#pragma unroll
            for (int m = 0; m < 4; ++m) { bf16_t* rowp = O + (size_t)(row0 + ai * HALF + m * 16) * ldc + col0;
#pragma unroll
                for (int bj = 0; bj < 2; ++bj) { f32x4 v0 = acc[ai][bj][m][0], v1 = acc[ai][bj][m][1];
                    if (ACT == 1) {
#pragma unroll
                        for (int q = 0; q < 4; ++q) { const float a0 = fmaxf(v0[q], 0.f), a1 = fmaxf(v1[q], 0.f); v0[q] = a0 * a0; v1[q] = a1 * a1; } }
                    u32x4 w; w.x = cvt_pk_bf16(v0[0], v0[1]); w.y = cvt_pk_bf16(v0[2], v0[3]); w.z = cvt_pk_bf16(v1[0], v1[1]); w.w = cvt_pk_bf16(v1[2], v1[3]);
                    *(u32x4*)(rowp + bj * HALF) = w; } }
    }
};
struct EpiResid {
    static constexpr bool PERM = false, AFTER_DRAIN = false;
    const float* base; float* out; int ldc; const float* gate; int rows_per_gate; int gate_stride;
    __device__ __forceinline__ void operator()(const f32x4 (&acc)[2][2][4][2], const Unit& u, int wr, int wc, int fr, int fq) const {
        const int row0 = u.pm * BM + wr * 64 + fr, col0 = u.pn * BM + wc * 32 + 4 * fq;
        const float* gp = gate + (size_t)((u.pm * BM) / rows_per_gate) * gate_stride + col0;
        f32x4 gv[2][2];
#pragma unroll
        for (int bj = 0; bj < 2; ++bj)
#pragma unroll
            for (int n = 0; n < 2; ++n) gv[bj][n] = *(const f32x4*)(gp + bj * HALF + n * 16);
#pragma unroll
        for (int ai = 0; ai < 2; ++ai)
#pragma unroll
            for (int m = 0; m < 4; ++m) { const size_t off = (size_t)(row0 + ai * HALF + m * 16) * ldc + col0;
#pragma unroll
                for (int bj = 0; bj < 2; ++bj)
#pragma unroll
                    for (int n = 0; n < 2; ++n) { const f32x4 bs = *(const f32x4*)(base + off + bj * HALF + n * 16);
                        *(f32x4*)(out + off + bj * HALF + n * 16) = bs + gv[bj][n] * acc[ai][bj][m][n]; } }
    }
};

template <class Epi, class Sched, bool ALIGN_EPI = false, bool SP2 = false>
__device__ __forceinline__ void gemm_phase(PG8_LAS unsigned char* lds, const Gemm g, const Sched& S, const Epi& E) {
    const int tid = threadIdx.x, wid = __builtin_amdgcn_readfirstlane(tid >> 6), lane = tid & 63, wr = wid >> 2, wc = wid & 3, fr = lane & 15, fq = lane >> 4;
    const int K = g.K, nt = K / BK;
    unsigned voffA[2], voffB[2];
#pragma unroll
    for (int i = 0; i < 2; ++i) { int R, C; stage_rc(tid * 16 + i * 8192, R, C); const int Rb = Epi::PERM ? ((R & ~31) + perm32(R & 31)) : R;
        voffA[i] = (unsigned)(R * K + C) * 2u; voffB[i] = (unsigned)(Rb * K + C) * 2u; }
    const size_t kstep = (size_t)(BK * 2);
    const size_t hstep = (size_t)HALF * K * 2;
    const size_t tstep = 2 * hstep;
    const unsigned ldsw = (unsigned)wid * 1024u;
    const int aoff = lds_byte(wr * 64 + fr, fq * 8), boff = lds_byte(wc * 32 + fr, fq * 8);
#define PG8_SA(b, h) (((b) * 2 + (h)) * HTB)
#define PG8_SB(b, h) ((4 + (b) * 2 + (h)) * HTB)
#define PG8_STAGE(bufoff, gbase, voff) do { _Pragma("unroll") for (int _i = 0; _i < 2; ++_i) \
        __builtin_amdgcn_global_load_lds((const unsigned*)((const char*)(gbase) + (voff)[_i]), (PG8_LAS unsigned*)(lds + (bufoff) + ldsw + _i * 8192), 16, 0, 0); } while (0)
#define PG8_LDA(dst, b, h) do { _Pragma("unroll") for (int m = 0; m < 4; ++m) _Pragma("unroll") for (int k = 0; k < 2; ++k) dst[m][k] = *(const PG8_LAS bf16x8*)(lds + PG8_SA(b, h) + aoff + m * 2048 + k * 1024); } while (0)
#define PG8_LDB(dst, b, h) do { _Pragma("unroll") for (int n = 0; n < 2; ++n) _Pragma("unroll") for (int k = 0; k < 2; ++k) dst[n][k] = *(const PG8_LAS bf16x8*)(lds + PG8_SB(b, h) + boff + n * 2048 + k * 1024); } while (0)
#define PG8_MMA(ai, bj, At, Bt) do { __builtin_amdgcn_s_setprio(1); _Pragma("unroll") for (int m = 0; m < 4; ++m) _Pragma("unroll") for (int n = 0; n < 2; ++n) _Pragma("unroll") for (int k = 0; k < 2; ++k) \
        acc[ai][bj][m][n] = __builtin_amdgcn_mfma_f32_16x16x32_bf16(Bt[n][k], At[m][k], acc[ai][bj][m][n], 0, 0, 0); __builtin_amdgcn_s_setprio(0); } while (0)
#define PG8_WAIT_V(n) asm volatile("s_waitcnt vmcnt(" #n ")" ::: "memory")
#define PG8_WAIT_L(n) asm volatile("s_waitcnt lgkmcnt(" #n ")" ::: "memory")
#define PG8_BAR __builtin_amdgcn_s_barrier()
#define PG8_SCHED __builtin_amdgcn_sched_barrier(0)
    Unit cur, nxt; int ui = 0;
    if (!S.next(0, cur)) return;
    f32x4 acc[2][2][4][2];
#pragma unroll
    for (int a = 0; a < 2; ++a)
#pragma unroll
        for (int b = 0; b < 2; ++b)
#pragma unroll
            for (int m = 0; m < 4; ++m)
#pragma unroll
                for (int n = 0; n < 2; ++n) acc[a][b][m][n] = (f32x4){0.f, 0.f, 0.f, 0.f};
    bf16x8 At[4][2], B0[2][2], B1[2][2];
    const char* cA = (const char*)g.A + (size_t)cur.pm * tstep; const char* cB = (const char*)g.Bt + (size_t)cur.pn * tstep;
    S.a_ready(cur);
    if constexpr (SP2) {
        PG8_STAGE(PG8_SB(0, 0), cB, voffB); PG8_STAGE(PG8_SB(0, 1), cB + hstep, voffB); PG8_STAGE(PG8_SA(0, 0), cA, voffA); PG8_STAGE(PG8_SA(0, 1), cA + hstep, voffA);
        if (wr == 1) PG8_BAR;
        PG8_WAIT_V(2); PG8_BAR;
        PG8_STAGE(PG8_SB(1, 0), cB + kstep, voffB); PG8_STAGE(PG8_SA(1, 0), cA + kstep, voffA); PG8_STAGE(PG8_SB(1, 1), cB + hstep + kstep, voffB);
        PG8_WAIT_V(6); PG8_BAR;
    } else {
        PG8_STAGE(PG8_SB(0, 0), cB, voffB); PG8_STAGE(PG8_SA(0, 0), cA, voffA); PG8_STAGE(PG8_SB(0, 1), cB + hstep, voffB); PG8_STAGE(PG8_SA(0, 1), cA + hstep, voffA);
        if (wr == 1) PG8_BAR;
        PG8_WAIT_V(4); PG8_BAR;
        PG8_STAGE(PG8_SB(1, 0), cB + kstep, voffB); PG8_STAGE(PG8_SA(1, 0), cA + kstep, voffA); PG8_STAGE(PG8_SB(1, 1), cB + hstep + kstep, voffB);
        PG8_WAIT_V(6); PG8_BAR;
    }
    for (;;) {
        const bool has_next = S.next(ui + 1, nxt);
        const char* nA = has_next ? (const char*)g.A + (size_t)nxt.pm * tstep : cA; const char* nB = has_next ? (const char*)g.Bt + (size_t)nxt.pn * tstep : cB;
        for (int t = 0; t < nt; t += 2) {
            const bool last = (t == nt - 2);
            const char* a1 = cA + (size_t)(t + 1) * kstep;
            const char* a2 = last ? nA : cA + (size_t)(t + 2) * kstep; const char* b2 = last ? nB : cB + (size_t)(t + 2) * kstep;
            const char* a3 = a2 + kstep; const char* b3 = b2 + kstep;
            if (last && has_next) S.a_ready(nxt);
            if constexpr (SP2) {
            PG8_LDB(B0, 0, 0); PG8_LDB(B1, 0, 1); PG8_SCHED; PG8_LDA(At, 0, 0); PG8_STAGE(PG8_SA(1, 1), a1 + hstep, voffA);
            PG8_WAIT_V(8); PG8_WAIT_L(0); PG8_BAR; PG8_MMA(0, 0, At, B0); PG8_MMA(0, 1, At, B1); PG8_BAR; PG8_SCHED;
            PG8_LDA(At, 0, 1); PG8_STAGE(PG8_SB(0, 0), b2, voffB); PG8_STAGE(PG8_SB(0, 1), b2 + hstep, voffB); PG8_STAGE(PG8_SA(0, 0), a2, voffA);
            PG8_WAIT_V(8); PG8_WAIT_L(0); PG8_BAR; PG8_MMA(1, 0, At, B0); PG8_MMA(1, 1, At, B1); PG8_BAR; PG8_SCHED;
            PG8_LDB(B0, 1, 0); PG8_LDB(B1, 1, 1); PG8_SCHED; PG8_LDA(At, 1, 0); PG8_STAGE(PG8_SA(0, 1), a2 + hstep, voffA);
            PG8_WAIT_V(8); PG8_WAIT_L(0); PG8_BAR; PG8_MMA(0, 0, At, B0); PG8_MMA(0, 1, At, B1); PG8_BAR; PG8_SCHED;
            PG8_LDA(At, 1, 1); PG8_STAGE(PG8_SB(1, 0), b3, voffB); PG8_STAGE(PG8_SB(1, 1), b3 + hstep, voffB); PG8_STAGE(PG8_SA(1, 0), a3, voffA);
            PG8_WAIT_V(8); PG8_WAIT_L(0); PG8_BAR; PG8_MMA(1, 0, At, B0); PG8_MMA(1, 1, At, B1); PG8_BAR; PG8_SCHED;
            } else {
            PG8_LDB(B0, 0, 0); PG8_SCHED; PG8_LDA(At, 0, 0); PG8_STAGE(PG8_SA(1, 1), a1 + hstep, voffA);
            PG8_WAIT_L(8); PG8_BAR; PG8_WAIT_L(0); PG8_MMA(0, 0, At, B0); PG8_BAR; PG8_SCHED;
            PG8_LDB(B1, 0, 1); PG8_STAGE(PG8_SB(0, 0), b2, voffB);
            PG8_BAR; PG8_WAIT_L(0); PG8_MMA(0, 1, At, B1); PG8_BAR;
            PG8_LDA(At, 0, 1); PG8_STAGE(PG8_SA(0, 0), a2, voffA);
            PG8_BAR; PG8_WAIT_L(0); PG8_MMA(1, 0, At, B0); PG8_BAR; PG8_SCHED;
            PG8_STAGE(PG8_SB(0, 1), b2 + hstep, voffB);
            PG8_WAIT_V(6); PG8_BAR; PG8_MMA(1, 1, At, B1); PG8_BAR;
            PG8_LDB(B0, 1, 0); PG8_SCHED; PG8_LDA(At, 1, 0); PG8_STAGE(PG8_SA(0, 1), a2 + hstep, voffA);
            PG8_WAIT_L(8); PG8_BAR; PG8_WAIT_L(0); PG8_MMA(0, 0, At, B0); PG8_BAR; PG8_SCHED;
            PG8_LDB(B1, 1, 1); PG8_STAGE(PG8_SB(1, 0), b3, voffB);
            PG8_BAR; PG8_WAIT_L(0); PG8_MMA(0, 1, At, B1); PG8_BAR;
            PG8_LDA(At, 1, 1); PG8_STAGE(PG8_SA(1, 0), a3, voffA);
            PG8_BAR; PG8_WAIT_L(0); PG8_MMA(1, 0, At, B0); PG8_BAR; PG8_SCHED;
            PG8_STAGE(PG8_SB(1, 1), b3 + hstep, voffB);
            PG8_WAIT_V(6); PG8_BAR; PG8_MMA(1, 1, At, B1); PG8_BAR;
            }
        }
        if constexpr (ALIGN_EPI) { if (wr == 0) PG8_BAR; }
        if constexpr (!Epi::AFTER_DRAIN) { E(acc, cur, wr, wc, fr, fq); S.done(cur); }
        if (!has_next) break;
#pragma unroll
        for (int a = 0; a < 2; ++a)
#pragma unroll
            for (int b = 0; b < 2; ++b)
#pragma unroll
                for (int m = 0; m < 4; ++m)
#pragma unroll
                    for (int n = 0; n < 2; ++n) acc[a][b][m][n] = (f32x4){0.f, 0.f, 0.f, 0.f};
        cur = nxt; cA = nA; cB = nB; ++ui;
        if constexpr (ALIGN_EPI) { if (wr == 1) PG8_BAR; }
    }
    PG8_WAIT_V(0);
    if constexpr (!ALIGN_EPI) { if (wr == 0) PG8_BAR; }
    PG8_BAR;
    if constexpr (Epi::AFTER_DRAIN) { E.fused(acc, cur, wr, wc, fr, fq, lds, wid, lane); S.done(cur); }
#undef PG8_SA
#undef PG8_SB
#undef PG8_STAGE
#undef PG8_LDA
#undef PG8_LDB
#undef PG8_MMA
#undef PG8_WAIT_V
#undef PG8_WAIT_L
#undef PG8_BAR
#undef PG8_SCHED
}
}

constexpr int NB = 8, SEQ = 4096, DM = 1024, CTXL = 256;
constexpr int MLAT = NB * SEQ, MCTX = NB * CTXL, MALL = MLAT + MCTX;
constexpr int DH = 512, NHY = 1536, NGL = 1792, NINP = NHY + NGL, NIN = 3104, FF = 4096;
constexpr int GQ = 0, GK = 256, GV = 512, GOG = 1024, GGF = 1536;
constexpr int NSIG = 68, NITEM = NB * 4 * 2 * NSIG;
constexpr float EPSF = 1e-6f;
constexpr int MOD_SH1 = 0, MOD_SC1 = 1024, MOD_G1 = 2048, MOD_SH2 = 3072, MOD_SC2 = 4096, MOD_G2 = 5120, MODW = 6144;

constexpr size_t MiB = 1u << 20;
constexpr size_t WS_CTL = 0, WS_MOD = 1 * MiB, WS_SSQ = 2 * MiB, WS_WIN = 4 * MiB, WS_WOUT = 11 * MiB, WS_W1 = 13 * MiB, WS_W2 = 21 * MiB;
constexpr size_t WS_KRAW = 30 * MiB, WS_DEC = 46 * MiB, WS_XN = 48 * MiB  , WS_HYT = 116 * MiB, WS_GPROJ = 212 * MiB;
constexpr size_t WS_YT = 331 * MiB, WS_YCAT = 363 * MiB, WS_HID = 116 * MiB  , WS_END = 427 * MiB;
static_assert(WS_WIN + (size_t)NINP * DM * 2 <= WS_WOUT && WS_W2 + (size_t)DM * FF * 2 <= WS_KRAW && WS_KRAW + (size_t)DH * 8192 * 4 <= WS_DEC, "ws map 1");
static_assert(WS_DEC + (size_t)NITEM * 64 * 4 <= WS_XN && WS_XN + (size_t)MALL * DM * 2 <= WS_HYT && WS_XN + (size_t)NITEM * 8192 * 2 <= WS_HYT, "ws map 2");
static_assert(WS_HYT + (size_t)NHY * MLAT * 2 <= WS_GPROJ && WS_GPROJ + (size_t)MALL * NGL * 2 <= WS_YT && WS_YT + (size_t)DH * MLAT * 2 <= WS_YCAT, "ws map 3");
static_assert(WS_HID + (size_t)MLAT * FF * 2 <= WS_YCAT + (size_t)MLAT * DM * 2 && WS_YCAT + (size_t)MLAT * DM * 2 <= WS_END, "ws map 4");

constexpr int NTHR = 512, NWAVES = 8;
constexpr int LDS_BYTES = 147456;
constexpr int MISC_OFF = LDS_BYTES - 256;
constexpr int CW_BAR = 4096, CTL_ZERO_BYTES = 65536;

#define LAS __attribute__((address_space(3)))
typedef unsigned short bf16;
typedef unsigned v4u __attribute__((ext_vector_type(4)));
typedef unsigned v2u __attribute__((ext_vector_type(2)));
typedef float f32x4 __attribute__((ext_vector_type(4)));
#define LDS_WAIT() asm volatile("s_waitcnt lgkmcnt(0)" ::: "memory")

__device__ __forceinline__ unsigned f2bf(float f) { unsigned u = __builtin_bit_cast(unsigned, f); return (u + 0x7fffu + ((u >> 16) & 1u)) >> 16; }
__device__ __forceinline__ unsigned pk2(float lo, float hi) { return f2bf(lo) | (f2bf(hi) << 16); }
__device__ __forceinline__ float bf2f(unsigned h) { return __builtin_bit_cast(float, h << 16); }
__device__ __forceinline__ float wave_sum(float v) {
#pragma unroll
    for (int o = 1; o < 64; o <<= 1) v += __shfl_xor(v, o);
    return v;
}
__device__ __forceinline__ float siluf(float v) { return v / (1.f + __expf(-v)); }
__device__ __forceinline__ float logsigmoidf(float a) { return fminf(a, 0.f) - log1pf(__expf(-fabsf(a))); }

struct Args { const float* in[29]; float* out; unsigned char* ws; int ph_lo, ph_hi; };

enum { I_X = 0, I_C, I_CTX, I_CCTX, I_WADA, I_BADA, I_NMIX, I_NMLP, I_WIN, I_CONVW, I_CONVB, I_FW1, I_FB1, I_FW2, I_FB2, I_FW3, I_FB3, I_FFREQ, I_FWOUT,
       I_HBIAS, I_GKWF, I_GKBF, I_GKWB, I_GKBB, I_GLAN, I_WOUT, I_WM1, I_WM2, I_NFIN };

__device__ __forceinline__ void p0_transpose_item(const float* W, int K, int N, bf16* WT, int row_off, float* scr, int item, int lane) {
    const int nblk = N / 32, kb = item / nblk, nb = item % nblk, k0 = 64 * kb, n0 = 32 * nb;
#pragma unroll 8
    for (int i = 0; i < 32; ++i) { const int kk = 2 * i + (lane >> 5); scr[kk * 33 + (lane & 31)] = W[(size_t)(k0 + kk) * N + n0 + (lane & 31)]; }
    LDS_WAIT(); asm volatile("" ::: "memory");
    const int c = lane & 7;
#pragma unroll
    for (int j = 0; j < 4; ++j) { const int n = (lane >> 3) + 8 * j; const float* s = scr + (8 * c) * 33 + n;
        v4u o; o.x = pk2(s[0 * 33], s[1 * 33]); o.y = pk2(s[2 * 33], s[3 * 33]); o.z = pk2(s[4 * 33], s[5 * 33]); o.w = pk2(s[6 * 33], s[7 * 33]);
        *(v4u*)(WT + (size_t)(row_off + n0 + n) * K + k0 + 8 * c) = o; }
    LDS_WAIT(); asm volatile("" ::: "memory");
}

__device__ __forceinline__ void p0_filter(const Args& a, unsigned char* lds) {
    float* zb = (float*)lds;
    float* h1 = zb + 16 * 33;
    float* h2 = h1 + 16 * 64;
    const int tid = threadIdx.x;
    float* Kraw = (float*)(a.ws + WS_KRAW); float* SSQ = (float*)(a.ws + WS_SSQ);
    const float* w1 = a.in[I_FW1]; const float* b1 = a.in[I_FB1]; const float* w2 = a.in[I_FW2]; const float* b2 = a.in[I_FB2];
    const float* w3 = a.in[I_FW3]; const float* b3 = a.in[I_FB3]; const float* fr = a.in[I_FFREQ]; const float* wo = a.in[I_FWOUT];
    for (int pg = blockIdx.x; pg < 256; pg += gridDim.x) {
        const int p0 = pg * 16;
        for (int i = tid; i < 16 * 33; i += NTHR) { const int pp = i / 33, j = i % 33; const int p = p0 + pp; float val;
            if (j == 0) val = (float)p * (1.0f / 4095.0f);
            else { const int bi = (j - 1) & 15; const float f = 1e-4f + (float)bi * ((15.0f - 1e-4f) / 15.0f); const float w = 6.283185307179586f * (float)p / 4096.0f; const float ang = w * f;
                   val = (j <= 16) ? cosf(ang) : -sinf(ang); }
            zb[i] = val; }
        __syncthreads();
        for (int i = tid; i < 1024; i += NTHR) { const int pp = i >> 6, j = i & 63; float acc = b1[j];
            for (int k = 0; k < 33; ++k) acc += zb[pp * 33 + k] * w1[k * 64 + j];
            h1[i] = sinf(fr[j] * acc); }
        __syncthreads();
        for (int i = tid; i < 1024; i += NTHR) { const int pp = i >> 6, j = i & 63; float acc = b2[j];
            for (int k = 0; k < 64; ++k) acc += h1[pp * 64 + k] * w2[k * 64 + j];
            h2[i] = sinf(fr[j] * acc); }
        __syncthreads();
        for (int i = tid; i < 1024; i += NTHR) { const int pp = i >> 6, j = i & 63; float acc = b3[j];
            for (int k = 0; k < 64; ++k) acc += h2[pp * 64 + k] * w3[k * 64 + j];
            h1[i] = sinf(fr[j] * acc); }
        __syncthreads();
        for (int dir = 0; dir < 2; ++dir) { const int c = tid, o = dir * 512 + c; float acc[16];
#pragma unroll
            for (int pp = 0; pp < 16; ++pp) acc[pp] = 0.f;
            for (int j = 0; j < 64; ++j) { const float w = wo[j * 1024 + o];
#pragma unroll
                for (int pp = 0; pp < 16; ++pp) acc[pp] += h1[pp * 64 + j] * w; }
            const float delta = 3.0701134573253945f + (float)c * ((15.350567286626972f - 3.0701134573253945f) / 511.0f); float ssq = 0.f;
#pragma unroll
            for (int pp = 0; pp < 16; ++pp) { const int p = p0 + pp; const float tn = (float)p * (1.0f / 4095.0f); const float val = acc[pp] * expf(-tn * delta);
                if (dir == 0) { Kraw[(size_t)c * 8192 + 4096 + p] = val; ssq += val * val; }
                else if (p >= 1) { Kraw[(size_t)c * 8192 + 4096 - p] = val; ssq += val * val; } }
            SSQ[pg * 1024 + o] = ssq;
            if (pg == 0 && dir == 0) Kraw[(size_t)c * 8192] = 0.f; }
        __syncthreads();
    }
}

__device__ __forceinline__ void p0_mod(const Args& a, unsigned char* lds) {
    float* sc = (float*)lds;
    float* red = sc + 9 * 1024;
    const int tid = threadIdx.x;
    if ((int)blockIdx.x >= 192) return;
    for (int i = tid; i < 9 * 1024; i += NTHR) { const float v = (i < 8192) ? a.in[I_C][i] : a.in[I_CCTX][i - 8192]; sc[i] = siluf(v); }
    __syncthreads();
    const float* wa = a.in[I_WADA]; const float* ba = a.in[I_BADA]; float* mod = (float*)(a.ws + WS_MOD);
    for (int it = blockIdx.x; it < 192; it += gridDim.x) {
        const int col = tid & 31, ks = tid >> 5, c0 = it * 32; float acc[9];
#pragma unroll
        for (int r = 0; r < 9; ++r) acc[r] = 0.f;
#pragma unroll 4
        for (int k = ks * 64; k < ks * 64 + 64; ++k) { const float w = wa[(size_t)k * MODW + c0 + col];
#pragma unroll
            for (int r = 0; r < 9; ++r) acc[r] += sc[r * 1024 + k] * w; }
#pragma unroll
        for (int r = 0; r < 9; ++r) red[(ks * 9 + r) * 32 + col] = acc[r];
        __syncthreads();
        if (tid < 288) { const int r = tid >> 5, cc = tid & 31; float s = ba[c0 + cc];
            for (int k2 = 0; k2 < 16; ++k2) s += red[(k2 * 9 + r) * 32 + cc];
            mod[r * MODW + c0 + cc] = s; }
        __syncthreads();
    }
}

__device__ __forceinline__ void p0_prologue(const Args& a, unsigned char* lds) {
    const int tid = threadIdx.x, lane = tid & 63, wave = tid >> 6;
    p0_filter(a, lds);
    __syncthreads();
    p0_mod(a, lds);
    __syncthreads();
    { v4u* z = (v4u*)((bf16*)(a.ws + WS_WIN) + (size_t)NIN * DM); const int n16 = (NINP - NIN) * DM * 2 / 16;
      for (int i = blockIdx.x * NTHR + tid; i < n16; i += gridDim.x * NTHR) z[i] = (v4u){0u, 0u, 0u, 0u}; }
    float* scr = (float*)(lds + wave * 16384);
    const int gw = blockIdx.x * NWAVES + wave, NGW = gridDim.x * NWAVES;
    constexpr int I_IN = (DM / 64) * (NIN / 32), I_O = (DM / 64) * (DM / 32), I_1 = (DM / 64) * (FF / 32), I_2 = (FF / 64) * (DM / 32);
    constexpr int NITEMS = I_IN + I_O + I_1 + I_2;
    for (int it = gw; it < NITEMS; it += NGW) {
        int r = it;
        if (r < I_IN) { p0_transpose_item(a.in[I_WIN], DM, NIN, (bf16*)(a.ws + WS_WIN), 0, scr, r, lane); continue; } r -= I_IN;
        if (r < I_O) { p0_transpose_item(a.in[I_WOUT], DM, DM, (bf16*)(a.ws + WS_WOUT), 0, scr, r, lane); continue; } r -= I_O;
        if (r < I_1) { p0_transpose_item(a.in[I_WM1], DM, FF, (bf16*)(a.ws + WS_W1), 0, scr, r, lane); continue; } r -= I_1;
        p0_transpose_item(a.in[I_WM2], FF, DM, (bf16*)(a.ws + WS_W2), 0, scr, r, lane);
    }
}

__device__ __forceinline__ void norm_mod_rows(const Args& a, const float* src_lat, const float* src_ctx, int nrows, const float* g, int sc_off, int sh_off, bf16* dst) {
    const int tid = threadIdx.x, lane = tid & 63, wave = tid >> 6;
    const int gw = blockIdx.x * NWAVES + wave, NGW = gridDim.x * NWAVES;
    const float* mod = (const float*)(a.ws + WS_MOD);
    for (int row = gw; row < nrows; row += NGW) {
        const float* src = row < MLAT ? src_lat + (size_t)row * DM : src_ctx + (size_t)(row - MLAT) * DM;
        const int mrow = row < MLAT ? row / SEQ : 8;
        const f32x4* xr = (const f32x4*)src + lane;
        f32x4 v[4]; float s = 0.f;
#pragma unroll
        for (int j = 0; j < 4; ++j) { v[j] = xr[64 * j]; s += (v[j].x * v[j].x + v[j].y * v[j].y) + (v[j].z * v[j].z + v[j].w * v[j].w); }
        const float rstd = rsqrtf(wave_sum(s) * (1.f / DM) + EPSF);
        unsigned long long* o8 = (unsigned long long*)(dst + (size_t)row * DM) + lane;
#pragma unroll
        for (int j = 0; j < 4; ++j) { const int col = 256 * j + 4 * lane;
            const f32x4 gg = *(const f32x4*)(g + col), scv = *(const f32x4*)(mod + mrow * MODW + sc_off + col), shv = *(const f32x4*)(mod + mrow * MODW + sh_off + col);
            const f32x4 y = (v[j] * rstd * gg) * (scv + 1.f) + shv;
            o8[64 * j] = (unsigned long long)pk2(y.x, y.y) | ((unsigned long long)pk2(y.z, y.w) << 32); }
    }
}
__device__ __forceinline__ void final_norm_rows(const Args& a) {
    const int tid = threadIdx.x, lane = tid & 63, wave = tid >> 6;
    const int gw = blockIdx.x * NWAVES + wave, NGW = gridDim.x * NWAVES;
    const float* g = a.in[I_NFIN];
    for (int row = gw; row < MLAT; row += NGW) {
        f32x4* xr = (f32x4*)(a.out + (size_t)row * DM) + lane;
        f32x4 v[4]; float s = 0.f;
#pragma unroll
        for (int j = 0; j < 4; ++j) { v[j] = xr[64 * j]; s += (v[j].x * v[j].x + v[j].y * v[j].y) + (v[j].z * v[j].z + v[j].w * v[j].w); }
        const float rstd = rsqrtf(wave_sum(s) * (1.f / DM) + EPSF);
#pragma unroll
        for (int j = 0; j < 4; ++j) { const f32x4 gg = *(const f32x4*)(g + 256 * j + 4 * lane); xr[64 * j] = v[j] * rstd * gg; }
    }
}

constexpr int L_GR = 0, L_WG = 1024, L_BG = 2048, L_TOT = 2112, L_BC = 2176, L_KE = L_BC + 4096, L_KI = L_KE + 64 * 65, L_ATT = L_KI + 64 * 65, L_V = L_ATT + 64 * 65, L_S = L_V + 64 * 128, L_END = L_S + 128 * 65;
static_assert(L_END * 4 <= LDS_BYTES, "GLA LDS map");

__device__ __forceinline__ void gla_gate_cumsum(const Args& a, float* L, const bf16* gp, size_t row0, int h, int dir) {
    const int tid = threadIdx.x;
    const float* gkw = a.in[dir ? I_GKWB : I_GKWF]; const float* gkb = a.in[dir ? I_GKBB : I_GKBF];
    for (int i = tid; i < 1024; i += NTHR) { const int tok = i >> 4, r = i & 15; L[L_GR + i] = bf2f(gp[(row0 + tok) * NGL + GGF + dir * 16 + r]); }
    for (int i = tid; i < 1024; i += NTHR) { const int r = i >> 6, d = i & 63; L[L_WG + i] = gkw[r * 256 + h * 64 + d]; }
    if (tid < 64) L[L_BG + tid] = gkb[h * 64 + tid];
    __syncthreads();
    for (int i = tid; i < 4096; i += NTHR) { const int tok = i >> 6, d = i & 63; float acc = L[L_BG + d];
#pragma unroll
        for (int r = 0; r < 16; ++r) acc += L[L_GR + tok * 16 + r] * L[L_WG + r * 64 + d];
        L[L_BC + i] = logsigmoidf(acc) * (1.0f / 16.0f); }
    __syncthreads();
    if (tid < 64) { float run = 0.f;
        if (dir == 0) { for (int tok = 0; tok < 64; ++tok) { run += L[L_BC + tok * 64 + tid]; L[L_BC + tok * 64 + tid] = run; } }
        else { for (int tok = 63; tok >= 0; --tok) { run += L[L_BC + tok * 64 + tid]; L[L_BC + tok * 64 + tid] = run; } }
        L[L_TOT + tid] = run; }
    __syncthreads();
}

__device__ __forceinline__ size_t gla_chunk_row0(int b, int dir, int sig) {
    if (sig < 4) { const int cc = dir == 0 ? sig : 3 - sig; return (size_t)MLAT + b * CTXL + cc * 64; }
    const int n = dir == 0 ? sig - 4 : 67 - sig; return (size_t)b * SEQ + n * 64;
}

__device__ __forceinline__ void gla_local(const Args& a, unsigned char* lds) {
    float* L = (float*)lds; const int tid = threadIdx.x;
    const bf16* gp = (const bf16*)(a.ws + WS_GPROJ); bf16* ST = (bf16*)(a.ws + WS_XN); float* DEC = (float*)(a.ws + WS_DEC);
    for (int item = blockIdx.x; item < NITEM; item += gridDim.x) {
        const int sig = item % NSIG, chain = item / NSIG, dir = chain & 1, h = (chain >> 1) & 3, b = chain >> 3;
        const size_t row0 = gla_chunk_row0(b, dir, sig);
        gla_gate_cumsum(a, L, gp, row0, h, dir);
        for (int i = tid; i < 4096; i += NTHR) { const int tok = i >> 6, d = i & 63;
            L[L_KE + tok * 65 + d] = bf2f(gp[(row0 + tok) * NGL + GK + h * 64 + d]) * __expf(L[L_TOT + d] - L[L_BC + i]); }
        for (int i = tid; i < 8192; i += NTHR) { const int tok = i >> 7, e = i & 127; L[L_V + i] = bf2f(gp[(row0 + tok) * NGL + GV + h * 128 + e]); }
        __syncthreads();
        { const int d = tid & 63, e0 = (tid >> 6) * 16; float acc[16];
#pragma unroll
          for (int i = 0; i < 16; ++i) acc[i] = 0.f;
          for (int tok = 0; tok < 64; ++tok) { const float ke = L[L_KE + tok * 65 + d];
#pragma unroll
              for (int i = 0; i < 16; ++i) acc[i] += L[L_V + tok * 128 + e0 + i] * ke; }
#pragma unroll
          for (int i = 0; i < 16; ++i) ST[(size_t)item * 8192 + (e0 + i) * 64 + d] = (bf16)f2bf(acc[i]);
          if (tid < 64) DEC[item * 64 + tid] = __expf(L[L_TOT + tid]); }
        __syncthreads();
    }
}

__device__ __forceinline__ void gla_scan(const Args& a) {
    bf16* ST = (bf16*)(a.ws + WS_XN); const float* DEC = (const float*)(a.ws + WS_DEC);
    for (int w = blockIdx.x * NTHR + threadIdx.x; w < 64 * 1024; w += gridDim.x * NTHR) {
        const int chain = w >> 10, el = (w & 1023) * 8, d0 = el & 63; float s[8];
#pragma unroll
        for (int i = 0; i < 8; ++i) s[i] = 0.f;
#pragma unroll 4
        for (int sig = 0; sig < NSIG; ++sig) { const size_t item = (size_t)chain * NSIG + sig;
            v4u* p = (v4u*)(ST + item * 8192 + el); const v4u dsv = *p;
            const f32x4 d0v = *(const f32x4*)(DEC + item * 64 + d0), d1v = *(const f32x4*)(DEC + item * 64 + d0 + 4);
            v4u o; o.x = pk2(s[0], s[1]); o.y = pk2(s[2], s[3]); o.z = pk2(s[4], s[5]); o.w = pk2(s[6], s[7]); *p = o;
            s[0] = d0v.x * s[0] + bf2f(dsv.x & 0xffffu); s[1] = d0v.y * s[1] + bf2f(dsv.x >> 16);
            s[2] = d0v.z * s[2] + bf2f(dsv.y & 0xffffu); s[3] = d0v.w * s[3] + bf2f(dsv.y >> 16);
            s[4] = d1v.x * s[4] + bf2f(dsv.z & 0xffffu); s[5] = d1v.y * s[5] + bf2f(dsv.z >> 16);
            s[6] = d1v.z * s[6] + bf2f(dsv.w & 0xffffu); s[7] = d1v.w * s[7] + bf2f(dsv.w >> 16); }
    }
}

__device__ __forceinline__ void gla_out(const Args& a, unsigned char* lds) {
    float* L = (float*)lds; const int tid = threadIdx.x, lane = tid & 63, wave = tid >> 6;
    const bf16* gp = (const bf16*)(a.ws + WS_GPROJ); const bf16* ST = (const bf16*)(a.ws + WS_XN); bf16* ycat = (bf16*)(a.ws + WS_YCAT);
    const float* gn = a.in[I_GLAN];
    for (int it = blockIdx.x; it < NB * 4 * 64; it += gridDim.x) {
        const int n = it & 63, h = (it >> 6) & 3, b = it >> 8; const size_t row0 = (size_t)b * SEQ + n * 64;
        const int e = tid & 127, c0 = (tid >> 7) * 16; float o[16];
#pragma unroll
        for (int i = 0; i < 16; ++i) o[i] = 0.f;
        for (int dir = 0; dir < 2; ++dir) {
            gla_gate_cumsum(a, L, gp, row0, h, dir);
            const int sig = dir == 0 ? n + 4 : 67 - n; const size_t item = (size_t)((b * 4 + h) * 2 + dir) * NSIG + sig;
            for (int i = tid; i < 4096; i += NTHR) { const int tok = i >> 6, d = i & 63; const float bc = L[L_BC + i];
                L[L_KE + tok * 65 + d] = bf2f(gp[(row0 + tok) * NGL + GQ + h * 64 + d]) * 0.125f * __expf(bc);
                L[L_KI + tok * 65 + d] = bf2f(gp[(row0 + tok) * NGL + GK + h * 64 + d]) * __expf(-bc); }
            if (dir == 0) for (int i = tid; i < 8192; i += NTHR) { const int tok = i >> 7, ee = i & 127; L[L_V + i] = bf2f(gp[(row0 + tok) * NGL + GV + h * 128 + ee]); }
            for (int i = tid; i < 8192; i += NTHR) { const int ee = i >> 6, d = i & 63; L[L_S + ee * 65 + d] = bf2f(ST[item * 8192 + i]); }
            __syncthreads();
            { const int s = tid & 63, ca = (tid >> 6) * 8; float acc[8];
#pragma unroll
              for (int i = 0; i < 8; ++i) acc[i] = 0.f;
              for (int d = 0; d < 64; ++d) { const float ki = L[L_KI + s * 65 + d];
#pragma unroll
                  for (int i = 0; i < 8; ++i) acc[i] += L[L_KE + (ca + i) * 65 + d] * ki; }
#pragma unroll
              for (int i = 0; i < 8; ++i) { const int c = ca + i; const bool keep = dir == 0 ? (s <= c) : (s >= c); L[L_ATT + c * 65 + s] = keep ? acc[i] : 0.f; } }
            __syncthreads();
            for (int s = 0; s < 64; ++s) { const float vv = L[L_V + s * 128 + e];
#pragma unroll
                for (int i = 0; i < 16; ++i) o[i] += L[L_ATT + (c0 + i) * 65 + s] * vv; }
            for (int d = 0; d < 64; ++d) { const float sv = L[L_S + e * 65 + d];
#pragma unroll
                for (int i = 0; i < 16; ++i) o[i] += L[L_KE + (c0 + i) * 65 + d] * sv; }
            __syncthreads();
        }
        float* OB = L + L_KE;
#pragma unroll
        for (int i = 0; i < 16; ++i) OB[(c0 + i) * 128 + e] = o[i];
        __syncthreads();
        for (int j = 0; j < 8; ++j) { const int c = wave * 8 + j; const float v0 = OB[c * 128 + lane], v1 = OB[c * 128 + 64 + lane];
            const float rstd = rsqrtf(wave_sum(v0 * v0 + v1 * v1) * (1.f / 128.f) + EPSF);
            const size_t row = row0 + c;
            const float g0 = bf2f(gp[row * NGL + GOG + h * 128 + lane]), g1 = bf2f(gp[row * NGL + GOG + h * 128 + 64 + lane]);
            ycat[row * DM + DH + h * 128 + lane] = (bf16)f2bf(v0 * rstd * gn[lane] * siluf(g0));
            ycat[row * DM + DH + h * 128 + 64 + lane] = (bf16)f2bf(v1 * rstd * gn[64 + lane] * siluf(g1)); }
        __syncthreads();
    }
}

typedef short gbf16x8 __attribute__((ext_vector_type(8)));
typedef float gf32x16 __attribute__((ext_vector_type(16)));
constexpr int GL_ROWB = 144;
constexpr int GL_GR = 0;
constexpr int GL_WG = GL_GR + 64 * 17 * 4;
constexpr int GL_BG = GL_WG + 4096;
constexpr int GL_TOT = GL_BG + 256;
constexpr int GL_BCT = GL_TOT + 256;
constexpr int GL_QI = GL_BCT + 64 * 65 * 4;
constexpr int GL_KI = GL_QI + 2 * 64 * GL_ROWB;
constexpr int GL_ATT = GL_KI + 2 * 64 * GL_ROWB;
constexpr int GL_VT = GL_ATT + 2 * 64 * GL_ROWB;
constexpr int GL_OB = GL_VT + 128 * GL_ROWB;
constexpr int GL_END = GL_OB + 64 * 132 * 4;
static_assert(GL_END <= LDS_BYTES && GL_GR % 16 == 0 && GL_QI % 16 == 0 && GL_KI % 16 == 0 && GL_ATT % 16 == 0 && GL_VT % 16 == 0 && GL_OB % 16 == 0, "GLA LDS map");

__device__ __forceinline__ void gla_gates(const Args& a, LAS unsigned char* L, const bf16* gp, size_t row0, int h, int dir) {
    const int tid = threadIdx.x;
    LAS float* GR = (LAS float*)(L + GL_GR); LAS float* WG = (LAS float*)(L + GL_WG); LAS float* BG = (LAS float*)(L + GL_BG); LAS float* TOT = (LAS float*)(L + GL_TOT); LAS float* BCT = (LAS float*)(L + GL_BCT);
    const float* gkw = a.in[dir ? I_GKWB : I_GKWF]; const float* gkb = a.in[dir ? I_GKBB : I_GKBF];
    for (int i = tid; i < 1024; i += NTHR) { const int tok = i >> 4, r = i & 15; GR[tok * 17 + r] = bf2f(gp[(row0 + tok) * NGL + GGF + dir * 16 + r]); }
    for (int i = tid; i < 1024; i += NTHR) { const int r = i >> 6, d = i & 63; WG[i] = gkw[r * 256 + h * 64 + d]; }
    if (tid < 64) BG[tid] = gkb[h * 64 + tid];
    __syncthreads();
    for (int i = tid; i < 4096; i += NTHR) { const int tok = i & 63, d = i >> 6; float acc = BG[d];
#pragma unroll
        for (int r = 0; r < 16; ++r) acc += GR[tok * 17 + r] * WG[r * 64 + d];
        BCT[d * 65 + tok] = logsigmoidf(acc) * (1.0f / 16.0f); }
    __syncthreads();
    { const int d = tid >> 3, seg = tid & 7; float v[8]; float run = 0.f;
#pragma unroll
      for (int j = 0; j < 8; ++j) { const int tp = seg * 8 + j, tok = dir ? 63 - tp : tp; run += BCT[d * 65 + tok]; v[j] = run; }
      float inc = run;
#pragma unroll
      for (int o = 1; o < 8; o <<= 1) { const float t = __shfl_up(inc, o, 8); if (seg >= o) inc += t; }
      const float excl = inc - run;
#pragma unroll
      for (int j = 0; j < 8; ++j) { const int tp = seg * 8 + j, tok = dir ? 63 - tp : tp; BCT[d * 65 + tok] = v[j] + excl; }
      if (seg == 7) TOT[d] = inc; }
    __syncthreads();
}
__device__ __forceinline__ void gla_fill_vt(LAS unsigned char* L, const bf16* gp, size_t row0, int h) {
    const int tid = threadIdx.x, s = tid & 63;
#pragma unroll
    for (int it = 0; it < 2; ++it) { const int eg = (tid >> 6) + 8 * it;
        const v4u r = *(const v4u*)(gp + (row0 + s) * NGL + GV + h * 128 + eg * 8);
        LAS bf16* vt = (LAS bf16*)(L + GL_VT) + (eg * 8) * 72 + s;
        vt[0 * 72] = (bf16)(r.x & 0xffffu); vt[1 * 72] = (bf16)(r.x >> 16); vt[2 * 72] = (bf16)(r.y & 0xffffu); vt[3 * 72] = (bf16)(r.y >> 16);
        vt[4 * 72] = (bf16)(r.z & 0xffffu); vt[5 * 72] = (bf16)(r.z >> 16); vt[6 * 72] = (bf16)(r.w & 0xffffu); vt[7 * 72] = (bf16)(r.w >> 16); }
}
__device__ __forceinline__ gbf16x8 gl_frag(const LAS unsigned char* p) { return __builtin_bit_cast(gbf16x8, *(const LAS v4u*)p); }

__device__ __forceinline__ size_t gla_item(int b, int h, int dir, int ck) {
    const int sig = ck < 4 ? (dir == 0 ? ck : 3 - ck) : (dir == 0 ? ck : 71 - ck);
    return (size_t)((b * 4 + h) * 2 + dir) * NSIG + sig;
}
__device__ __forceinline__ void gla_local_mfma(const Args& a, unsigned char* lds) {
    LAS unsigned char* L = (LAS unsigned char*)lds;
    const int tid = threadIdx.x, lane = tid & 63, wave = __builtin_amdgcn_readfirstlane(tid >> 6), r = lane & 31, hh = lane >> 5;
    const bf16* gp = (const bf16*)(a.ws + WS_GPROJ); bf16* ST = (bf16*)(a.ws + WS_XN); float* DEC = (float*)(a.ws + WS_DEC);
    LAS float* TOT = (LAS float*)(L + GL_TOT); LAS float* BCT = (LAS float*)(L + GL_BCT);
    for (int ci = blockIdx.x; ci < NB * 4 * NSIG; ci += gridDim.x) {
        const int ck = ci % NSIG, h = (ci / NSIG) & 3, b = ci / (NSIG * 4);
        const size_t row0 = ck < 4 ? (size_t)MLAT + b * CTXL + ck * 64 : (size_t)b * SEQ + (ck - 4) * 64;
        for (int dir = 0; dir < 2; ++dir) {
            const size_t item_d = gla_item(b, h, dir, ck);
            gla_gates(a, L, gp, row0, h, dir);
            { const int s = tid & 63, dg = tid >> 6; const v4u kr = *(const v4u*)(gp + (row0 + s) * NGL + GK + h * 64 + dg * 8);
              float kv[8]; kv[0] = bf2f(kr.x & 0xffffu); kv[1] = bf2f(kr.x >> 16); kv[2] = bf2f(kr.y & 0xffffu); kv[3] = bf2f(kr.y >> 16); kv[4] = bf2f(kr.z & 0xffffu); kv[5] = bf2f(kr.z >> 16); kv[6] = bf2f(kr.w & 0xffffu); kv[7] = bf2f(kr.w >> 16);
              LAS bf16* ke = (LAS bf16*)(L + GL_QI + dir * 64 * GL_ROWB);
#pragma unroll
              for (int i = 0; i < 8; ++i) { const int d = dg * 8 + i; ke[d * 72 + s] = (bf16)f2bf(kv[i] * __expf(TOT[d] - BCT[d * 65 + s])); } }
            if (tid < 64) DEC[item_d * 64 + tid] = __expf(TOT[tid]);
            if (dir == 0) gla_fill_vt(L, gp, row0, h);
            __syncthreads();
        }
#pragma unroll
        for (int j = 0; j < 2; ++j) { const int tile = 2 * wave + j, dir = tile >> 3, mt = (tile >> 1) & 3, nt = tile & 1;
            gf32x16 acc;
#pragma unroll
            for (int i = 0; i < 16; ++i) acc[i] = 0.f;
            const LAS unsigned char* ap = L + GL_VT + (mt * 32 + r) * GL_ROWB + 16 * hh;
            const LAS unsigned char* bp = L + GL_QI + dir * 64 * GL_ROWB + (nt * 32 + r) * GL_ROWB + 16 * hh;
#pragma unroll
            for (int kk = 0; kk < 4; ++kk) acc = __builtin_amdgcn_mfma_f32_32x32x16_bf16(gl_frag(ap + 32 * kk), gl_frag(bp + 32 * kk), acc, 0, 0, 0);
            bf16* sp = ST + gla_item(b, h, dir, ck) * 8192 + nt * 32 + r;
#pragma unroll
            for (int i = 0; i < 16; ++i) { const int e = mt * 32 + (i & 3) + 8 * (i >> 2) + 4 * hh; sp[e * 64] = (bf16)f2bf(acc[i]); } }
        __syncthreads();
    }
}

__device__ __forceinline__ void gla_out_mfma(const Args& a, unsigned char* lds) {
    LAS unsigned char* L = (LAS unsigned char*)lds;
    const int tid = threadIdx.x, lane = tid & 63, wave = __builtin_amdgcn_readfirstlane(tid >> 6), r = lane & 31, hh = lane >> 5;
    const bf16* gp = (const bf16*)(a.ws + WS_GPROJ); const bf16* ST = (const bf16*)(a.ws + WS_XN); bf16* ycat = (bf16*)(a.ws + WS_YCAT);
    const float* gn = a.in[I_GLAN];
    LAS float* BCT = (LAS float*)(L + GL_BCT); LAS float* OB = (LAS float*)(L + GL_OB);
    for (int it = blockIdx.x; it < NB * 4 * 64; it += gridDim.x) {
        const int n = it & 63, h = (it >> 6) & 3, b = it >> 8; const size_t row0 = (size_t)b * SEQ + n * 64;
        for (int dir = 0; dir < 2; ++dir) {
            gla_gates(a, L, gp, row0, h, dir);
            { const int s = tid & 63, dg = tid >> 6;
              const v4u qr = *(const v4u*)(gp + (row0 + s) * NGL + GQ + h * 64 + dg * 8), kr = *(const v4u*)(gp + (row0 + s) * NGL + GK + h * 64 + dg * 8);
              float qv[8], kv[8];
              qv[0] = bf2f(qr.x & 0xffffu); qv[1] = bf2f(qr.x >> 16); qv[2] = bf2f(qr.y & 0xffffu); qv[3] = bf2f(qr.y >> 16); qv[4] = bf2f(qr.z & 0xffffu); qv[5] = bf2f(qr.z >> 16); qv[6] = bf2f(qr.w & 0xffffu); qv[7] = bf2f(qr.w >> 16);
              kv[0] = bf2f(kr.x & 0xffffu); kv[1] = bf2f(kr.x >> 16); kv[2] = bf2f(kr.y & 0xffffu); kv[3] = bf2f(kr.y >> 16); kv[4] = bf2f(kr.z & 0xffffu); kv[5] = bf2f(kr.z >> 16); kv[6] = bf2f(kr.w & 0xffffu); kv[7] = bf2f(kr.w >> 16);
              float qo[8], ko[8];
#pragma unroll
              for (int i = 0; i < 8; ++i) { const float bc = BCT[(dg * 8 + i) * 65 + s]; qo[i] = qv[i] * 0.125f * __expf(bc); ko[i] = kv[i] * __expf(-bc); }
              v4u qw, kw; qw.x = pk2(qo[0], qo[1]); qw.y = pk2(qo[2], qo[3]); qw.z = pk2(qo[4], qo[5]); qw.w = pk2(qo[6], qo[7]);
              kw.x = pk2(ko[0], ko[1]); kw.y = pk2(ko[2], ko[3]); kw.z = pk2(ko[4], ko[5]); kw.w = pk2(ko[6], ko[7]);
              *(LAS v4u*)(L + GL_QI + dir * 64 * GL_ROWB + s * GL_ROWB + dg * 16) = qw;
              *(LAS v4u*)(L + GL_KI + dir * 64 * GL_ROWB + s * GL_ROWB + dg * 16) = kw; }
            if (dir == 0) gla_fill_vt(L, gp, row0, h);
            __syncthreads();
        }
        { const int dir = wave >> 2, mt = (wave >> 1) & 1, nt = wave & 1;
          gf32x16 acc;
#pragma unroll
          for (int i = 0; i < 16; ++i) acc[i] = 0.f;
          const LAS unsigned char* ap = L + GL_QI + dir * 64 * GL_ROWB + (mt * 32 + r) * GL_ROWB + 16 * hh;
          const LAS unsigned char* bp = L + GL_KI + dir * 64 * GL_ROWB + (nt * 32 + r) * GL_ROWB + 16 * hh;
#pragma unroll
          for (int kk = 0; kk < 4; ++kk) acc = __builtin_amdgcn_mfma_f32_32x32x16_bf16(gl_frag(ap + 32 * kk), gl_frag(bp + 32 * kk), acc, 0, 0, 0);
          LAS bf16* at = (LAS bf16*)(L + GL_ATT + dir * 64 * GL_ROWB); const int s = nt * 32 + r;
#pragma unroll
          for (int i = 0; i < 16; ++i) { const int c = mt * 32 + (i & 3) + 8 * (i >> 2) + 4 * hh; const bool keep = dir == 0 ? (s <= c) : (s >= c);
              at[c * 72 + s] = (bf16)f2bf(keep ? acc[i] : 0.f); } }
        __syncthreads();
        { const int mt = wave >> 2, nt = wave & 3;
          gf32x16 acc;
#pragma unroll
          for (int i = 0; i < 16; ++i) acc[i] = 0.f;
#pragma unroll
          for (int dir = 0; dir < 2; ++dir) {
              const int sig = dir == 0 ? n + 4 : 67 - n; const size_t item = (size_t)((b * 4 + h) * 2 + dir) * NSIG + sig;
              const LAS unsigned char* ap = L + GL_ATT + dir * 64 * GL_ROWB + (mt * 32 + r) * GL_ROWB + 16 * hh;
              const LAS unsigned char* bp = L + GL_VT + (nt * 32 + r) * GL_ROWB + 16 * hh;
#pragma unroll
              for (int kk = 0; kk < 4; ++kk) acc = __builtin_amdgcn_mfma_f32_32x32x16_bf16(gl_frag(ap + 32 * kk), gl_frag(bp + 32 * kk), acc, 0, 0, 0);
              const LAS unsigned char* qp = L + GL_QI + dir * 64 * GL_ROWB + (mt * 32 + r) * GL_ROWB + 16 * hh;
              const bf16* sp = ST + item * 8192 + (nt * 32 + r) * 64 + 8 * hh;
#pragma unroll
              for (int kk = 0; kk < 4; ++kk) acc = __builtin_amdgcn_mfma_f32_32x32x16_bf16(gl_frag(qp + 32 * kk), __builtin_bit_cast(gbf16x8, *(const v4u*)(sp + 16 * kk)), acc, 0, 0, 0);
          }
#pragma unroll
          for (int i = 0; i < 16; ++i) { const int c = mt * 32 + (i & 3) + 8 * (i >> 2) + 4 * hh; OB[c * 132 + nt * 32 + r] = acc[i]; } }
        __syncthreads();
        for (int j = 0; j < 8; ++j) { const int c = wave * 8 + j; const float v0 = OB[c * 132 + lane], v1 = OB[c * 132 + 64 + lane];
            const float rstd = rsqrtf(wave_sum(v0 * v0 + v1 * v1) * (1.f / 128.f) + EPSF);
            const size_t row = row0 + c;
            const float g0 = bf2f(gp[row * NGL + GOG + h * 128 + lane]), g1 = bf2f(gp[row * NGL + GOG + h * 128 + 64 + lane]);
            ycat[row * DM + DH + h * 128 + lane] = (bf16)f2bf(v0 * rstd * gn[lane] * siluf(g0));
            ycat[row * DM + DH + h * 128 + 64 + lane] = (bf16)f2bf(v1 * rstd * gn[64 + lane] * siluf(g1)); }
        __syncthreads();
    }
}

__device__ __forceinline__ float hy_sconv(const bf16* hyT, int ch, int col, float w0, float w1, float w2, float cb) {
    const int tt = col & 63; const bf16* p = hyT + (size_t)ch * MLAT + col;
    const float h0 = bf2f(p[0]), hm = tt > 0 ? bf2f(p[-1]) : 0.f, hp = tt < 63 ? bf2f(p[1]) : 0.f;
    return cb + w0 * hm + w1 * h0 + w2 * hp;
}
__device__ __forceinline__ void hyena_conv(const Args& a, unsigned char* lds) {
    float* KL = (float*)lds;
    bf16* Z = (bf16*)(lds + 32768);
    float* RED = (float*)(lds + 32768 + 65536);
    const int tid = threadIdx.x, lane = tid & 63, wave = tid >> 6;
    const bf16* hyT = (const bf16*)(a.ws + WS_HYT); bf16* yT = (bf16*)(a.ws + WS_YT);
    const float* Kraw = (const float*)(a.ws + WS_KRAW); const float* SSQ = (const float*)(a.ws + WS_SSQ);
    const float* cw = a.in[I_CONVW]; const float* cbv = a.in[I_CONVB];
    for (int c = blockIdx.x; c < DH; c += gridDim.x) {
        { const float part = SSQ[(tid >> 1) * 1024 + (tid & 1) * 512 + c]; const float ws = wave_sum(part); if (lane == 0) RED[wave] = ws; }
        __syncthreads();
        float tot = 0.f;
#pragma unroll
        for (int i = 0; i < 8; ++i) tot += RED[i];
        const float sc = rsqrtf(tot + EPSF);
        for (int i = tid; i < 8192; i += NTHR) KL[i] = Kraw[(size_t)c * 8192 + i] * sc;
        { const int c1 = DH + c, c2 = 2 * DH + c;
          const float a0 = cw[c1], a1 = cw[NHY + c1], a2 = cw[2 * NHY + c1], ab = cbv[c1], b0 = cw[c2], b1 = cw[NHY + c2], b2 = cw[2 * NHY + c2], bb = cbv[c2];
          for (int i = tid; i < MLAT; i += NTHR) Z[i] = (bf16)f2bf(hy_sconv(hyT, c1, i, a0, a1, a2, ab) * hy_sconv(hyT, c2, i, b0, b1, b2, bb)); }
        __syncthreads();
        float acc[8][8];
#pragma unroll
        for (int j = 0; j < 8; ++j)
#pragma unroll
            for (int b = 0; b < 8; ++b) acc[j][b] = 0.f;
        const unsigned* Z2 = (const unsigned*)Z;
        for (int s2 = 0; s2 < 2048; ++s2) { float zl[8], zh[8];
#pragma unroll
            for (int b = 0; b < 8; ++b) { const unsigned zz = Z2[b * 2048 + s2]; zl[b] = bf2f(zz & 0xffffu); zh[b] = bf2f(zz >> 16); }
#pragma unroll
            for (int j = 0; j < 8; ++j) { const int base = tid + 512 * j - 2 * s2 + 4096; const float k0 = KL[base], k1 = KL[base - 1];
#pragma unroll
                for (int b = 0; b < 8; ++b) acc[j][b] += k0 * zl[b] + k1 * zh[b]; } }
        { const float w0 = cw[c], w1 = cw[NHY + c], w2 = cw[2 * NHY + c], wb = cbv[c], hb = a.in[I_HBIAS][c];
#pragma unroll
          for (int j = 0; j < 8; ++j)
#pragma unroll
              for (int b = 0; b < 8; ++b) { const int col = b * SEQ + tid + 512 * j; const float x0 = hy_sconv(hyT, c, col, w0, w1, w2, wb);
                  yT[(size_t)c * MLAT + col] = (bf16)f2bf(x0 * (acc[j][b] + hb * bf2f(Z[col]))); } }
        __syncthreads();
    }
}
typedef short hbf16x8 __attribute__((ext_vector_type(8)));
typedef float hf32x16 __attribute__((ext_vector_type(16)));
constexpr int HK_COPYB = 16448, HK_OFF = 0, HZ_OFF = 4 * HK_COPYB, HZ_ROWB = 8208, HZERO_OFF = HZ_OFF + 8 * HZ_ROWB, HRED_OFF = HZERO_OFF + 64;
static_assert(HRED_OFF + 64 <= LDS_BYTES && 8 * HZ_ROWB <= 4 * HK_COPYB, "hyena LDS map");
__device__ __forceinline__ void hy_unpack8(const v4u r, float* o) {
    o[0] = bf2f(r.x & 0xffffu); o[1] = bf2f(r.x >> 16); o[2] = bf2f(r.y & 0xffffu); o[3] = bf2f(r.y >> 16);
    o[4] = bf2f(r.z & 0xffffu); o[5] = bf2f(r.z >> 16); o[6] = bf2f(r.w & 0xffffu); o[7] = bf2f(r.w >> 16);
}
__device__ __forceinline__ void hyena_conv_mfma(const Args& a, unsigned char* lds) {
    LAS unsigned char* L = (LAS unsigned char*)lds;
    const int tid = threadIdx.x, lane = tid & 63, wave = __builtin_amdgcn_readfirstlane(tid >> 6), r = lane & 31, h = lane >> 5;
    const bf16* hyT = (const bf16*)(a.ws + WS_HYT); bf16* yT = (bf16*)(a.ws + WS_YT);
    const float* Kraw = (const float*)(a.ws + WS_KRAW); const float* SSQ = (const float*)(a.ws + WS_SSQ);
    const float* cw = a.in[I_CONVW]; const float* cbv = a.in[I_CONVB];
    LAS float* RED = (LAS float*)(L + HRED_OFF);
    for (int c = blockIdx.x; c < DH; c += gridDim.x) {
        { const float part = SSQ[(tid >> 1) * 1024 + (tid & 1) * 512 + c]; const float ws = wave_sum(part); if (lane == 0) RED[wave] = ws; }
        __syncthreads();
        float tot = 0.f;
#pragma unroll
        for (int i = 0; i < 8; ++i) tot += RED[i];
        const float sc = rsqrtf(tot + EPSF);
        for (int idx = tid; idx < 4 * 4096; idx += NTHR) { const int s = idx >> 12, y = (idx & 4095) * 2, x = y + s;
            const float v0 = (x >= 1 && x <= 8191) ? Kraw[(size_t)c * 8192 + 8192 - x] * sc : 0.f;
            const float v1 = (x + 1 <= 8191) ? Kraw[(size_t)c * 8192 + 8191 - x] * sc : 0.f;
            *(LAS unsigned*)(L + HK_OFF + s * HK_COPYB + 2 * y) = pk2(v0, v1); }
        if (tid < 4) ((LAS unsigned*)(L + HZERO_OFF))[tid] = 0u;
        { const int c1 = DH + c, c2 = 2 * DH + c;
          const float a0 = cw[c1], a1 = cw[NHY + c1], a2 = cw[2 * NHY + c1], ab = cbv[c1], b0 = cw[c2], b1 = cw[NHY + c2], b2 = cw[2 * NHY + c2], bb = cbv[c2];
          for (int gi = tid; gi < 4096; gi += NTHR) { const int b = gi >> 9, t0 = (gi & 511) * 8, col = b * SEQ + t0;
              const bf16* p1 = hyT + (size_t)c1 * MLAT + col; const bf16* p2 = hyT + (size_t)c2 * MLAT + col;
              float u[10], w[10];
              hy_unpack8(*(const v4u*)p1, u + 1); hy_unpack8(*(const v4u*)p2, w + 1);
              const bool hl = (t0 & 63) != 0, hr = ((t0 + 8) & 63) != 0;
              u[0] = hl ? bf2f(p1[-1]) : 0.f; w[0] = hl ? bf2f(p2[-1]) : 0.f; u[9] = hr ? bf2f(p1[8]) : 0.f; w[9] = hr ? bf2f(p2[8]) : 0.f;
              float z[8];
#pragma unroll
              for (int i = 0; i < 8; ++i) z[i] = (ab + a0 * u[i] + a1 * u[i + 1] + a2 * u[i + 2]) * (bb + b0 * w[i] + b1 * w[i + 1] + b2 * w[i + 2]);
              v4u o; o.x = pk2(z[0], z[1]); o.y = pk2(z[2], z[3]); o.z = pk2(z[4], z[5]); o.w = pk2(z[6], z[7]);
              *(LAS v4u*)(L + HZ_OFF + b * HZ_ROWB + 2 * t0) = o; } }
        __syncthreads();
        hf32x16 acc[2][2];
#pragma unroll
        for (int m = 0; m < 2; ++m)
#pragma unroll
            for (int n = 0; n < 2; ++n)
#pragma unroll
                for (int i = 0; i < 16; ++i) acc[m][n][i] = 0.f;
        const int I0 = 8 * wave, q = r >> 3, b = r & 7, sh = (-r) & 3;
        const int a_lane = HK_OFF + sh * HK_COPYB + 2 * (4096 - r + 8 * h - sh);
        const int b_lane = HZ_OFF + b * HZ_ROWB + 16 * h;
        for (int d = I0 - 63; d <= I0 + 7; ++d) {
            const int J0 = I0 + q - d, J1 = J0 + 4;
            const bool ok0 = (unsigned)J0 < 64u, ok1 = (unsigned)J1 < 64u;
            const int abase = a_lane - 128 * d, bb0 = ok0 ? b_lane + 128 * J0 : HZERO_OFF, bb1 = ok1 ? b_lane + 128 * J1 : HZERO_OFF;
#pragma unroll
            for (int kk = 0; kk < 4; ++kk) {
                hbf16x8 af[2], bf[2];
#pragma unroll
                for (int m = 0; m < 2; ++m) { const int ad = abase - 64 * m + 32 * kk;
                    const v2u lo = *(const LAS v2u*)(L + ad), hi = *(const LAS v2u*)(L + ad + 8);
                    af[m] = __builtin_bit_cast(hbf16x8, (v4u){lo.x, lo.y, hi.x, hi.y}); }
                bf[0] = __builtin_bit_cast(hbf16x8, *(const LAS v4u*)(L + bb0 + (ok0 ? 32 * kk : 0)));
                bf[1] = __builtin_bit_cast(hbf16x8, *(const LAS v4u*)(L + bb1 + (ok1 ? 32 * kk : 0)));
#pragma unroll
                for (int m = 0; m < 2; ++m)
#pragma unroll
                    for (int n = 0; n < 2; ++n) acc[m][n] = __builtin_amdgcn_mfma_f32_32x32x16_bf16(af[m], bf[n], acc[m][n], 0, 0, 0);
            }
        }
        __syncthreads();
        for (int gi = tid; gi < 4096; gi += NTHR) { const int bb = gi >> 9, t0 = (gi & 511) * 8;
            *(LAS v4u*)(L + HK_OFF + bb * HZ_ROWB + 2 * t0) = *(const v4u*)(hyT + (size_t)c * MLAT + bb * SEQ + t0); }
        __syncthreads();
        { const float w0 = cw[c], w1 = cw[NHY + c], w2 = cw[2 * NHY + c], wb = cbv[c], hb = a.in[I_HBIAS][c];
#pragma unroll
          for (int m = 0; m < 2; ++m)
#pragma unroll
              for (int n = 0; n < 2; ++n)
#pragma unroll
                  for (int g = 0; g < 4; ++g) { const int t0 = 64 * (I0 + 4 * n + q) + 32 * m + 8 * g + 4 * h;
                      const LAS bf16* xp = (const LAS bf16*)(L + HK_OFF + b * HZ_ROWB + 2 * t0);
                      const v2u xr = *(const LAS v2u*)xp; const v2u zr = *(const LAS v2u*)(L + HZ_OFF + b * HZ_ROWB + 2 * t0);
                      float xv[6];
                      xv[0] = (t0 & 63) != 0 ? bf2f(xp[-1]) : 0.f; xv[5] = ((t0 + 4) & 63) != 0 ? bf2f(xp[4]) : 0.f;
                      xv[1] = bf2f(xr.x & 0xffffu); xv[2] = bf2f(xr.x >> 16); xv[3] = bf2f(xr.y & 0xffffu); xv[4] = bf2f(xr.y >> 16);
                      const float zv[4] = {bf2f(zr.x & 0xffffu), bf2f(zr.x >> 16), bf2f(zr.y & 0xffffu), bf2f(zr.y >> 16)};
                      float y[4];
#pragma unroll
                      for (int k = 0; k < 4; ++k) y[k] = (wb + w0 * xv[k] + w1 * xv[k + 1] + w2 * xv[k + 2]) * (acc[m][n][4 * g + k] + hb * zv[k]);
                      v2u o; o.x = pk2(y[0], y[1]); o.y = pk2(y[2], y[3]);
                      *(v2u*)(yT + (size_t)c * MLAT + b * SEQ + t0) = o; } }
        __syncthreads();
    }
}
__device__ __forceinline__ void hyena_transpose(const Args& a, unsigned char* lds) {
    const int tid = threadIdx.x, lane = tid & 63, wave = tid >> 6;
    bf16* scr = (bf16*)(lds + wave * 16384);
    const bf16* yT = (const bf16*)(a.ws + WS_YT); bf16* ycat = (bf16*)(a.ws + WS_YCAT);
    const int gw = blockIdx.x * NWAVES + wave, NGW = gridDim.x * NWAVES;
    for (int t = gw; t < (DH / 64) * (MLAT / 64); t += NGW) { const int cb = t & 7, tb = t >> 3, c0 = cb * 64, k0 = tb * 64;
        for (int r = 0; r < 64; ++r) scr[r * 66 + lane] = yT[(size_t)(c0 + r) * MLAT + k0 + lane];
        LDS_WAIT(); asm volatile("" ::: "memory");
        for (int r = 0; r < 64; ++r) ycat[(size_t)(k0 + r) * DM + c0 + lane] = scr[lane * 66 + r];
        LDS_WAIT(); asm volatile("" ::: "memory"); }
}

#define XB_TMO      128
#define XB_XCNT(j)  (256  + 64 * (j))
#define XB_XSUB(j)  (1280 + 64 * (j))
#define XB_XGEN(j)  (2304 + 64 * (j))
#define XB_TOP      3328
#define XB_TOPGEN   3392
#define XCD_BAR_WORDS 3456
#define XB_SPIN_CAP (1u << 18)

__device__ __forceinline__ unsigned xb_ld(unsigned* p)              { return __hip_atomic_load(p, __ATOMIC_RELAXED, __HIP_MEMORY_SCOPE_AGENT); }
__device__ __forceinline__ unsigned xb_add(unsigned* p, unsigned v) { return __hip_atomic_fetch_add(p, v, __ATOMIC_RELAXED, __HIP_MEMORY_SCOPE_AGENT); }
__device__ __forceinline__ unsigned xb_xcc_id() { return (unsigned)__builtin_amdgcn_s_getreg((3 << 11) | 20) & 0xFu; }
#define XB_SPIN(cond, bar) do { unsigned _sp = 0; while (cond) { __builtin_amdgcn_s_sleep(1); \
    if ((++_sp & 255u) == 0u) { if (xb_ld(&(bar)[XB_TMO])) break; if (_sp > XB_SPIN_CAP) { atomicAdd(&(bar)[XB_TMO], 1u); break; } } } } while (0)

struct XcdBarrier {
    unsigned* bar; unsigned x;
    volatile LAS unsigned* st;
};

__device__ __forceinline__ XcdBarrier xcd_barrier_post(unsigned* bar, volatile LAS unsigned* st) {
    XcdBarrier b; b.bar = bar; b.x = xb_xcc_id(); b.st = st;
    if (threadIdx.x == 0) (void)xb_add(&bar[XB_XCNT(b.x)], 1u);
    return b;
}
__device__ __forceinline__ void xcd_barrier_complete(unsigned* bar, unsigned x, unsigned& nloc, unsigned& nx) {
    const unsigned G = gridDim.x * gridDim.y * gridDim.z;
    unsigned sum, cnt, mine, sp = 0u;
    for (;;) {
        sum = 0u; cnt = 0u; mine = 0u;
#pragma unroll
        for (unsigned j = 0; j < 16; ++j) { const unsigned c = xb_ld(&bar[XB_XCNT(j)]); sum += c; cnt += (c > 0u) ? 1u : 0u; mine = (j == x) ? c : mine; }
        if (sum == G) break;
        __builtin_amdgcn_s_sleep(1);
        if ((++sp & 255u) == 0u) { if (xb_ld(&bar[XB_TMO])) break; if (sp > XB_SPIN_CAP) { atomicAdd(&bar[XB_TMO], 1u); break; } }
    }
    nloc = mine > 0u ? mine : 1u; nx = cnt > 0u ? cnt : 1u;
}

__device__ __forceinline__ void xcd_barrier(const XcdBarrier& b) {
    asm volatile("s_waitcnt vmcnt(0)" ::: "memory");
    __syncthreads();
    if (threadIdx.x == 0) {
        unsigned* bar = b.bar;
        __builtin_amdgcn_s_waitcnt(0);
        unsigned nloc = b.st[0], nx = b.st[1];
        if (nloc == 0u) { xcd_barrier_complete(bar, b.x, nloc, nx); b.st[0] = nloc; b.st[1] = nx; }
        const unsigned old = xb_add(&bar[XB_XSUB(b.x)], 1u);
        const unsigned gen = old / nloc;
        if (old + 1u == (gen + 1u) * nloc) {
            __builtin_amdgcn_fence(__ATOMIC_RELEASE, "agent");
            asm volatile("s_waitcnt vmcnt(0)" ::: "memory");
            const unsigned og = xb_add(&bar[XB_TOP], 1u);
            const unsigned tg = og / nx;
            if (og + 1u == (tg + 1u) * nx) xb_add(&bar[XB_TOPGEN], 1u);
            else XB_SPIN(xb_ld(&bar[XB_TOPGEN]) == tg, bar);
            __builtin_amdgcn_fence(__ATOMIC_ACQUIRE, "agent");
            xb_add(&bar[XB_XGEN(b.x)], 1u);
            asm volatile("s_waitcnt vmcnt(0)" ::: "memory");
        } else {
            XB_SPIN(xb_ld(&bar[XB_XGEN(b.x)]) == gen, bar);
            __builtin_amdgcn_fence(__ATOMIC_ACQUIRE, "agent");
            asm volatile("s_waitcnt vmcnt(0)" ::: "memory");
        }
    }
    __syncthreads();
}

constexpr int NPHASE = 11;
__global__ void __launch_bounds__(NTHR, 2) fwd_kernel(Args a) {
    extern __shared__ __attribute__((aligned(16))) unsigned char lds[];
    const int lo = a.ph_lo, hi = a.ph_hi;
    volatile LAS unsigned* MISC = (volatile LAS unsigned*)((LAS unsigned char*)lds + MISC_OFF);
    if (threadIdx.x < 16) MISC[threadIdx.x] = 0u;
    __syncthreads();
    XcdBarrier bar = xcd_barrier_post((unsigned*)(a.ws + WS_CTL) + CW_BAR, MISC + 8);
#define IN(k) (lo <= (k) && (k) < hi)
#define SEAM(k) do { if (IN(k) && IN((k) + 1)) xcd_barrier(bar); } while (0)
    unsigned char* ws = a.ws;
    PG8_LAS unsigned char* ldsg = (PG8_LAS unsigned char*)lds;
    if (IN(0)) { p0_prologue(a, lds); } SEAM(0);
    if (IN(1)) { norm_mod_rows(a, a.in[I_X], a.in[I_CTX], MALL, a.in[I_NMIX], MOD_SC1, MOD_SH1, (bf16*)(ws + WS_XN)); } SEAM(1);
    if (IN(2)) {
        { pg8::Gemm g{(const pg8::bf16_t*)(ws + WS_WIN), (const pg8::bf16_t*)(ws + WS_XN), NHY, MLAT, DM}; pg8::StaticOrder S; S.init(NHY, MLAT, gridDim.x, blockIdx.x);
          pg8::EpiBf16<0> E{(pg8::bf16_t*)(ws + WS_HYT), MLAT};
          pg8::gemm_phase<pg8::EpiBf16<0>, pg8::StaticOrder, true, true>(ldsg, g, S, E); }
        __syncthreads();
        { pg8::Gemm g{(const pg8::bf16_t*)(ws + WS_XN), (const pg8::bf16_t*)(ws + WS_WIN) + (size_t)NHY * DM, MALL, NGL, DM}; pg8::StaticOrder S; S.init(MALL, NGL, gridDim.x, blockIdx.x);
          pg8::EpiBf16<0> E{(pg8::bf16_t*)(ws + WS_GPROJ), NGL};
          pg8::gemm_phase<pg8::EpiBf16<0>, pg8::StaticOrder, true, true>(ldsg, g, S, E); }
    } SEAM(2);
    if (IN(3)) { gla_local_mfma(a, lds); __syncthreads(); hyena_conv_mfma(a, lds); } SEAM(3);
    if (IN(4)) { gla_scan(a); } SEAM(4);
    if (IN(5)) { gla_out_mfma(a, lds); __syncthreads(); hyena_transpose(a, lds); } SEAM(5);
    if (IN(6)) { pg8::Gemm g{(const pg8::bf16_t*)(ws + WS_YCAT), (const pg8::bf16_t*)(ws + WS_WOUT), MLAT, DM, DM}; pg8::StaticOrder S; S.init(MLAT, DM, gridDim.x, blockIdx.x);
        pg8::EpiResid E{a.in[I_X], a.out, DM, (const float*)(ws + WS_MOD) + MOD_G1, SEQ, MODW};
        pg8::gemm_phase<pg8::EpiResid, pg8::StaticOrder, true, true>(ldsg, g, S, E); } SEAM(6);
    if (IN(7)) { norm_mod_rows(a, a.out, a.out, MLAT, a.in[I_NMLP], MOD_SC2, MOD_SH2, (bf16*)(ws + WS_XN)); } SEAM(7);
    if (IN(8)) { pg8::Gemm g{(const pg8::bf16_t*)(ws + WS_XN), (const pg8::bf16_t*)(ws + WS_W1), MLAT, FF, DM}; pg8::StaticOrder S; S.init(MLAT, FF, gridDim.x, blockIdx.x);
        pg8::EpiBf16<1> E{(pg8::bf16_t*)(ws + WS_HID), FF};
        pg8::gemm_phase<pg8::EpiBf16<1>, pg8::StaticOrder, true, true>(ldsg, g, S, E); } SEAM(8);
    if (IN(9)) { pg8::Gemm g{(const pg8::bf16_t*)(ws + WS_HID), (const pg8::bf16_t*)(ws + WS_W2), MLAT, DM, FF}; pg8::StaticOrder S; S.init(MLAT, DM, gridDim.x, blockIdx.x);
        pg8::EpiResid E{a.out, a.out, DM, (const float*)(ws + WS_MOD) + MOD_G2, SEQ, MODW};
        pg8::gemm_phase<pg8::EpiResid, pg8::StaticOrder, true, true>(ldsg, g, S, E); } SEAM(9);
    if (IN(10)) { final_norm_rows(a); }
#undef IN
#undef SEAM
}

#ifndef N_LAUNCH_MODE
#define N_LAUNCH_MODE 1
#endif
extern "C" void kernel_launch(void* const* d_in, const int* in_sizes, int n_in, void* d_out, int out_size, void* d_ws, size_t ws_size, hipStream_t stream) {
    static int grid = 0;
    if (grid == 0) {
        if (n_in != 29 || out_size != MLAT * DM || ws_size < WS_END) { fprintf(stderr, "kernel_launch: unexpected shapes (n_in %d out %d ws %zu)\n", n_in, out_size, ws_size); grid = -1; return; }
        int dev = 0, cus = 0, per_cu = 0;
        if (hipGetDevice(&dev) != hipSuccess || hipDeviceGetAttribute(&cus, hipDeviceAttributeMultiprocessorCount, dev) != hipSuccess) { grid = -1; return; }
        if (hipFuncSetAttribute((const void*)fwd_kernel, hipFuncAttributeMaxDynamicSharedMemorySize, LDS_BYTES) != hipSuccess) { fprintf(stderr, "kernel_launch: hipFuncSetAttribute failed\n"); grid = -1; return; }
        if (hipOccupancyMaxActiveBlocksPerMultiprocessor(&per_cu, (const void*)fwd_kernel, NTHR, LDS_BYTES) != hipSuccess || per_cu < 1) { fprintf(stderr, "kernel_launch: occupancy query says %d blocks per CU\n", per_cu); (void)hipGetLastError(); grid = -1; return; }
        grid = cus;
    }
    if (grid < 0) return;
    Args a{};
    for (int i = 0; i < 29; ++i) a.in[i] = (const float*)d_in[i];
    a.out = (float*)d_out; a.ws = (unsigned char*)d_ws;
#if N_LAUNCH_MODE == 0
    for (int p = 0; p < NPHASE; ++p) { a.ph_lo = p; a.ph_hi = p + 1; hipLaunchKernelGGL(fwd_kernel, dim3(grid), dim3(NTHR), LDS_BYTES, stream, a); }
#else
    a.ph_lo = 0; a.ph_hi = NPHASE;
    if (hipMemsetAsync((char*)d_ws + WS_CTL, 0, CTL_ZERO_BYTES, stream) != hipSuccess) { fprintf(stderr, "kernel_launch: memset of the control words failed\n"); return; }
    hipLaunchKernelGGL(fwd_kernel, dim3(grid), dim3(NTHR), LDS_BYTES, stream, a);
#endif
}
```

```cpp
#include <hip/hip_runtime.h>
#include <hip/hip_cooperative_groups.h>
#include <cstdio>
#include <cstdint>
#include <cmath>
namespace cg = cooperative_groups;
namespace pg8 {
#define PG8_LAS __attribute__((address_space(3)))
typedef unsigned short bf16_t;
typedef short bf16x8 __attribute__((ext_vector_type(8)));
typedef float f32x4 __attribute__((ext_vector_type(4)));
typedef unsigned u32x4 __attribute__((ext_vector_type(4)));
constexpr int BM = 256, BK = 64, HALF = 128, HTB = HALF * BK * 2  , STAGE_BYTES = 8 * HTB, NXCD = 8, WGM = 8;

__host__ __device__ __forceinline__ int lds_byte(int r, int c) { const int st = (r >> 4) * 2 + (c >> 5), rr = r & 15, cc = c & 31, ob = rr * 64 + cc * 2; return st * 1024 + (ob ^ (((ob >> 9) & 1) << 5)); }
__host__ __device__ __forceinline__ void stage_rc(int b, int& R, int& C) { const int st = b / 1024, sb = b % 1024, swz = sb ^ (((sb >> 9) & 1) << 5); R = (st >> 1) * 16 + swz / 64; C = (st & 1) * 32 + (swz % 64) / 2; }
__host__ __device__ __forceinline__ int perm32(int rho) { const int n = rho >> 4, i = rho & 15; return 8 * (i >> 2) + 4 * n + (i & 3); }

struct Unit { int pm, pn; };
struct Gemm { const bf16_t* A; const bf16_t* Bt; int M, N, K; };

struct StaticOrder {
    int nM, nN, nwg, G, c;
    __host__ __device__ void init(int M, int N, int G_, int c_) { nM = M / BM; nN = N / BM; nwg = nM * nN; G = G_; c = c_; }
    __host__ __device__ bool next(int i, Unit& u) const {
        const long L = (long)i * G + c; if (L >= nwg) return false;
        int wgid = (int)L; { const int q = nwg / NXCD, r = nwg % NXCD, xcd = wgid % NXCD, off = wgid / NXCD; wgid = (xcd < r ? xcd * (q + 1) : r * (q + 1) + (xcd - r) * q) + off; }
        const int nig = WGM * nN, gid = wgid / nig, fm = gid * WGM, gsz = (nM - fm) < WGM ? (nM - fm) : WGM;
        u.pm = fm + ((wgid % nig) % gsz); u.pn = (wgid % nig) / gsz; return true;
    }
    __device__ __forceinline__ void a_ready(const Unit&) const {}
    __device__ __forceinline__ void done(const Unit&) const {}
};


__device__ __forceinline__ unsigned cvt_pk_bf16(float lo, float hi) { unsigned r; asm volatile("v_cvt_pk_bf16_f32 %0, %1, %2" : "=v"(r) : "v"(lo), "v"(hi)); return r; }

template <int ACT> struct EpiBf16 {
    static constexpr bool PERM = true, AFTER_DRAIN = false;
    bf16_t* O; int ldc;
    __device__ __forceinline__ void operator()(const f32x4 (&acc)[2][2][4][2], const Unit& u, int wr, int wc, int fr, int fq) const {
        const int row0 = u.pm * BM + wr * 64 + fr; const int col0 = u.pn * BM + wc * 32 + 8 * fq;
#pragma unroll
        for (int ai = 0; ai < 2; ++ai)
#pragma unroll
            for (int m = 0; m < 4; ++m) { bf16_t* rowp = O + (size_t)(row0 + ai * HALF + m * 16) * ldc + col0;
#pragma unroll
                for (int bj = 0; bj < 2; ++bj) { f32x4 v0 = acc[ai][bj][m][0], v1 = acc[ai][bj][m][1];
                    if (ACT == 1) {
#pragma unroll
                        for (int q = 0; q < 4; ++q) { const float a0 = fmaxf(v0[q], 0.f), a1 = fmaxf(v1[q], 0.f); v0[q] = a0 * a0; v1[q] = a1 * a1; } }
                    u32x4 w; w.x = cvt_pk_bf16(v0[0], v0[1]); w.y = cvt_pk_bf16(v0[2], v0[3]); w.z = cvt_pk_bf16(v1[0], v1[1]); w.w = cvt_pk_bf16(v1[2], v1[3]);
                    *(u32x4*)(rowp + bj * HALF) = w; } }
    }
};
struct EpiResid {
    static constexpr bool PERM = false, AFTER_DRAIN = false;
    const float* base; float* out; int ldc; const float* gate; int rows_per_gate; int gate_stride;
    __device__ __forceinline__ void operator()(const f32x4 (&acc)[2][2][4][2], const Unit& u, int wr, int wc, int fr, int fq) const {
        const int row0 = u.pm * BM + wr * 64 + fr, col0 = u.pn * BM + wc * 32 + 4 * fq;
        const float* gp = gate + (size_t)((u.pm * BM) / rows_per_gate) * gate_stride + col0;
        f32x4 gv[2][2];
#pragma unroll
        for (int bj = 0; bj < 2; ++bj)
#pragma unroll
            for (int n = 0; n < 2; ++n) gv[bj][n] = *(const f32x4*)(gp + bj * HALF + n * 16);
#pragma unroll
        for (int ai = 0; ai < 2; ++ai)
#pragma unroll
            for (int m = 0; m < 4; ++m) { const size_t off = (size_t)(row0 + ai * HALF + m * 16) * ldc + col0;
#pragma unroll
                for (int bj = 0; bj < 2; ++bj)
#pragma unroll
                    for (int n = 0; n < 2; ++n) { const f32x4 bs = *(const f32x4*)(base + off + bj * HALF + n * 16);
                        *(f32x4*)(out + off + bj * HALF + n * 16) = bs + gv[bj][n] * acc[ai][bj][m][n]; } }
    }
};

template <class Epi, class Sched, bool ALIGN_EPI = false, bool SP2 = false>
__device__ __forceinline__ void gemm_phase(PG8_LAS unsigned char* lds, const Gemm g, const Sched& S, const Epi& E) {
    const int tid = threadIdx.x, wid = __builtin_amdgcn_readfirstlane(tid >> 6), lane = tid & 63, wr = wid >> 2, wc = wid & 3, fr = lane & 15, fq = lane >> 4;
    const int K = g.K, nt = K / BK;
    unsigned voffA[2], voffB[2];
#pragma unroll
    for (int i = 0; i < 2; ++i) { int R, C; stage_rc(tid * 16 + i * 8192, R, C); const int Rb = Epi::PERM ? ((R & ~31) + perm32(R & 31)) : R;
        voffA[i] = (unsigned)(R * K + C) * 2u; voffB[i] = (unsigned)(Rb * K + C) * 2u; }
    const size_t kstep = (size_t)(BK * 2);
    const size_t hstep = (size_t)HALF * K * 2;
    const size_t tstep = 2 * hstep;
    const unsigned ldsw = (unsigned)wid * 1024u;
    const int aoff = lds_byte(wr * 64 + fr, fq * 8), boff = lds_byte(wc * 32 + fr, fq * 8);
#define PG8_SA(b, h) (((b) * 2 + (h)) * HTB)
#define PG8_SB(b, h) ((4 + (b) * 2 + (h)) * HTB)
#define PG8_STAGE(bufoff, gbase, voff) do { _Pragma("unroll") for (int _i = 0; _i < 2; ++_i) \
        __builtin_amdgcn_global_load_lds((const unsigned*)((const char*)(gbase) + (voff)[_i]), (PG8_LAS unsigned*)(lds + (bufoff) + ldsw + _i * 8192), 16, 0, 0); } while (0)
#define PG8_LDA(dst, b, h) do { _Pragma("unroll") for (int m = 0; m < 4; ++m) _Pragma("unroll") for (int k = 0; k < 2; ++k) dst[m][k] = *(const PG8_LAS bf16x8*)(lds + PG8_SA(b, h) + aoff + m * 2048 + k * 1024); } while (0)
#define PG8_LDB(dst, b, h) do { _Pragma("unroll") for (int n = 0; n < 2; ++n) _Pragma("unroll") for (int k = 0; k < 2; ++k) dst[n][k] = *(const PG8_LAS bf16x8*)(lds + PG8_SB(b, h) + boff + n * 2048 + k * 1024); } while (0)
#define PG8_MMA(ai, bj, At, Bt) do { __builtin_amdgcn_s_setprio(1); _Pragma("unroll") for (int m = 0; m < 4; ++m) _Pragma("unroll") for (int n = 0; n < 2; ++n) _Pragma("unroll") for (int k = 0; k < 2; ++k) \
        acc[ai][bj][m][n] = __builtin_amdgcn_mfma_f32_16x16x32_bf16(Bt[n][k], At[m][k], acc[ai][bj][m][n], 0, 0, 0); __builtin_amdgcn_s_setprio(0); } while (0)
#define PG8_WAIT_V(n) asm volatile("s_waitcnt vmcnt(" #n ")" ::: "memory")
#define PG8_WAIT_L(n) asm volatile("s_waitcnt lgkmcnt(" #n ")" ::: "memory")
#define PG8_BAR __builtin_amdgcn_s_barrier()
#define PG8_SCHED __builtin_amdgcn_sched_barrier(0)
    Unit cur, nxt; int ui = 0;
    if (!S.next(0, cur)) return;
    f32x4 acc[2][2][4][2];
#pragma unroll
    for (int a = 0; a < 2; ++a)
#pragma unroll
        for (int b = 0; b < 2; ++b)
#pragma unroll
            for (int m = 0; m < 4; ++m)
#pragma unroll
                for (int n = 0; n < 2; ++n) acc[a][b][m][n] = (f32x4){0.f, 0.f, 0.f, 0.f};
    bf16x8 At[4][2], B0[2][2], B1[2][2];
    const char* cA = (const char*)g.A + (size_t)cur.pm * tstep; const char* cB = (const char*)g.Bt + (size_t)cur.pn * tstep;
    S.a_ready(cur);
    if constexpr (SP2) {
        PG8_STAGE(PG8_SB(0, 0), cB, voffB); PG8_STAGE(PG8_SB(0, 1), cB + hstep, voffB); PG8_STAGE(PG8_SA(0, 0), cA, voffA); PG8_STAGE(PG8_SA(0, 1), cA + hstep, voffA);
        if (wr == 1) PG8_BAR;
        PG8_WAIT_V(2); PG8_BAR;
        PG8_STAGE(PG8_SB(1, 0), cB + kstep, voffB); PG8_STAGE(PG8_SA(1, 0), cA + kstep, voffA); PG8_STAGE(PG8_SB(1, 1), cB + hstep + kstep, voffB);
        PG8_WAIT_V(6); PG8_BAR;
    } else {
        PG8_STAGE(PG8_SB(0, 0), cB, voffB); PG8_STAGE(PG8_SA(0, 0), cA, voffA); PG8_STAGE(PG8_SB(0, 1), cB + hstep, voffB); PG8_STAGE(PG8_SA(0, 1), cA + hstep, voffA);
        if (wr == 1) PG8_BAR;
        PG8_WAIT_V(4); PG8_BAR;
        PG8_STAGE(PG8_SB(1, 0), cB + kstep, voffB); PG8_STAGE(PG8_SA(1, 0), cA + kstep, voffA); PG8_STAGE(PG8_SB(1, 1), cB + hstep + kstep, voffB);
        PG8_WAIT_V(6); PG8_BAR;
    }
    for (;;) {
        const bool has_next = S.next(ui + 1, nxt);
        const char* nA = has_next ? (const char*)g.A + (size_t)nxt.pm * tstep : cA; const char* nB = has_next ? (const char*)g.Bt + (size_t)nxt.pn * tstep : cB;
        for (int t = 0; t < nt; t += 2) {
            const bool last = (t == nt - 2);
            const char* a1 = cA + (size_t)(t + 1) * kstep;
            const char* a2 = last ? nA : cA + (size_t)(t + 2) * kstep; const char* b2 = last ? nB : cB + (size_t)(t + 2) * kstep;
            const char* a3 = a2 + kstep; const char* b3 = b2 + kstep;
            if (last && has_next) S.a_ready(nxt);
            if constexpr (SP2) {
            PG8_LDB(B0, 0, 0); PG8_LDB(B1, 0, 1); PG8_SCHED; PG8_LDA(At, 0, 0); PG8_STAGE(PG8_SA(1, 1), a1 + hstep, voffA);
            PG8_WAIT_V(8); PG8_WAIT_L(0); PG8_BAR; PG8_MMA(0, 0, At, B0); PG8_MMA(0, 1, At, B1); PG8_BAR; PG8_SCHED;
            PG8_LDA(At, 0, 1); PG8_STAGE(PG8_SB(0, 0), b2, voffB); PG8_STAGE(PG8_SB(0, 1), b2 + hstep, voffB); PG8_STAGE(PG8_SA(0, 0), a2, voffA);
            PG8_WAIT_V(8); PG8_WAIT_L(0); PG8_BAR; PG8_MMA(1, 0, At, B0); PG8_MMA(1, 1, At, B1); PG8_BAR; PG8_SCHED;
            PG8_LDB(B0, 1, 0); PG8_LDB(B1, 1, 1); PG8_SCHED; PG8_LDA(At, 1, 0); PG8_STAGE(PG8_SA(0, 1), a2 + hstep, voffA);
            PG8_WAIT_V(8); PG8_WAIT_L(0); PG8_BAR; PG8_MMA(0, 0, At, B0); PG8_MMA(0, 1, At, B1); PG8_BAR; PG8_SCHED;
            PG8_LDA(At, 1, 1); PG8_STAGE(PG8_SB(1, 0), b3, voffB); PG8_STAGE(PG8_SB(1, 1), b3 + hstep, voffB); PG8_STAGE(PG8_SA(1, 0), a3, voffA);
            PG8_WAIT_V(8); PG8_WAIT_L(0); PG8_BAR; PG8_MMA(1, 0, At, B0); PG8_MMA(1, 1, At, B1); PG8_BAR; PG8_SCHED;
            } else {
            PG8_LDB(B0, 0, 0); PG8_SCHED; PG8_LDA(At, 0, 0); PG8_STAGE(PG8_SA(1, 1), a1 + hstep, voffA);
            PG8_WAIT_L(8); PG8_BAR; PG8_WAIT_L(0); PG8_MMA(0, 0, At, B0); PG8_BAR; PG8_SCHED;
            PG8_LDB(B1, 0, 1); PG8_STAGE(PG8_SB(0, 0), b2, voffB);
            PG8_BAR; PG8_WAIT_L(0); PG8_MMA(0, 1, At, B1); PG8_BAR;
            PG8_LDA(At, 0, 1); PG8_STAGE(PG8_SA(0, 0), a2, voffA);
            PG8_BAR; PG8_WAIT_L(0); PG8_MMA(1, 0, At, B0); PG8_BAR; PG8_SCHED;
            PG8_STAGE(PG8_SB(0, 1), b2 + hstep, voffB);
            PG8_WAIT_V(6); PG8_BAR; PG8_MMA(1, 1, At, B1); PG8_BAR;
            PG8_LDB(B0, 1, 0); PG8_SCHED; PG8_LDA(At, 1, 0); PG8_STAGE(PG8_SA(0, 1), a2 + hstep, voffA);
            PG8_WAIT_L(8); PG8_BAR; PG8_WAIT_L(0); PG8_MMA(0, 0, At, B0); PG8_BAR; PG8_SCHED;
            PG8_LDB(B1, 1, 1); PG8_STAGE(PG8_SB(1, 0), b3, voffB);
            PG8_BAR; PG8_WAIT_L(0); PG8_MMA(0, 1, At, B1); PG8_BAR;
            PG8_LDA(At, 1, 1); PG8_STAGE(PG8_SA(1, 0), a3, voffA);
            PG8_BAR; PG8_WAIT_L(0); PG8_MMA(1, 0, At, B0); PG8_BAR; PG8_SCHED;
            PG8_STAGE(PG8_SB(1, 1), b3 + hstep, voffB);
            PG8_WAIT_V(6); PG8_BAR; PG8_MMA(1, 1, At, B1); PG8_BAR;
            }
        }
        if constexpr (ALIGN_EPI) { if (wr == 0) PG8_BAR; }
        if constexpr (!Epi::AFTER_DRAIN) { E(acc, cur, wr, wc, fr, fq); S.done(cur); }
        if (!has_next) break;
#pragma unroll
        for (int a = 0; a < 2; ++a)
#pragma unroll
            for (int b = 0; b < 2; ++b)
#pragma unroll
                for (int m = 0; m < 4; ++m)
#pragma unroll
                    for (int n = 0; n < 2; ++n) acc[a][b][m][n] = (f32x4){0.f, 0.f, 0.f, 0.f};
        cur = nxt; cA = nA; cB = nB; ++ui;
        if constexpr (ALIGN_EPI) { if (wr == 1) PG8_BAR; }
    }
    PG8_WAIT_V(0);
    if constexpr (!ALIGN_EPI) { if (wr == 0) PG8_BAR; }
    PG8_BAR;
    if constexpr (Epi::AFTER_DRAIN) { E.fused(acc, cur, wr, wc, fr, fq, lds, wid, lane); S.done(cur); }
#undef PG8_SA
#undef PG8_SB
#undef PG8_STAGE
#undef PG8_LDA
#undef PG8_LDB
#undef PG8_MMA
#undef PG8_WAIT_V
#undef PG8_WAIT_L
#undef PG8_BAR
#undef PG8_SCHED
}
}

constexpr int NB = 8, SEQ = 4096, DM = 1024, CTXL = 256;
constexpr int MLAT = NB * SEQ, MCTX = NB * CTXL, MALL = MLAT + MCTX;
constexpr int DH = 512, NHY = 1536, NGL = 1792, NINP = NHY + NGL, NIN = 3104, FF = 4096;
constexpr int GQ = 0, GK = 256, GV = 512, GOG = 1024, GGF = 1536;
constexpr int NSIG = 68, NITEM = NB * 4 * 2 * NSIG;
constexpr float EPSF = 1e-6f;
constexpr int MOD_SH1 = 0, MOD_SC1 = 1024, MOD_G1 = 2048, MOD_SH2 = 3072, MOD_SC2 = 4096, MOD_G2 = 5120, MODW = 6144;

constexpr size_t MiB = 1u << 20;
constexpr size_t WS_CTL = 0, WS_MOD = 1 * MiB, WS_SSQ = 2 * MiB, WS_WIN = 4 * MiB, WS_WOUT = 11 * MiB, WS_W1 = 13 * MiB, WS_W2 = 21 * MiB;
constexpr size_t WS_KRAW = 30 * MiB, WS_DEC = 46 * MiB, WS_XN = 48 * MiB  , WS_HYT = 116 * MiB, WS_GPROJ = 212 * MiB;
constexpr size_t WS_YT = 331 * MiB, WS_YCAT = 363 * MiB, WS_HID = 116 * MiB  , WS_END = 427 * MiB;
static_assert(WS_WIN + (size_t)NINP * DM * 2 <= WS_WOUT && WS_W2 + (size_t)DM * FF * 2 <= WS_KRAW && WS_KRAW + (size_t)DH * 8192 * 4 <= WS_DEC, "ws map 1");
static_assert(WS_DEC + (size_t)NITEM * 64 * 4 <= WS_XN && WS_XN + (size_t)MALL * DM * 2 <= WS_HYT && WS_XN + (size_t)NITEM * 8192 * 2 <= WS_HYT, "ws map 2");
static_assert(WS_HYT + (size_t)NHY * MLAT * 2 <= WS_GPROJ && WS_GPROJ + (size_t)MALL * NGL * 2 <= WS_YT && WS_YT + (size_t)DH * MLAT * 2 <= WS_YCAT, "ws map 3");
static_assert(WS_HID + (size_t)MLAT * FF * 2 <= WS_YCAT + (size_t)MLAT * DM * 2 && WS_YCAT + (size_t)MLAT * DM * 2 <= WS_END, "ws map 4");

constexpr int NTHR = 512, NWAVES = 8;
constexpr int LDS_BYTES = 147456;
constexpr int MISC_OFF = LDS_BYTES - 256;
constexpr int CW_BAR = 4096, CTL_ZERO_BYTES = 65536;

#define LAS __attribute__((address_space(3)))
typedef unsigned short bf16;
typedef unsigned v4u __attribute__((ext_vector_type(4)));
typedef unsigned v2u __attribute__((ext_vector_type(2)));
typedef float f32x4 __attribute__((ext_vector_type(4)));
#define LDS_WAIT() asm volatile("s_waitcnt lgkmcnt(0)" ::: "memory")

__device__ __forceinline__ unsigned f2bf(float f) { unsigned u = __builtin_bit_cast(unsigned, f); return (u + 0x7fffu + ((u >> 16) & 1u)) >> 16; }
__device__ __forceinline__ unsigned pk2(float lo, float hi) { return f2bf(lo) | (f2bf(hi) << 16); }
__device__ __forceinline__ float bf2f(unsigned h) { return __builtin_bit_cast(float, h << 16); }
__device__ __forceinline__ float wave_sum(float v) {
#pragma unroll
    for (int o = 1; o < 64; o <<= 1) v += __shfl_xor(v, o);
    return v;
}
__device__ __forceinline__ float siluf(float v) { return v / (1.f + __expf(-v)); }
__device__ __forceinline__ float logsigmoidf(float a) { return fminf(a, 0.f) - log1pf(__expf(-fabsf(a))); }

struct Args { const float* in[29]; float* out; unsigned char* ws; int ph_lo, ph_hi; };

enum { I_X = 0, I_C, I_CTX, I_CCTX, I_WADA, I_BADA, I_NMIX, I_NMLP, I_WIN, I_CONVW, I_CONVB, I_FW1, I_FB1, I_FW2, I_FB2, I_FW3, I_FB3, I_FFREQ, I_FWOUT,
       I_HBIAS, I_GKWF, I_GKBF, I_GKWB, I_GKBB, I_GLAN, I_WOUT, I_WM1, I_WM2, I_NFIN };

__device__ __forceinline__ void p0_transpose_item(const float* W, int K, int N, bf16* WT, int row_off, float* scr, int item, int lane) {
    const int nblk = N / 32, kb = item / nblk, nb = item % nblk, k0 = 64 * kb, n0 = 32 * nb;
#pragma unroll 8
    for (int i = 0; i < 32; ++i) { const int kk = 2 * i + (lane >> 5); scr[kk * 33 + (lane & 31)] = W[(size_t)(k0 + kk) * N + n0 + (lane & 31)]; }
    LDS_WAIT(); asm volatile("" ::: "memory");
    const int c = lane & 7;
#pragma unroll
    for (int j = 0; j < 4; ++j) { const int n = (lane >> 3) + 8 * j; const float* s = scr + (8 * c) * 33 + n;
        v4u o; o.x = pk2(s[0 * 33], s[1 * 33]); o.y = pk2(s[2 * 33], s[3 * 33]); o.z = pk2(s[4 * 33], s[5 * 33]); o.w = pk2(s[6 * 33], s[7 * 33]);
        *(v4u*)(WT + (size_t)(row_off + n0 + n) * K + k0 + 8 * c) = o; }
    LDS_WAIT(); asm volatile("" ::: "memory");
}

__device__ __forceinline__ void p0_filter(const Args& a, unsigned char* lds) {
    float* zb = (float*)lds;
    float* h1 = zb + 16 * 33;
    float* h2 = h1 + 16 * 64;
    const int tid = threadIdx.x;
    float* Kraw = (float*)(a.ws + WS_KRAW); float* SSQ = (float*)(a.ws + WS_SSQ);
    const float* w1 = a.in[I_FW1]; const float* b1 = a.in[I_FB1]; const float* w2 = a.in[I_FW2]; const float* b2 = a.in[I_FB2];
    const float* w3 = a.in[I_FW3]; const float* b3 = a.in[I_FB3]; const float* fr = a.in[I_FFREQ]; const float* wo = a.in[I_FWOUT];
    for (int pg = blockIdx.x; pg < 256; pg += gridDim.x) {
        const int p0 = pg * 16;
        for (int i = tid; i < 16 * 33; i += NTHR) { const int pp = i / 33, j = i % 33; const int p = p0 + pp; float val;
            if (j == 0) val = (float)p * (1.0f / 4095.0f);
            else { const int bi = (j - 1) & 15; const float f = 1e-4f + (float)bi * ((15.0f - 1e-4f) / 15.0f); const float w = 6.283185307179586f * (float)p / 4096.0f; const float ang = w * f;
                   val = (j <= 16) ? cosf(ang) : -sinf(ang); }
            zb[i] = val; }
        __syncthreads();
        for (int i = tid; i < 1024; i += NTHR) { const int pp = i >> 6, j = i & 63; float acc = b1[j];
            for (int k = 0; k < 33; ++k) acc += zb[pp * 33 + k] * w1[k * 64 + j];
            h1[i] = sinf(fr[j] * acc); }
        __syncthreads();
        for (int i = tid; i < 1024; i += NTHR) { const int pp = i >> 6, j = i & 63; float acc = b2[j];
            for (int k = 0; k < 64; ++k) acc += h1[pp * 64 + k] * w2[k * 64 + j];
            h2[i] = sinf(fr[j] * acc); }
        __syncthreads();
        for (int i = tid; i < 1024; i += NTHR) { const int pp = i >> 6, j = i & 63; float acc = b3[j];
            for (int k = 0; k < 64; ++k) acc += h2[pp * 64 + k] * w3[k * 64 + j];
            h1[i] = sinf(fr[j] * acc); }
        __syncthreads();
        for (int dir = 0; dir < 2; ++dir) { const int c = tid, o = dir * 512 + c; float acc[16];
#pragma unroll
            for (int pp = 0; pp < 16; ++pp) acc[pp] = 0.f;
            for (int j = 0; j < 64; ++j) { const float w = wo[j * 1024 + o];
#pragma unroll
                for (int pp = 0; pp < 16; ++pp) acc[pp] += h1[pp * 64 + j] * w; }
            const float delta = 3.0701134573253945f + (float)c * ((15.350567286626972f - 3.0701134573253945f) / 511.0f); float ssq = 0.f;
#pragma unroll
            for (int pp = 0; pp < 16; ++pp) { const int p = p0 + pp; const float tn = (float)p * (1.0f / 4095.0f); const float val = acc[pp] * expf(-tn * delta);
                if (dir == 0) { Kraw[(size_t)c * 8192 + 4096 + p] = val; ssq += val * val; }
                else if (p >= 1) { Kraw[(size_t)c * 8192 + 4096 - p] = val; ssq += val * val; } }
            SSQ[pg * 1024 + o] = ssq;
            if (pg == 0 && dir == 0) Kraw[(size_t)c * 8192] = 0.f; }
        __syncthreads();
    }
}

__device__ __forceinline__ void p0_mod(const Args& a, unsigned char* lds) {
    float* sc = (float*)lds;
    float* red = sc + 9 * 1024;
    const int tid = threadIdx.x;
    if ((int)blockIdx.x >= 192) return;
    for (int i = tid; i < 9 * 1024; i += NTHR) { const float v = (i < 8192) ? a.in[I_C][i] : a.in[I_CCTX][i - 8192]; sc[i] = siluf(v); }
    __syncthreads();
    const float* wa = a.in[I_WADA]; const float* ba = a.in[I_BADA]; float* mod = (float*)(a.ws + WS_MOD);
    for (int it = blockIdx.x; it < 192; it += gridDim.x) {
        const int col = tid & 31, ks = tid >> 5, c0 = it * 32; float acc[9];
#pragma unroll
        for (int r = 0; r < 9; ++r) acc[r] = 0.f;
#pragma unroll 4
        for (int k = ks * 64; k < ks * 64 + 64; ++k) { const float w = wa[(size_t)k * MODW + c0 + col];
#pragma unroll
            for (int r = 0; r < 9; ++r) acc[r] += sc[r * 1024 + k] * w; }
#pragma unroll
        for (int r = 0; r < 9; ++r) red[(ks * 9 + r) * 32 + col] = acc[r];
        __syncthreads();
        if (tid < 288) { const int r = tid >> 5, cc = tid & 31; float s = ba[c0 + cc];
            for (int k2 = 0; k2 < 16; ++k2) s += red[(k2 * 9 + r) * 32 + cc];
            mod[r * MODW + c0 + cc] = s; }
        __syncthreads();
    }
}

__device__ __forceinline__ void p0_prologue(const Args& a, unsigned char* lds) {
    const int tid = threadIdx.x, lane = tid & 63, wave = tid >> 6;
    p0_filter(a, lds);
    __syncthreads();
    p0_mod(a, lds);
    __syncthreads();
    { v4u* z = (v4u*)((bf16*)(a.ws + WS_WIN) + (size_t)NIN * DM); const int n16 = (NINP - NIN) * DM * 2 / 16;
      for (int i = blockIdx.x * NTHR + tid; i < n16; i += gridDim.x * NTHR) z[i] = (v4u){0u, 0u, 0u, 0u}; }
    float* scr = (float*)(lds + wave * 16384);
    const int gw = blockIdx.x * NWAVES + wave, NGW = gridDim.x * NWAVES;
    constexpr int I_IN = (DM / 64) * (NIN / 32), I_O = (DM / 64) * (DM / 32), I_1 = (DM / 64) * (FF / 32), I_2 = (FF / 64) * (DM / 32);
    constexpr int NITEMS = I_IN + I_O + I_1 + I_2;
    for (int it = gw; it < NITEMS; it += NGW) {
        int r = it;
        if (r < I_IN) { p0_transpose_item(a.in[I_WIN], DM, NIN, (bf16*)(a.ws + WS_WIN), 0, scr, r, lane); continue; } r -= I_IN;
        if (r < I_O) { p0_transpose_item(a.in[I_WOUT], DM, DM, (bf16*)(a.ws + WS_WOUT), 0, scr, r, lane); continue; } r -= I_O;
        if (r < I_1) { p0_transpose_item(a.in[I_WM1], DM, FF, (bf16*)(a.ws + WS_W1), 0, scr, r, lane); continue; } r -= I_1;
        p0_transpose_item(a.in[I_WM2], FF, DM, (bf16*)(a.ws + WS_W2), 0, scr, r, lane);
    }
}

__device__ __forceinline__ void norm_mod_rows(const Args& a, const float* src_lat, const float* src_ctx, int nrows, const float* g, int sc_off, int sh_off, bf16* dst) {
    const int tid = threadIdx.x, lane = tid & 63, wave = tid >> 6;
    const int gw = blockIdx.x * NWAVES + wave, NGW = gridDim.x * NWAVES;
    const float* mod = (const float*)(a.ws + WS_MOD);
    for (int row = gw; row < nrows; row += NGW) {
        const float* src = row < MLAT ? src_lat + (size_t)row * DM : src_ctx + (size_t)(row - MLAT) * DM;
        const int mrow = row < MLAT ? row / SEQ : 8;
        const f32x4* xr = (const f32x4*)src + lane;
        f32x4 v[4]; float s = 0.f;
#pragma unroll
        for (int j = 0; j < 4; ++j) { v[j] = xr[64 * j]; s += (v[j].x * v[j].x + v[j].y * v[j].y) + (v[j].z * v[j].z + v[j].w * v[j].w); }
        const float rstd = rsqrtf(wave_sum(s) * (1.f / DM) + EPSF);
        unsigned long long* o8 = (unsigned long long*)(dst + (size_t)row * DM) + lane;
#pragma unroll
        for (int j = 0; j < 4; ++j) { const int col = 256 * j + 4 * lane;
            const f32x4 gg = *(const f32x4*)(g + col), scv = *(const f32x4*)(mod + mrow * MODW + sc_off + col), shv = *(const f32x4*)(mod + mrow * MODW + sh_off + col);
            const f32x4 y = (v[j] * rstd * gg) * (scv + 1.f) + shv;
            o8[64 * j] = (unsigned long long)pk2(y.x, y.y) | ((unsigned long long)pk2(y.z, y.w) << 32); }
    }
}
__device__ __forceinline__ void final_norm_rows(const Args& a) {
    const int tid = threadIdx.x, lane = tid & 63, wave = tid >> 6;
    const int gw = blockIdx.x * NWAVES + wave, NGW = gridDim.x * NWAVES;
    const float* g = a.in[I_NFIN];
    for (int row = gw; row < MLAT; row += NGW) {
        f32x4* xr = (f32x4*)(a.out + (size_t)row * DM) + lane;
        f32x4 v[4]; float s = 0.f;
#pragma unroll
        for (int j = 0; j < 4; ++j) { v[j] = xr[64 * j]; s += (v[j].x * v[j].x + v[j].y * v[j].y) + (v[j].z * v[j].z + v[j].w * v[j].w); }
        const float rstd = rsqrtf(wave_sum(s) * (1.f / DM) + EPSF);
#pragma unroll
        for (int j = 0; j < 4; ++j) { const f32x4 gg = *(const f32x4*)(g + 256 * j + 4 * lane); xr[64 * j] = v[j] * rstd * gg; }
    }
}

typedef short gbf16x8 __attribute__((ext_vector_type(8)));
typedef float gf32x16 __attribute__((ext_vector_type(16)));
constexpr int GL_ROWB = 144;
constexpr int G2_GR = 0;
constexpr int G2_WG = G2_GR + 2 * 64 * 17 * 4;
constexpr int G2_BG = G2_WG + 2 * 4096;
constexpr int G2_TOT = G2_BG + 512;
constexpr int G2_BCT = G2_TOT + 512;
constexpr int G2_OB = 0;
constexpr int G2_RS = G2_OB + 64 * 132 * 4;
constexpr int G2_QI = G2_BCT + 2 * 64 * 65 * 4;
constexpr int G2_KI = G2_QI + 2 * 64 * GL_ROWB;
constexpr int G2_ATT = G2_KI + 2 * 64 * GL_ROWB;
constexpr int G2_VT = G2_ATT + 2 * 64 * GL_ROWB;
constexpr int G2_END = G2_VT + 128 * GL_ROWB;
static_assert(G2_END <= MISC_OFF && G2_RS + 256 <= G2_QI && G2_QI % 16 == 0, "GLA LDS map");

#define LBAR() asm volatile("s_waitcnt lgkmcnt(0)\n\ts_barrier" ::: "memory")
__device__ __forceinline__ gbf16x8 gl_frag(const LAS unsigned char* p) { return __builtin_bit_cast(gbf16x8, *(const LAS v4u*)p); }
__device__ __forceinline__ void unpack8(const v4u r, float* o) {
    o[0] = bf2f(r.x & 0xffffu); o[1] = bf2f(r.x >> 16); o[2] = bf2f(r.y & 0xffffu); o[3] = bf2f(r.y >> 16);
    o[4] = bf2f(r.z & 0xffffu); o[5] = bf2f(r.z >> 16); o[6] = bf2f(r.w & 0xffffu); o[7] = bf2f(r.w >> 16);
}
__device__ __forceinline__ size_t gla_item(int b, int h, int dir, int ck) {
    const int sig = ck < 4 ? (dir == 0 ? ck : 3 - ck) : (dir == 0 ? ck : 71 - ck);
    return (size_t)((b * 4 + h) * 2 + dir) * NSIG + sig;
}
__device__ __forceinline__ float logsig16(float a) { return (fminf(a, 0.f) - __logf(1.0f + __expf(-fabsf(a)))) * (1.0f / 16.0f); }
struct GateRegs { v2u gr; float wg[4]; float bg; };
__device__ __forceinline__ void gla_gate_loads(const Args& a, GateRegs& g, const bf16* gp, size_t row0, int h) {
    const int tid = threadIdx.x;
    g.gr = *(const v2u*)(gp + (row0 + (tid >> 3)) * NGL + GGF + (tid & 7) * 4);
#pragma unroll
    for (int i = 0; i < 4; ++i) { const int idx = tid + NTHR * i, rem = idx & 1023; const float* w = a.in[(i >> 1) ? I_GKWB : I_GKWF]; g.wg[i] = w[(rem >> 6) * 256 + h * 64 + (rem & 63)]; }
    g.bg = tid < 128 ? a.in[(tid >> 6) ? I_GKBB : I_GKBF][h * 64 + (tid & 63)] : 0.f;
}
__device__ __forceinline__ void gla_gates2(LAS unsigned char* L, const GateRegs& g) {
    const int tid = threadIdx.x;
    LAS float* GR = (LAS float*)(L + G2_GR); LAS float* WG = (LAS float*)(L + G2_WG); LAS float* BG = (LAS float*)(L + G2_BG); LAS float* TOT = (LAS float*)(L + G2_TOT); LAS float* BCT = (LAS float*)(L + G2_BCT);
    { const int tok = tid >> 3, j = tid & 7, dir = j >> 2, r0 = (j & 3) * 4; LAS float* p = GR + dir * (16 * 68) + r0 * 68 + tok;
      p[0] = bf2f(g.gr.x & 0xffffu); p[68] = bf2f(g.gr.x >> 16); p[136] = bf2f(g.gr.y & 0xffffu); p[204] = bf2f(g.gr.y >> 16); }
#pragma unroll
    for (int i = 0; i < 4; ++i) WG[tid + NTHR * i] = g.wg[i];
    if (tid < 128) BG[tid] = g.bg;
    LBAR();
    { const int tb = tid & 15, db = (tid >> 4) & 15, dir = tid >> 8;
      const f32x4 bgv = *(const LAS f32x4*)(BG + dir * 64 + 4 * db); float acc[4][4];
#pragma unroll
      for (int i = 0; i < 4; ++i) { acc[i][0] = bgv.x; acc[i][1] = bgv.y; acc[i][2] = bgv.z; acc[i][3] = bgv.w; }
#pragma unroll
      for (int r = 0; r < 16; ++r) { const f32x4 gv = *(const LAS f32x4*)(GR + dir * (16 * 68) + r * 68 + 4 * tb), wv = *(const LAS f32x4*)(WG + dir * 1024 + r * 64 + 4 * db);
          const float ga[4] = {gv.x, gv.y, gv.z, gv.w}, wa[4] = {wv.x, wv.y, wv.z, wv.w};
#pragma unroll
          for (int i = 0; i < 4; ++i)
#pragma unroll
              for (int j = 0; j < 4; ++j) acc[i][j] += ga[i] * wa[j]; }
#pragma unroll
      for (int i = 0; i < 4; ++i)
#pragma unroll
          for (int j = 0; j < 4; ++j) BCT[dir * (64 * 65) + (4 * db + j) * 65 + 4 * tb + i] = logsig16(acc[i][j]); }
    LBAR();
    { const int d = tid >> 3, seg = tid & 7;
#pragma unroll
      for (int dir = 0; dir < 2; ++dir) { LAS float* bp = BCT + dir * (64 * 65) + d * 65; float v[8]; float run = 0.f;
#pragma unroll
          for (int j = 0; j < 8; ++j) { const int tp = seg * 8 + j, tok = dir ? 63 - tp : tp; run += bp[tok]; v[j] = run; }
          float inc = run;
#pragma unroll
          for (int o = 1; o < 8; o <<= 1) { const float t = __shfl_up(inc, o, 8); if (seg >= o) inc += t; }
          const float excl = inc - run;
#pragma unroll
          for (int j = 0; j < 8; ++j) { const int tp = seg * 8 + j, tok = dir ? 63 - tp : tp; bp[tok] = v[j] + excl; }
          if (seg == 7) TOT[dir * 64 + d] = inc; } }
    LBAR();
}
__device__ __forceinline__ void gla_put_vt(LAS unsigned char* L, const v4u r, int eg, int s) {
    LAS bf16* vt = (LAS bf16*)(L + G2_VT) + (eg * 8) * 72 + s;
    vt[0 * 72] = (bf16)(r.x & 0xffffu); vt[1 * 72] = (bf16)(r.x >> 16); vt[2 * 72] = (bf16)(r.y & 0xffffu); vt[3 * 72] = (bf16)(r.y >> 16);
    vt[4 * 72] = (bf16)(r.z & 0xffffu); vt[5 * 72] = (bf16)(r.z >> 16); vt[6 * 72] = (bf16)(r.w & 0xffffu); vt[7 * 72] = (bf16)(r.w >> 16);
}

__device__ __forceinline__ void gla_local_mfma(const Args& a, unsigned char* lds) {
    LAS unsigned char* L = (LAS unsigned char*)lds;
    const int tid = threadIdx.x, lane = tid & 63, wave = __builtin_amdgcn_readfirstlane(tid >> 6), r = lane & 31, hh = lane >> 5;
    const bf16* gp = (const bf16*)(a.ws + WS_GPROJ); bf16* ST = (bf16*)(a.ws + WS_XN); float* DEC = (float*)(a.ws + WS_DEC);
    LAS float* TOT = (LAS float*)(L + G2_TOT); LAS float* BCT = (LAS float*)(L + G2_BCT);
    const int s = tid & 63, dg = tid >> 6;
    for (int ci = blockIdx.x; ci < NB * 4 * NSIG; ci += gridDim.x) {
        const int ck = ci % NSIG, h = (ci / NSIG) & 3, b = ci / (NSIG * 4);
        const size_t row0 = ck < 4 ? (size_t)MLAT + b * CTXL + ck * 64 : (size_t)b * SEQ + (ck - 4) * 64;
        const bf16* rowp = gp + (row0 + s) * NGL;
        GateRegs g; gla_gate_loads(a, g, gp, row0, h);
        const v4u kr = *(const v4u*)(rowp + GK + h * 64 + dg * 8), v0 = *(const v4u*)(rowp + GV + h * 128 + dg * 8), v1 = *(const v4u*)(rowp + GV + h * 128 + 64 + dg * 8);
        gla_gates2(L, g);
        { float kv[8]; unpack8(kr, kv);
#pragma unroll
          for (int dir = 0; dir < 2; ++dir) { LAS bf16* ke = (LAS bf16*)(L + G2_QI + dir * 64 * GL_ROWB);
#pragma unroll
              for (int i = 0; i < 8; ++i) { const int d = dg * 8 + i; ke[d * 72 + s] = (bf16)f2bf(kv[i] * __expf(TOT[dir * 64 + d] - BCT[dir * (64 * 65) + d * 65 + s])); } }
          gla_put_vt(L, v0, dg, s); gla_put_vt(L, v1, dg + 8, s);
          if (tid < 128) DEC[gla_item(b, h, tid >> 6, ck) * 64 + (tid & 63)] = __expf(TOT[tid]); }
        LBAR();
#pragma unroll
        for (int j = 0; j < 2; ++j) { const int tile = 2 * wave + j, dir = tile >> 3, mt = (tile >> 2) & 1, nt = tile & 3;
            gf32x16 acc;
#pragma unroll
            for (int i = 0; i < 16; ++i) acc[i] = 0.f;
            const LAS unsigned char* ap = L + G2_QI + dir * 64 * GL_ROWB + (mt * 32 + r) * GL_ROWB + 16 * hh;
            const LAS unsigned char* bp = L + G2_VT + (nt * 32 + r) * GL_ROWB + 16 * hh;
#pragma unroll
            for (int kk = 0; kk < 4; ++kk) acc = __builtin_amdgcn_mfma_f32_32x32x16_bf16(gl_frag(ap + 32 * kk), gl_frag(bp + 32 * kk), acc, 0, 0, 0);
            bf16* sp = ST + gla_item(b, h, dir, ck) * 8192 + (nt * 32 + r) * 64 + mt * 32 + 4 * hh;
#pragma unroll
            for (int gq = 0; gq < 4; ++gq) { v2u o; o.x = pk2(acc[4 * gq], acc[4 * gq + 1]); o.y = pk2(acc[4 * gq + 2], acc[4 * gq + 3]); *(v2u*)(sp + 8 * gq) = o; } }
        LBAR();
    }
}

__device__ __forceinline__ void gla_scan(const Args& a) {
    bf16* ST = (bf16*)(a.ws + WS_XN); const float* DEC = (const float*)(a.ws + WS_DEC);
    for (int w = blockIdx.x * NTHR + threadIdx.x; w < 64 * 1024; w += gridDim.x * NTHR) {
        const int chain = w >> 10, el = (w & 1023) * 8, d0 = el & 63; float s[8];
#pragma unroll
        for (int i = 0; i < 8; ++i) s[i] = 0.f;
#pragma unroll 4
        for (int sig = 0; sig < NSIG; ++sig) { const size_t item = (size_t)chain * NSIG + sig;
            v4u* p = (v4u*)(ST + item * 8192 + el); const v4u dsv = *p;
            const f32x4 d0v = *(const f32x4*)(DEC + item * 64 + d0), d1v = *(const f32x4*)(DEC + item * 64 + d0 + 4);
            v4u o; o.x = pk2(s[0], s[1]); o.y = pk2(s[2], s[3]); o.z = pk2(s[4], s[5]); o.w = pk2(s[6], s[7]); *p = o;
            s[0] = d0v.x * s[0] + bf2f(dsv.x & 0xffffu); s[1] = d0v.y * s[1] + bf2f(dsv.x >> 16);
            s[2] = d0v.z * s[2] + bf2f(dsv.y & 0xffffu); s[3] = d0v.w * s[3] + bf2f(dsv.y >> 16);
            s[4] = d1v.x * s[4] + bf2f(dsv.z & 0xffffu); s[5] = d1v.y * s[5] + bf2f(dsv.z >> 16);
            s[6] = d1v.z * s[6] + bf2f(dsv.w & 0xffffu); s[7] = d1v.w * s[7] + bf2f(dsv.w >> 16); }
    }
}

__device__ __forceinline__ void gla_out_mfma(const Args& a, unsigned char* lds) {
    LAS unsigned char* L = (LAS unsigned char*)lds;
    const int tid = threadIdx.x, lane = tid & 63, wave = __builtin_amdgcn_readfirstlane(tid >> 6), r = lane & 31, hh = lane >> 5;
    const bf16* gp = (const bf16*)(a.ws + WS_GPROJ); const bf16* ST = (const bf16*)(a.ws + WS_XN); bf16* ycat = (bf16*)(a.ws + WS_YCAT);
    LAS float* BCT = (LAS float*)(L + G2_BCT); LAS float* OB = (LAS float*)(L + G2_OB); LAS float* RS = (LAS float*)(L + G2_RS);
    const int s = tid & 63, dg = tid >> 6;
    float gnv[16];
#pragma unroll
    for (int i = 0; i < 8; ++i) { gnv[i] = a.in[I_GLAN][dg * 8 + i]; gnv[8 + i] = a.in[I_GLAN][64 + dg * 8 + i]; }
    for (int it = blockIdx.x; it < NB * 4 * 64; it += gridDim.x) {
        const int n = it & 63, h = (it >> 6) & 3, b = it >> 8; const size_t row0 = (size_t)b * SEQ + n * 64;
        const bf16* rowp = gp + (row0 + s) * NGL;
        GateRegs g; gla_gate_loads(a, g, gp, row0, h);
        const v4u qr = *(const v4u*)(rowp + GQ + h * 64 + dg * 8), kr = *(const v4u*)(rowp + GK + h * 64 + dg * 8);
        const v4u v0 = *(const v4u*)(rowp + GV + h * 128 + dg * 8), v1 = *(const v4u*)(rowp + GV + h * 128 + 64 + dg * 8);
        const v4u og0 = *(const v4u*)(rowp + GOG + h * 128 + dg * 8), og1 = *(const v4u*)(rowp + GOG + h * 128 + 64 + dg * 8);
        const int omt = wave >> 2, ont = wave & 3;
        v4u stf[2][4];
#pragma unroll
        for (int dir = 0; dir < 2; ++dir) { const bf16* sp = ST + gla_item(b, h, dir, n + 4) * 8192 + (ont * 32 + r) * 64 + 8 * hh;
#pragma unroll
            for (int kk = 0; kk < 4; ++kk) stf[dir][kk] = *(const v4u*)(sp + 16 * kk); }
        gla_gates2(L, g);
        { float qv[8], kv[8]; unpack8(qr, qv); unpack8(kr, kv);
#pragma unroll
          for (int dir = 0; dir < 2; ++dir) { float qo[8], ko[8];
#pragma unroll
              for (int i = 0; i < 8; ++i) { const float bc = BCT[dir * (64 * 65) + (dg * 8 + i) * 65 + s]; qo[i] = qv[i] * 0.125f * __expf(bc); ko[i] = kv[i] * __expf(-bc); }
              v4u qw, kw; qw.x = pk2(qo[0], qo[1]); qw.y = pk2(qo[2], qo[3]); qw.z = pk2(qo[4], qo[5]); qw.w = pk2(qo[6], qo[7]);
              kw.x = pk2(ko[0], ko[1]); kw.y = pk2(ko[2], ko[3]); kw.z = pk2(ko[4], ko[5]); kw.w = pk2(ko[6], ko[7]);
              *(LAS v4u*)(L + G2_QI + dir * 64 * GL_ROWB + s * GL_ROWB + dg * 16) = qw;
              *(LAS v4u*)(L + G2_KI + dir * 64 * GL_ROWB + s * GL_ROWB + dg * 16) = kw; }
          gla_put_vt(L, v0, dg, s); gla_put_vt(L, v1, dg + 8, s); }
        LBAR();
        { const int dir = wave >> 2, mt = (wave >> 1) & 1, nt = wave & 1;
          gf32x16 acc;
#pragma unroll
          for (int i = 0; i < 16; ++i) acc[i] = 0.f;
          const LAS unsigned char* ap = L + G2_QI + dir * 64 * GL_ROWB + (mt * 32 + r) * GL_ROWB + 16 * hh;
          const LAS unsigned char* bp = L + G2_KI + dir * 64 * GL_ROWB + (nt * 32 + r) * GL_ROWB + 16 * hh;
#pragma unroll
          for (int kk = 0; kk < 4; ++kk) acc = __builtin_amdgcn_mfma_f32_32x32x16_bf16(gl_frag(ap + 32 * kk), gl_frag(bp + 32 * kk), acc, 0, 0, 0);
          LAS bf16* at = (LAS bf16*)(L + G2_ATT + dir * 64 * GL_ROWB); const int sc = nt * 32 + r;
#pragma unroll
          for (int i = 0; i < 16; ++i) { const int c = mt * 32 + (i & 3) + 8 * (i >> 2) + 4 * hh; const bool keep = dir == 0 ? (sc <= c) : (sc >= c);
              at[c * 72 + sc] = (bf16)f2bf(keep ? acc[i] : 0.f); } }
        LBAR();
        { gf32x16 acc;
#pragma unroll
          for (int i = 0; i < 16; ++i) acc[i] = 0.f;
#pragma unroll
          for (int dir = 0; dir < 2; ++dir) {
              const LAS unsigned char* ap = L + G2_ATT + dir * 64 * GL_ROWB + (omt * 32 + r) * GL_ROWB + 16 * hh;
              const LAS unsigned char* bp = L + G2_VT + (ont * 32 + r) * GL_ROWB + 16 * hh;
#pragma unroll
              for (int kk = 0; kk < 4; ++kk) acc = __builtin_amdgcn_mfma_f32_32x32x16_bf16(gl_frag(ap + 32 * kk), gl_frag(bp + 32 * kk), acc, 0, 0, 0);
              const LAS unsigned char* qp = L + G2_QI + dir * 64 * GL_ROWB + (omt * 32 + r) * GL_ROWB + 16 * hh;
#pragma unroll
              for (int kk = 0; kk < 4; ++kk) acc = __builtin_amdgcn_mfma_f32_32x32x16_bf16(gl_frag(qp + 32 * kk), __builtin_bit_cast(gbf16x8, stf[dir][kk]), acc, 0, 0, 0);
          }
#pragma unroll
          for (int i = 0; i < 16; ++i) { const int c = omt * 32 + (i & 3) + 8 * (i >> 2) + 4 * hh; OB[c * 132 + ont * 32 + r] = acc[i]; } }
        LBAR();
        for (int j = 0; j < 8; ++j) { const int c = wave * 8 + j; const float x0 = OB[c * 132 + lane], x1 = OB[c * 132 + 64 + lane];
            const float ss = wave_sum(x0 * x0 + x1 * x1); if (lane == 0) RS[c] = rsqrtf(ss * (1.f / 128.f) + EPSF); }
        LBAR();
        { const float rstd = RS[s]; float g0[8], g1[8]; unpack8(og0, g0); unpack8(og1, g1);
          const f32x4 a0 = *(const LAS f32x4*)(OB + s * 132 + dg * 8), a1 = *(const LAS f32x4*)(OB + s * 132 + dg * 8 + 4);
          const f32x4 b0 = *(const LAS f32x4*)(OB + s * 132 + 64 + dg * 8), b1 = *(const LAS f32x4*)(OB + s * 132 + 64 + dg * 8 + 4);
          const float ov0[8] = {a0.x, a0.y, a0.z, a0.w, a1.x, a1.y, a1.z, a1.w}, ov1[8] = {b0.x, b0.y, b0.z, b0.w, b1.x, b1.y, b1.z, b1.w};
          float y0[8], y1[8];
#pragma unroll
          for (int i = 0; i < 8; ++i) { y0[i] = ov0[i] * rstd * gnv[i] * siluf(g0[i]); y1[i] = ov1[i] * rstd * gnv[8 + i] * siluf(g1[i]); }
          v4u w0, w1; w0.x = pk2(y0[0], y0[1]); w0.y = pk2(y0[2], y0[3]); w0.z = pk2(y0[4], y0[5]); w0.w = pk2(y0[6], y0[7]);
          w1.x = pk2(y1[0], y1[1]); w1.y = pk2(y1[2], y1[3]); w1.z = pk2(y1[4], y1[5]); w1.w = pk2(y1[6], y1[7]);
          bf16* yp = ycat + (row0 + s) * DM + DH + h * 128 + dg * 8;
          *(v4u*)yp = w0; *(v4u*)(yp + 64) = w1; }
        LBAR();
    }
}

typedef short hbf16x8 __attribute__((ext_vector_type(8)));
typedef float hf32x16 __attribute__((ext_vector_type(16)));
constexpr int HK_COPYB = 16448, HK_OFF = 0, HZ_OFF = 4 * HK_COPYB, HZ_ROWB = 8208, HZERO_OFF = HZ_OFF + 8 * HZ_ROWB, HRED_OFF = HZERO_OFF + 64;
static_assert(HRED_OFF + 64 <= LDS_BYTES && 8 * HZ_ROWB <= 4 * HK_COPYB, "hyena LDS map");
__device__ __forceinline__ void hy_unpack8(const v4u r, float* o) {
    o[0] = bf2f(r.x & 0xffffu); o[1] = bf2f(r.x >> 16); o[2] = bf2f(r.y & 0xffffu); o[3] = bf2f(r.y >> 16);
    o[4] = bf2f(r.z & 0xffffu); o[5] = bf2f(r.z >> 16); o[6] = bf2f(r.w & 0xffffu); o[7] = bf2f(r.w >> 16);
}
__device__ __forceinline__ void hyena_conv_mfma(const Args& a, unsigned char* lds) {
    LAS unsigned char* L = (LAS unsigned char*)lds;
    const int tid = threadIdx.x, lane = tid & 63, wave = __builtin_amdgcn_readfirstlane(tid >> 6), r = lane & 31, h = lane >> 5;
    const bf16* hyT = (const bf16*)(a.ws + WS_HYT); bf16* yT = (bf16*)(a.ws + WS_YT);
    const float* Kraw = (const float*)(a.ws + WS_KRAW); const float* SSQ = (const float*)(a.ws + WS_SSQ);
    const float* cw = a.in[I_CONVW]; const float* cbv = a.in[I_CONVB];
    LAS float* RED = (LAS float*)(L + HRED_OFF);
    for (int c = blockIdx.x; c < DH; c += gridDim.x) {
        { const float part = SSQ[(tid >> 1) * 1024 + (tid & 1) * 512 + c]; const float ws = wave_sum(part); if (lane == 0) RED[wave] = ws; }
        __syncthreads();
        float tot = 0.f;
#pragma unroll
        for (int i = 0; i < 8; ++i) tot += RED[i];
        const float sc = rsqrtf(tot + EPSF);
        for (int idx = tid; idx < 4 * 4096; idx += NTHR) { const int s = idx >> 12, y = (idx & 4095) * 2, x = y + s;
            const float v0 = (x >= 1 && x <= 8191) ? Kraw[(size_t)c * 8192 + 8192 - x] * sc : 0.f;
            const float v1 = (x + 1 <= 8191) ? Kraw[(size_t)c * 8192 + 8191 - x] * sc : 0.f;
            *(LAS unsigned*)(L + HK_OFF + s * HK_COPYB + 2 * y) = pk2(v0, v1); }
        if (tid < 4) ((LAS unsigned*)(L + HZERO_OFF))[tid] = 0u;
        { const int c1 = DH + c, c2 = 2 * DH + c;
          const float a0 = cw[c1], a1 = cw[NHY + c1], a2 = cw[2 * NHY + c1], ab = cbv[c1], b0 = cw[c2], b1 = cw[NHY + c2], b2 = cw[2 * NHY + c2], bb = cbv[c2];
          for (int gi = tid; gi < 4096; gi += NTHR) { const int b = gi >> 9, t0 = (gi & 511) * 8, col = b * SEQ + t0;
              const bf16* p1 = hyT + (size_t)c1 * MLAT + col; const bf16* p2 = hyT + (size_t)c2 * MLAT + col;
              float u[10], w[10];
              hy_unpack8(*(const v4u*)p1, u + 1); hy_unpack8(*(const v4u*)p2, w + 1);
              const bool hl = (t0 & 63) != 0, hr = ((t0 + 8) & 63) != 0;
              u[0] = hl ? bf2f(p1[-1]) : 0.f; w[0] = hl ? bf2f(p2[-1]) : 0.f; u[9] = hr ? bf2f(p1[8]) : 0.f; w[9] = hr ? bf2f(p2[8]) : 0.f;
              float z[8];
#pragma unroll
              for (int i = 0; i < 8; ++i) z[i] = (ab + a0 * u[i] + a1 * u[i + 1] + a2 * u[i + 2]) * (bb + b0 * w[i] + b1 * w[i + 1] + b2 * w[i + 2]);
              v4u o; o.x = pk2(z[0], z[1]); o.y = pk2(z[2], z[3]); o.z = pk2(z[4], z[5]); o.w = pk2(z[6], z[7]);
              *(LAS v4u*)(L + HZ_OFF + b * HZ_ROWB + 2 * t0) = o; } }
        __syncthreads();
        hf32x16 acc[2][2];
#pragma unroll
        for (int m = 0; m < 2; ++m)
#pragma unroll
            for (int n = 0; n < 2; ++n)
#pragma unroll
                for (int i = 0; i < 16; ++i) acc[m][n][i] = 0.f;
        const int I0 = 8 * wave, q = r >> 3, b = r & 7, sh = (-r) & 3;
        const int a_lane = HK_OFF + sh * HK_COPYB + 2 * (4096 - r + 8 * h - sh);
        const int b_lane = HZ_OFF + b * HZ_ROWB + 16 * h;
        for (int d = I0 - 63; d <= I0 + 7; ++d) {
            const int J0 = I0 + q - d, J1 = J0 + 4;
            const bool ok0 = (unsigned)J0 < 64u, ok1 = (unsigned)J1 < 64u;
            const int abase = a_lane - 128 * d, bb0 = ok0 ? b_lane + 128 * J0 : HZERO_OFF, bb1 = ok1 ? b_lane + 128 * J1 : HZERO_OFF;
#pragma unroll
            for (int kk = 0; kk < 4; ++kk) {
                hbf16x8 af[2], bf[2];
#pragma unroll
                for (int m = 0; m < 2; ++m) { const int ad = abase - 64 * m + 32 * kk;
                    const v2u lo = *(const LAS v2u*)(L + ad), hi = *(const LAS v2u*)(L + ad + 8);
                    af[m] = __builtin_bit_cast(hbf16x8, (v4u){lo.x, lo.y, hi.x, hi.y}); }
                bf[0] = __builtin_bit_cast(hbf16x8, *(const LAS v4u*)(L + bb0 + (ok0 ? 32 * kk : 0)));
                bf[1] = __builtin_bit_cast(hbf16x8, *(const LAS v4u*)(L + bb1 + (ok1 ? 32 * kk : 0)));
#pragma unroll
                for (int m = 0; m < 2; ++m)
#pragma unroll
                    for (int n = 0; n < 2; ++n) acc[m][n] = __builtin_amdgcn_mfma_f32_32x32x16_bf16(af[m], bf[n], acc[m][n], 0, 0, 0);
            }
        }
        __syncthreads();
        for (int gi = tid; gi < 4096; gi += NTHR) { const int bb = gi >> 9, t0 = (gi & 511) * 8;
            *(LAS v4u*)(L + HK_OFF + bb * HZ_ROWB + 2 * t0) = *(const v4u*)(hyT + (size_t)c * MLAT + bb * SEQ + t0); }
        __syncthreads();
        { const float w0 = cw[c], w1 = cw[NHY + c], w2 = cw[2 * NHY + c], wb = cbv[c], hb = a.in[I_HBIAS][c];
#pragma unroll
          for (int m = 0; m < 2; ++m)
#pragma unroll
              for (int n = 0; n < 2; ++n)
#pragma unroll
                  for (int g = 0; g < 4; ++g) { const int t0 = 64 * (I0 + 4 * n + q) + 32 * m + 8 * g + 4 * h;
                      const LAS bf16* xp = (const LAS bf16*)(L + HK_OFF + b * HZ_ROWB + 2 * t0);
                      const v2u xr = *(const LAS v2u*)xp; const v2u zr = *(const LAS v2u*)(L + HZ_OFF + b * HZ_ROWB + 2 * t0);
                      float xv[6];
                      xv[0] = (t0 & 63) != 0 ? bf2f(xp[-1]) : 0.f; xv[5] = ((t0 + 4) & 63) != 0 ? bf2f(xp[4]) : 0.f;
                      xv[1] = bf2f(xr.x & 0xffffu); xv[2] = bf2f(xr.x >> 16); xv[3] = bf2f(xr.y & 0xffffu); xv[4] = bf2f(xr.y >> 16);
                      const float zv[4] = {bf2f(zr.x & 0xffffu), bf2f(zr.x >> 16), bf2f(zr.y & 0xffffu), bf2f(zr.y >> 16)};
                      float y[4];
#pragma unroll
                      for (int k = 0; k < 4; ++k) y[k] = (wb + w0 * xv[k] + w1 * xv[k + 1] + w2 * xv[k + 2]) * (acc[m][n][4 * g + k] + hb * zv[k]);
                      v2u o; o.x = pk2(y[0], y[1]); o.y = pk2(y[2], y[3]);
                      *(v2u*)(yT + (size_t)c * MLAT + b * SEQ + t0) = o; } }
        __syncthreads();
    }
}
__device__ __forceinline__ void hyena_transpose(const Args& a, unsigned char* lds) {
    const int tid = threadIdx.x, lane = tid & 63, wave = tid >> 6;
    bf16* scr = (bf16*)(lds + wave * 16384);
    const bf16* yT = (const bf16*)(a.ws + WS_YT); bf16* ycat = (bf16*)(a.ws + WS_YCAT);
    const int gw = blockIdx.x * NWAVES + wave, NGW = gridDim.x * NWAVES;
    for (int t = gw; t < (DH / 64) * (MLAT / 64); t += NGW) { const int cb = t & 7, tb = t >> 3, c0 = cb * 64, k0 = tb * 64;
        for (int r = 0; r < 64; ++r) scr[r * 66 + lane] = yT[(size_t)(c0 + r) * MLAT + k0 + lane];
        LDS_WAIT(); asm volatile("" ::: "memory");
        for (int r = 0; r < 64; ++r) ycat[(size_t)(k0 + r) * DM + c0 + lane] = scr[lane * 66 + r];
        LDS_WAIT(); asm volatile("" ::: "memory"); }
}

#define XB_TMO      128
#define XB_XCNT(j)  (256  + 64 * (j))
#define XB_XSUB(j)  (1280 + 64 * (j))
#define XB_XGEN(j)  (2304 + 64 * (j))
#define XB_TOP      3328
#define XB_TOPGEN   3392
#define XCD_BAR_WORDS 3456
#define XB_SPIN_CAP (1u << 18)

__device__ __forceinline__ unsigned xb_ld(unsigned* p)              { return __hip_atomic_load(p, __ATOMIC_RELAXED, __HIP_MEMORY_SCOPE_AGENT); }
__device__ __forceinline__ unsigned xb_add(unsigned* p, unsigned v) { return __hip_atomic_fetch_add(p, v, __ATOMIC_RELAXED, __HIP_MEMORY_SCOPE_AGENT); }
__device__ __forceinline__ unsigned xb_xcc_id() { return (unsigned)__builtin_amdgcn_s_getreg((3 << 11) | 20) & 0xFu; }
#define XB_SPIN(cond, bar) do { unsigned _sp = 0; while (cond) { __builtin_amdgcn_s_sleep(1); \
    if ((++_sp & 255u) == 0u) { if (xb_ld(&(bar)[XB_TMO])) break; if (_sp > XB_SPIN_CAP) { atomicAdd(&(bar)[XB_TMO], 1u); break; } } } } while (0)

struct XcdBarrier {
    unsigned* bar; unsigned x;
    volatile LAS unsigned* st;
};

__device__ __forceinline__ XcdBarrier xcd_barrier_post(unsigned* bar, volatile LAS unsigned* st) {
    XcdBarrier b; b.bar = bar; b.x = xb_xcc_id(); b.st = st;
    if (threadIdx.x == 0) (void)xb_add(&bar[XB_XCNT(b.x)], 1u);
    return b;
}
__device__ __forceinline__ void xcd_barrier_complete(unsigned* bar, unsigned x, unsigned& nloc, unsigned& nx) {
    const unsigned G = gridDim.x * gridDim.y * gridDim.z;
    unsigned sum, cnt, mine, sp = 0u;
    for (;;) {
        sum = 0u; cnt = 0u; mine = 0u;
#pragma unroll
        for (unsigned j = 0; j < 16; ++j) { const unsigned c = xb_ld(&bar[XB_XCNT(j)]); sum += c; cnt += (c > 0u) ? 1u : 0u; mine = (j == x) ? c : mine; }
        if (sum == G) break;
        __builtin_amdgcn_s_sleep(1);
        if ((++sp & 255u) == 0u) { if (xb_ld(&bar[XB_TMO])) break; if (sp > XB_SPIN_CAP) { atomicAdd(&bar[XB_TMO], 1u); break; } }
    }
    nloc = mine > 0u ? mine : 1u; nx = cnt > 0u ? cnt : 1u;
}

__device__ __forceinline__ void xcd_barrier(const XcdBarrier& b) {
    asm volatile("s_waitcnt vmcnt(0)" ::: "memory");
    __syncthreads();
    if (threadIdx.x == 0) {
        unsigned* bar = b.bar;
        __builtin_amdgcn_s_waitcnt(0);
        unsigned nloc = b.st[0], nx = b.st[1];
        if (nloc == 0u) { xcd_barrier_complete(bar, b.x, nloc, nx); b.st[0] = nloc; b.st[1] = nx; }
        const unsigned old = xb_add(&bar[XB_XSUB(b.x)], 1u);
        const unsigned gen = old / nloc;
        if (old + 1u == (gen + 1u) * nloc) {
            __builtin_amdgcn_fence(__ATOMIC_RELEASE, "agent");
            asm volatile("s_waitcnt vmcnt(0)" ::: "memory");
            const unsigned og = xb_add(&bar[XB_TOP], 1u);
            const unsigned tg = og / nx;
            if (og + 1u == (tg + 1u) * nx) xb_add(&bar[XB_TOPGEN], 1u);
            else XB_SPIN(xb_ld(&bar[XB_TOPGEN]) == tg, bar);
            __builtin_amdgcn_fence(__ATOMIC_ACQUIRE, "agent");
            xb_add(&bar[XB_XGEN(b.x)], 1u);
            asm volatile("s_waitcnt vmcnt(0)" ::: "memory");
        } else {
            XB_SPIN(xb_ld(&bar[XB_XGEN(b.x)]) == gen, bar);
            __builtin_amdgcn_fence(__ATOMIC_ACQUIRE, "agent");
            asm volatile("s_waitcnt vmcnt(0)" ::: "memory");
        }
    }
    __syncthreads();
}

constexpr int NPHASE = 11;
#define PROBE_REPEAT 0
__global__ void __launch_bounds__(NTHR, 2) fwd_kernel(Args a) {
    extern __shared__ __attribute__((aligned(16))) unsigned char lds[];
    const int lo = a.ph_lo, hi = a.ph_hi;
    volatile LAS unsigned* MISC = (volatile LAS unsigned*)((LAS unsigned char*)lds + MISC_OFF);
    if (threadIdx.x < 16) MISC[threadIdx.x] = 0u;
    __syncthreads();
    XcdBarrier bar = xcd_barrier_post((unsigned*)(a.ws + WS_CTL) + CW_BAR, MISC + 8);
#define IN(k) (lo <= (k) && (k) < hi)
#define SEAM(k) do { if (IN(k) && IN((k) + 1)) xcd_barrier(bar); } while (0)
    unsigned char* ws = a.ws;
    PG8_LAS unsigned char* ldsg = (PG8_LAS unsigned char*)lds;
    if (IN(0)) { for (int rep = 0; rep < 1 + ((PROBE_REPEAT >> 4) & 1); ++rep) { p0_prologue(a, lds); __syncthreads(); } } SEAM(0);
    if (IN(1)) { norm_mod_rows(a, a.in[I_X], a.in[I_CTX], MALL, a.in[I_NMIX], MOD_SC1, MOD_SH1, (bf16*)(ws + WS_XN)); } SEAM(1);
    if (IN(2)) {
        { pg8::Gemm g{(const pg8::bf16_t*)(ws + WS_WIN), (const pg8::bf16_t*)(ws + WS_XN), NHY, MLAT, DM}; pg8::StaticOrder S; S.init(NHY, MLAT, gridDim.x, blockIdx.x);
          pg8::EpiBf16<0> E{(pg8::bf16_t*)(ws + WS_HYT), MLAT};
          pg8::gemm_phase<pg8::EpiBf16<0>, pg8::StaticOrder, true, true>(ldsg, g, S, E); }
        __syncthreads();
        { pg8::Gemm g{(const pg8::bf16_t*)(ws + WS_XN), (const pg8::bf16_t*)(ws + WS_WIN) + (size_t)NHY * DM, MALL, NGL, DM}; pg8::StaticOrder S; S.init(MALL, NGL, gridDim.x, blockIdx.x);
          pg8::EpiBf16<0> E{(pg8::bf16_t*)(ws + WS_GPROJ), NGL};
          pg8::gemm_phase<pg8::EpiBf16<0>, pg8::StaticOrder, true, true>(ldsg, g, S, E); }
    } SEAM(2);
    if (IN(3)) { for (int rep = 0; rep < 1 + ((PROBE_REPEAT >> 0) & 1); ++rep) { gla_local_mfma(a, lds); __syncthreads(); }
                 for (int rep = 0; rep < 1 + ((PROBE_REPEAT >> 1) & 1); ++rep) { hyena_conv_mfma(a, lds); __syncthreads(); } } SEAM(3);
    if (IN(4)) { gla_scan(a); } SEAM(4);
    if (IN(5)) { for (int rep = 0; rep < 1 + ((PROBE_REPEAT >> 2) & 1); ++rep) { gla_out_mfma(a, lds); __syncthreads(); }
                 for (int rep = 0; rep < 1 + ((PROBE_REPEAT >> 3) & 1); ++rep) { hyena_transpose(a, lds); __syncthreads(); } } SEAM(5);
    if (IN(6)) { pg8::Gemm g{(const pg8::bf16_t*)(ws + WS_YCAT), (const pg8::bf16_t*)(ws + WS_WOUT), MLAT, DM, DM}; pg8::StaticOrder S; S.init(MLAT, DM, gridDim.x, blockIdx.x);
        pg8::EpiResid E{a.in[I_X], a.out, DM, (const float*)(ws + WS_MOD) + MOD_G1, SEQ, MODW};
        pg8::gemm_phase<pg8::EpiResid, pg8::StaticOrder, true, true>(ldsg, g, S, E); } SEAM(6);
    if (IN(7)) { norm_mod_rows(a, a.out, a.out, MLAT, a.in[I_NMLP], MOD_SC2, MOD_SH2, (bf16*)(ws + WS_XN)); } SEAM(7);
    if (IN(8)) { pg8::Gemm g{(const pg8::bf16_t*)(ws + WS_XN), (const pg8::bf16_t*)(ws + WS_W1), MLAT, FF, DM}; pg8::StaticOrder S; S.init(MLAT, FF, gridDim.x, blockIdx.x);
        pg8::EpiBf16<1> E{(pg8::bf16_t*)(ws + WS_HID), FF};
        pg8::gemm_phase<pg8::EpiBf16<1>, pg8::StaticOrder, true, true>(ldsg, g, S, E); } SEAM(8);
    if (IN(9)) { pg8::Gemm g{(const pg8::bf16_t*)(ws + WS_HID), (const pg8::bf16_t*)(ws + WS_W2), MLAT, DM, FF}; pg8::StaticOrder S; S.init(MLAT, DM, gridDim.x, blockIdx.x);
        pg8::EpiResid E{a.out, a.out, DM, (const float*)(ws + WS_MOD) + MOD_G2, SEQ, MODW};
        pg8::gemm_phase<pg8::EpiResid, pg8::StaticOrder, true, true>(ldsg, g, S, E); } SEAM(9);
    if (IN(10)) { final_norm_rows(a); }
#undef IN
#undef SEAM
}

#ifndef N_LAUNCH_MODE
#define N_LAUNCH_MODE 1
#endif
extern "C" void kernel_launch(void* const* d_in, const int* in_sizes, int n_in, void* d_out, int out_size, void* d_ws, size_t ws_size, hipStream_t stream) {
    static int grid = 0;
    if (grid == 0) {
        if (n_in != 29 || out_size != MLAT * DM || ws_size < WS_END) { fprintf(stderr, "kernel_launch: unexpected shapes (n_in %d out %d ws %zu)\n", n_in, out_size, ws_size); grid = -1; return; }
        int dev = 0, cus = 0, per_cu = 0;
        if (hipGetDevice(&dev) != hipSuccess || hipDeviceGetAttribute(&cus, hipDeviceAttributeMultiprocessorCount, dev) != hipSuccess) { grid = -1; return; }
        if (hipFuncSetAttribute((const void*)fwd_kernel, hipFuncAttributeMaxDynamicSharedMemorySize, LDS_BYTES) != hipSuccess) { fprintf(stderr, "kernel_launch: hipFuncSetAttribute failed\n"); grid = -1; return; }
        if (hipOccupancyMaxActiveBlocksPerMultiprocessor(&per_cu, (const void*)fwd_kernel, NTHR, LDS_BYTES) != hipSuccess || per_cu < 1) { fprintf(stderr, "kernel_launch: occupancy query says %d blocks per CU\n", per_cu); (void)hipGetLastError(); grid = -1; return; }
        grid = cus;
    }
    if (grid < 0) return;
    Args a{};
    for (int i = 0; i < 29; ++i) a.in[i] = (const float*)d_in[i];
    a.out = (float*)d_out; a.ws = (unsigned char*)d_ws;
#if N_LAUNCH_MODE == 0
    for (int p = 0; p < NPHASE; ++p) { a.ph_lo = p; a.ph_hi = p + 1; hipLaunchKernelGGL(fwd_kernel, dim3(grid), dim3(NTHR), LDS_BYTES, stream, a); }
#else
    a.ph_lo = 0; a.ph_hi = NPHASE;
    if (hipMemsetAsync((char*)d_ws + WS_CTL, 0, CTL_ZERO_BYTES, stream) != hipSuccess) { fprintf(stderr, "kernel_launch: memset of the control words failed\n"); return; }
    hipLaunchKernelGGL(fwd_kernel, dim3(grid), dim3(NTHR), LDS_BYTES, stream, a);
#endif
}
```

```cpp
#include <hip/hip_runtime.h>
#include <hip/hip_cooperative_groups.h>
#include <cstdio>
#include <cstdint>
#include <cmath>
namespace cg = cooperative_groups;
namespace pg8 {
#define PG8_LAS __attribute__((address_space(3)))
typedef unsigned short bf16_t;
typedef short bf16x8 __attribute__((ext_vector_type(8)));
typedef float f32x4 __attribute__((ext_vector_type(4)));
typedef unsigned u32x4 __attribute__((ext_vector_type(4)));
constexpr int BM = 256, BK = 64, HALF = 128, HTB = HALF * BK * 2  , STAGE_BYTES = 8 * HTB, NXCD = 8, WGM = 8;

__host__ __device__ __forceinline__ int lds_byte(int r, int c) { const int st = (r >> 4) * 2 + (c >> 5), rr = r & 15, cc = c & 31, ob = rr * 64 + cc * 2; return st * 1024 + (ob ^ (((ob >> 9) & 1) << 5)); }
__host__ __device__ __forceinline__ void stage_rc(int b, int& R, int& C) { const int st = b / 1024, sb = b % 1024, swz = sb ^ (((sb >> 9) & 1) << 5); R = (st >> 1) * 16 + swz / 64; C = (st & 1) * 32 + (swz % 64) / 2; }
__host__ __device__ __forceinline__ int perm32(int rho) { const int n = rho >> 4, i = rho & 15; return 8 * (i >> 2) + 4 * n + (i & 3); }

struct Unit { int pm, pn; };
struct Gemm { const bf16_t* A; const bf16_t* Bt; int M, N, K; };

struct StaticOrder {
    int nM, nN, nwg, G, c;
    __host__ __device__ void init(int M, int N, int G_, int c_) { nM = M / BM; nN = N / BM; nwg = nM * nN; G = G_; c = c_; }
    __host__ __device__ bool next(int i, Unit& u) const {
        const long L = (long)i * G + c; if (L >= nwg) return false;
        int wgid = (int)L; { const int q = nwg / NXCD, r = nwg % NXCD, xcd = wgid % NXCD, off = wgid / NXCD; wgid = (xcd < r ? xcd * (q + 1) : r * (q + 1) + (xcd - r) * q) + off; }
        const int nig = WGM * nN, gid = wgid / nig, fm = gid * WGM, gsz = (nM - fm) < WGM ? (nM - fm) : WGM;
        u.pm = fm + ((wgid % nig) % gsz); u.pn = (wgid % nig) / gsz; return true;
    }
    __device__ __forceinline__ void a_ready(const Unit&) const {}
    __device__ __forceinline__ void done(const Unit&) const {}
};


__device__ __forceinline__ unsigned cvt_pk_bf16(float lo, float hi) { unsigned r; asm volatile("v_cvt_pk_bf16_f32 %0, %1, %2" : "=v"(r) : "v"(lo), "v"(hi)); return r; }

template <int ACT> struct EpiBf16 {
    static constexpr bool PERM = true, AFTER_DRAIN = false;
    bf16_t* O; int ldc;
    __device__ __forceinline__ void operator()(const f32x4 (&acc)[2][2][4][2], const Unit& u, int wr, int wc, int fr, int fq) const {
        const int row0 = u.pm * BM + wr * 64 + fr; const int col0 = u.pn * BM + wc * 32 + 8 * fq;
#pragma unroll
        for (int ai = 0; ai < 2; ++ai)
#pragma unroll
            for (int m = 0; m < 4; ++m) { bf16_t* rowp = O + (size_t)(row0 + ai * HALF + m * 16) * ldc + col0;
#pragma unroll
                for (int bj = 0; bj < 2; ++bj) { f32x4 v0 = acc[ai][bj][m][0], v1 = acc[ai][bj][m][1];
                    if (ACT == 1) {
#pragma unroll
                        for (int q = 0; q < 4; ++q) { const float a0 = fmaxf(v0[q], 0.f), a1 = fmaxf(v1[q], 0.f); v0[q] = a0 * a0; v1[q] = a1 * a1; } }
                    u32x4 w; w.x = cvt_pk_bf16(v0[0], v0[1]); w.y = cvt_pk_bf16(v0[2], v0[3]); w.z = cvt_pk_bf16(v1[0], v1[1]); w.w = cvt_pk_bf16(v1[2], v1[3]);
                    *(u32x4*)(rowp + bj * HALF) = w; } }
    }
};
struct EpiResid {
    static constexpr bool PERM = false, AFTER_DRAIN = false;
    const float* base; float* out; int ldc; const float* gate; int rows_per_gate; int gate_stride;
    __device__ __forceinline__ void operator()(const f32x4 (&acc)[2][2][4][2], const Unit& u, int wr, int wc, int fr, int fq) const {
        const int row0 = u.pm * BM + wr * 64 + fr, col0 = u.pn * BM + wc * 32 + 4 * fq;
        const float* gp = gate + (size_t)((u.pm * BM) / rows_per_gate) * gate_stride + col0;
        f32x4 gv[2][2];
#pragma unroll
        for (int bj = 0; bj < 2; ++bj)
#pragma unroll
            for (int n = 0; n < 2; ++n) gv[bj][n] = *(const f32x4*)(gp + bj * HALF + n * 16);
#pragma unroll
        for (int ai = 0; ai < 2; ++ai)
#pragma unroll
            for (int m = 0; m < 4; ++m) { const size_t off = (size_t)(row0 + ai * HALF + m * 16) * ldc + col0;
#pragma unroll
                for (int bj = 0; bj < 2; ++bj)
#pragma unroll
                    for (int n = 0; n < 2; ++n) { const f32x4 bs = *(const f32x4*)(base + off + bj * HALF + n * 16);
                        *(f32x4*)(out + off + bj * HALF + n * 16) = bs + gv[bj][n] * acc[ai][bj][m][n]; } }
    }
};

template <class Epi, class Sched, bool ALIGN_EPI = false, bool SP2 = false>
__device__ __forceinline__ void gemm_phase(PG8_LAS unsigned char* lds, const Gemm g, const Sched& S, const Epi& E) {
    const int tid = threadIdx.x, wid = __builtin_amdgcn_readfirstlane(tid >> 6), lane = tid & 63, wr = wid >> 2, wc = wid & 3, fr = lane & 15, fq = lane >> 4;
    const int K = g.K, nt = K / BK;
    unsigned voffA[2], voffB[2];
#pragma unroll
    for (int i = 0; i < 2; ++i) { int R, C; stage_rc(tid * 16 + i * 8192, R, C); const int Rb = Epi::PERM ? ((R & ~31) + perm32(R & 31)) : R;
        voffA[i] = (unsigned)(R * K + C) * 2u; voffB[i] = (unsigned)(Rb * K + C) * 2u; }
    const size_t kstep = (size_t)(BK * 2);
    const size_t hstep = (size_t)HALF * K * 2;
    const size_t tstep = 2 * hstep;
    const unsigned ldsw = (unsigned)wid * 1024u;
    const int aoff = lds_byte(wr * 64 + fr, fq * 8), boff = lds_byte(wc * 32 + fr, fq * 8);
#define PG8_SA(b, h) (((b) * 2 + (h)) * HTB)
#define PG8_SB(b, h) ((4 + (b) * 2 + (h)) * HTB)
#define PG8_STAGE(bufoff, gbase, voff) do { _Pragma("unroll") for (int _i = 0; _i < 2; ++_i) \
        __builtin_amdgcn_global_load_lds((const unsigned*)((const char*)(gbase) + (voff)[_i]), (PG8_LAS unsigned*)(lds + (bufoff) + ldsw + _i * 8192), 16, 0, 0); } while (0)
#define PG8_LDA(dst, b, h) do { _Pragma("unroll") for (int m = 0; m < 4; ++m) _Pragma("unroll") for (int k = 0; k < 2; ++k) dst[m][k] = *(const PG8_LAS bf16x8*)(lds + PG8_SA(b, h) + aoff + m * 2048 + k * 1024); } while (0)
#define PG8_LDB(dst, b, h) do { _Pragma("unroll") for (int n = 0; n < 2; ++n) _Pragma("unroll") for (int k = 0; k < 2; ++k) dst[n][k] = *(const PG8_LAS bf16x8*)(lds + PG8_SB(b, h) + boff + n * 2048 + k * 1024); } while (0)
#define PG8_MMA(ai, bj, At, Bt) do { __builtin_amdgcn_s_setprio(1); _Pragma("unroll") for (int m = 0; m < 4; ++m) _Pragma("unroll") for (int n = 0; n < 2; ++n) _Pragma("unroll") for (int k = 0; k < 2; ++k) \
        acc[ai][bj][m][n] = __builtin_amdgcn_mfma_f32_16x16x32_bf16(Bt[n][k], At[m][k], acc[ai][bj][m][n], 0, 0, 0); __builtin_amdgcn_s_setprio(0); } while (0)
#define PG8_WAIT_V(n) asm volatile("s_waitcnt vmcnt(" #n ")" ::: "memory")
#define PG8_WAIT_L(n) asm volatile("s_waitcnt lgkmcnt(" #n ")" ::: "memory")
#define PG8_BAR __builtin_amdgcn_s_barrier()
#define PG8_SCHED __builtin_amdgcn_sched_barrier(0)
    Unit cur, nxt; int ui = 0;
    if (!S.next(0, cur)) return;
    f32x4 acc[2][2][4][2];
#pragma unroll
    for (int a = 0; a < 2; ++a)
#pragma unroll
        for (int b = 0; b < 2; ++b)
#pragma unroll
            for (int m = 0; m < 4; ++m)
#pragma unroll
                for (int n = 0; n < 2; ++n) acc[a][b][m][n] = (f32x4){0.f, 0.f, 0.f, 0.f};
    bf16x8 At[4][2], B0[2][2], B1[2][2];
    const char* cA = (const char*)g.A + (size_t)cur.pm * tstep; const char* cB = (const char*)g.Bt + (size_t)cur.pn * tstep;
    S.a_ready(cur);
    if constexpr (SP2) {
        PG8_STAGE(PG8_SB(0, 0), cB, voffB); PG8_STAGE(PG8_SB(0, 1), cB + hstep, voffB); PG8_STAGE(PG8_SA(0, 0), cA, voffA); PG8_STAGE(PG8_SA(0, 1), cA + hstep, voffA);
        if (wr == 1) PG8_BAR;
        PG8_WAIT_V(2); PG8_BAR;
        PG8_STAGE(PG8_SB(1, 0), cB + kstep, voffB); PG8_STAGE(PG8_SA(1, 0), cA + kstep, voffA); PG8_STAGE(PG8_SB(1, 1), cB + hstep + kstep, voffB);
        PG8_WAIT_V(6); PG8_BAR;
    } else {
        PG8_STAGE(PG8_SB(0, 0), cB, voffB); PG8_STAGE(PG8_SA(0, 0), cA, voffA); PG8_STAGE(PG8_SB(0, 1), cB + hstep, voffB); PG8_STAGE(PG8_SA(0, 1), cA + hstep, voffA);
        if (wr == 1) PG8_BAR;
        PG8_WAIT_V(4); PG8_BAR;
        PG8_STAGE(PG8_SB(1, 0), cB + kstep, voffB); PG8_STAGE(PG8_SA(1, 0), cA + kstep, voffA); PG8_STAGE(PG8_SB(1, 1), cB + hstep + kstep, voffB);
        PG8_WAIT_V(6); PG8_BAR;
    }
    for (;;) {
        const bool has_next = S.next(ui + 1, nxt);
        const char* nA = has_next ? (const char*)g.A + (size_t)nxt.pm * tstep : cA; const char* nB = has_next ? (const char*)g.Bt + (size_t)nxt.pn * tstep : cB;
        for (int t = 0; t < nt; t += 2) {
            const bool last = (t == nt - 2);
            const char* a1 = cA + (size_t)(t + 1) * kstep;
            const char* a2 = last ? nA : cA + (size_t)(t + 2) * kstep; const char* b2 = last ? nB : cB + (size_t)(t + 2) * kstep;
            const char* a3 = a2 + kstep; const char* b3 = b2 + kstep;
            if (last && has_next) S.a_ready(nxt);
            if constexpr (SP2) {
            PG8_LDB(B0, 0, 0); PG8_LDB(B1, 0, 1); PG8_SCHED; PG8_LDA(At, 0, 0); PG8_STAGE(PG8_SA(1, 1), a1 + hstep, voffA);
            PG8_WAIT_V(8); PG8_WAIT_L(0); PG8_BAR; PG8_MMA(0, 0, At, B0); PG8_MMA(0, 1, At, B1); PG8_BAR; PG8_SCHED;
            PG8_LDA(At, 0, 1); PG8_STAGE(PG8_SB(0, 0), b2, voffB); PG8_STAGE(PG8_SB(0, 1), b2 + hstep, voffB); PG8_STAGE(PG8_SA(0, 0), a2, voffA);
            PG8_WAIT_V(8); PG8_WAIT_L(0); PG8_BAR; PG8_MMA(1, 0, At, B0); PG8_MMA(1, 1, At, B1); PG8_BAR; PG8_SCHED;
            PG8_LDB(B0, 1, 0); PG8_LDB(B1, 1, 1); PG8_SCHED; PG8_LDA(At, 1, 0); PG8_STAGE(PG8_SA(0, 1), a2 + hstep, voffA);
            PG8_WAIT_V(8); PG8_WAIT_L(0); PG8_BAR; PG8_MMA(0, 0, At, B0); PG8_MMA(0, 1, At, B1); PG8_BAR; PG8_SCHED;
            PG8_LDA(At, 1, 1); PG8_STAGE(PG8_SB(1, 0), b3, voffB); PG8_STAGE(PG8_SB(1, 1), b3 + hstep, voffB); PG8_STAGE(PG8_SA(1, 0), a3, voffA);
            PG8_WAIT_V(8); PG8_WAIT_L(0); PG8_BAR; PG8_MMA(1, 0, At, B0); PG8_MMA(1, 1, At, B1); PG8_BAR; PG8_SCHED;
            } else {
            PG8_LDB(B0, 0, 0); PG8_SCHED; PG8_LDA(At, 0, 0); PG8_STAGE(PG8_SA(1, 1), a1 + hstep, voffA);
            PG8_WAIT_L(8); PG8_BAR; PG8_WAIT_L(0); PG8_MMA(0, 0, At, B0); PG8_BAR; PG8_SCHED;
            PG8_LDB(B1, 0, 1); PG8_STAGE(PG8_SB(0, 0), b2, voffB);
            PG8_BAR; PG8_WAIT_L(0); PG8_MMA(0, 1, At, B1); PG8_BAR;
            PG8_LDA(At, 0, 1); PG8_STAGE(PG8_SA(0, 0), a2, voffA);
            PG8_BAR; PG8_WAIT_L(0); PG8_MMA(1, 0, At, B0); PG8_BAR; PG8_SCHED;
            PG8_STAGE(PG8_SB(0, 1), b2 + hstep, voffB);
            PG8_WAIT_V(6); PG8_BAR; PG8_MMA(1, 1, At, B1); PG8_BAR;
            PG8_LDB(B0, 1, 0); PG8_SCHED; PG8_LDA(At, 1, 0); PG8_STAGE(PG8_SA(0, 1), a2 + hstep, voffA);
            PG8_WAIT_L(8); PG8_BAR; PG8_WAIT_L(0); PG8_MMA(0, 0, At, B0); PG8_BAR; PG8_SCHED;
            PG8_LDB(B1, 1, 1); PG8_STAGE(PG8_SB(1, 0), b3, voffB);
            PG8_BAR; PG8_WAIT_L(0); PG8_MMA(0, 1, At, B1); PG8_BAR;
            PG8_LDA(At, 1, 1); PG8_STAGE(PG8_SA(1, 0), a3, voffA);
            PG8_BAR; PG8_WAIT_L(0); PG8_MMA(1, 0, At, B0); PG8_BAR; PG8_SCHED;
            PG8_STAGE(PG8_SB(1, 1), b3 + hstep, voffB);
            PG8_WAIT_V(6); PG8_BAR; PG8_MMA(1, 1, At, B1); PG8_BAR;
            }
        }
        if constexpr (ALIGN_EPI) { if (wr == 0) PG8_BAR; }
        if constexpr (!Epi::AFTER_DRAIN) { E(acc, cur, wr, wc, fr, fq); S.done(cur); }
        if (!has_next) break;
#pragma unroll
        for (int a = 0; a < 2; ++a)
#pragma unroll
            for (int b = 0; b < 2; ++b)
#pragma unroll
                for (int m = 0; m < 4; ++m)
#pragma unroll
                    for (int n = 0; n < 2; ++n) acc[a][b][m][n] = (f32x4){0.f, 0.f, 0.f, 0.f};
        cur = nxt; cA = nA; cB = nB; ++ui;
        if constexpr (ALIGN_EPI) { if (wr == 1) PG8_BAR; }
    }
    PG8_WAIT_V(0);
    if constexpr (!ALIGN_EPI) { if (wr == 0) PG8_BAR; }
    PG8_BAR;
    if constexpr (Epi::AFTER_DRAIN) { E.fused(acc, cur, wr, wc, fr, fq, lds, wid, lane); S.done(cur); }
#undef PG8_SA
#undef PG8_SB
#undef PG8_STAGE
#undef PG8_LDA
#undef PG8_LDB
#undef PG8_MMA
#undef PG8_WAIT_V
#undef PG8_WAIT_L
#undef PG8_BAR
#undef PG8_SCHED
}
}

constexpr int NB = 8, SEQ = 4096, DM = 1024, CTXL = 256;
constexpr int MLAT = NB * SEQ, MCTX = NB * CTXL, MALL = MLAT + MCTX;
constexpr int DH = 512, NHY = 1536, NGL = 1792, NINP = NHY + NGL, NIN = 3104, FF = 4096;
constexpr int GQ = 0, GK = 256, GV = 512, GOG = 1024, GGF = 1536;
constexpr int NSIG = 68, NITEM = NB * 4 * 2 * NSIG;
constexpr float EPSF = 1e-6f;
constexpr int MOD_SH1 = 0, MOD_SC1 = 1024, MOD_G1 = 2048, MOD_SH2 = 3072, MOD_SC2 = 4096, MOD_G2 = 5120, MODW = 6144;

constexpr size_t MiB = 1u << 20;
constexpr size_t WS_CTL = 0, WS_MOD = 1 * MiB, WS_SSQ = 2 * MiB, WS_WIN = 4 * MiB, WS_WOUT = 11 * MiB, WS_W1 = 13 * MiB, WS_W2 = 21 * MiB;
constexpr size_t WS_KRAW = 30 * MiB, WS_DEC = 46 * MiB, WS_XN = 48 * MiB  , WS_HYT = 116 * MiB, WS_GPROJ = 212 * MiB;
constexpr size_t WS_YT = 331 * MiB, WS_YCAT = 363 * MiB, WS_HID = 116 * MiB  , WS_KC = 427 * MiB  , WS_END = 461 * MiB;
static_assert(WS_WIN + (size_t)NINP * DM * 2 <= WS_WOUT && WS_W2 + (size_t)DM * FF * 2 <= WS_KRAW && WS_KRAW + (size_t)DH * 8192 * 4 <= WS_DEC, "ws map 1");
static_assert(WS_DEC + (size_t)NITEM * 64 * 4 <= WS_XN && WS_XN + (size_t)MALL * DM * 2 <= WS_HYT && WS_XN + (size_t)NITEM * 8192 * 2 <= WS_HYT, "ws map 2");
static_assert(WS_HYT + (size_t)NHY * MLAT * 2 <= WS_GPROJ && WS_GPROJ + (size_t)MALL * NGL * 2 <= WS_YT && WS_YT + (size_t)DH * MLAT * 2 <= WS_YCAT, "ws map 3");
static_assert(WS_HID + (size_t)MLAT * FF * 2 <= WS_YCAT + (size_t)MLAT * DM * 2 && WS_YCAT + (size_t)MLAT * DM * 2 <= WS_KC && WS_KC + (size_t)DH * 65792 <= WS_END, "ws map 4");

#define PROBE_REPEAT 0
#define PROBE_TS (-1)
#define STAMP(k) do { if (PROBE_TS >= 0) { const unsigned long long t__ = __builtin_amdgcn_s_memrealtime(); if (blockIdx.x == 0 && threadIdx.x == 0) ((unsigned long long*)(a.ws + 32768))[k] += t__ - tp_; tp_ = t__; } } while (0)
constexpr int NTHR = 512, NWAVES = 8;
constexpr int LDS_BYTES = 147456;
constexpr int MISC_OFF = LDS_BYTES - 256;
constexpr int CW_BAR = 4096, CTL_ZERO_BYTES = 65536;

#define LAS __attribute__((address_space(3)))
typedef unsigned short bf16;
typedef unsigned v4u __attribute__((ext_vector_type(4)));
typedef unsigned v2u __attribute__((ext_vector_type(2)));
typedef float f32x4 __attribute__((ext_vector_type(4)));
#define LDS_WAIT() asm volatile("s_waitcnt lgkmcnt(0)" ::: "memory")

__device__ __forceinline__ unsigned f2bf(float f) { unsigned u = __builtin_bit_cast(unsigned, f); return (u + 0x7fffu + ((u >> 16) & 1u)) >> 16; }
__device__ __forceinline__ unsigned pk2(float lo, float hi) { return f2bf(lo) | (f2bf(hi) << 16); }
__device__ __forceinline__ float bf2f(unsigned h) { return __builtin_bit_cast(float, h << 16); }
__device__ __forceinline__ float wave_sum(float v) {
#pragma unroll
    for (int o = 1; o < 64; o <<= 1) v += __shfl_xor(v, o);
    return v;
}
__device__ __forceinline__ float siluf(float v) { return v / (1.f + __expf(-v)); }
__device__ __forceinline__ float logsigmoidf(float a) { return fminf(a, 0.f) - log1pf(__expf(-fabsf(a))); }

struct Args { const float* in[29]; float* out; unsigned char* ws; int ph_lo, ph_hi; };

enum { I_X = 0, I_C, I_CTX, I_CCTX, I_WADA, I_BADA, I_NMIX, I_NMLP, I_WIN, I_CONVW, I_CONVB, I_FW1, I_FB1, I_FW2, I_FB2, I_FW3, I_FB3, I_FFREQ, I_FWOUT,
       I_HBIAS, I_GKWF, I_GKBF, I_GKWB, I_GKBB, I_GLAN, I_WOUT, I_WM1, I_WM2, I_NFIN };

__device__ __forceinline__ void p0_transpose_item(const float* W, int K, int N, bf16* WT, int row_off, float* scr, int item, int lane) {
    const int nblk = N / 32, kb = item / nblk, nb = item % nblk, k0 = 64 * kb, n0 = 32 * nb;
    float wv[32];
#pragma unroll
    for (int i = 0; i < 32; ++i) { const int kk = 2 * i + (lane >> 5); wv[i] = W[(size_t)(k0 + kk) * N + n0 + (lane & 31)]; }
#pragma unroll
    for (int i = 0; i < 32; ++i) { const int kk = 2 * i + (lane >> 5); scr[kk * 33 + (lane & 31)] = wv[i]; }
    LDS_WAIT(); asm volatile("" ::: "memory");
    const int c = lane & 7;
#pragma unroll
    for (int j = 0; j < 4; ++j) { const int n = (lane >> 3) + 8 * j; const float* s = scr + (8 * c) * 33 + n;
        v4u o; o.x = pk2(s[0 * 33], s[1 * 33]); o.y = pk2(s[2 * 33], s[3 * 33]); o.z = pk2(s[4 * 33], s[5 * 33]); o.w = pk2(s[6 * 33], s[7 * 33]);
        *(v4u*)(WT + (size_t)(row_off + n0 + n) * K + k0 + 8 * c) = o; }
    LDS_WAIT(); asm volatile("" ::: "memory");
}

__device__ __forceinline__ void p0_filter(const Args& a, unsigned char* lds) {
    float* zb = (float*)lds;
    float* h1 = zb + 17 * 33 + 3;
    float* h2 = h1 + 17 * 64;
    float* hT = h2 + 17 * 64;
    const int tid = threadIdx.x;
    float* Kraw = (float*)(a.ws + WS_KRAW); float* SSQ = (float*)(a.ws + WS_SSQ);
    const float* w1 = a.in[I_FW1]; const float* b1 = a.in[I_FB1]; const float* w2 = a.in[I_FW2]; const float* b2 = a.in[I_FB2];
    const float* w3 = a.in[I_FW3]; const float* b3 = a.in[I_FB3]; const float* fr = a.in[I_FFREQ]; const float* wo = a.in[I_FWOUT];
    for (int pg = blockIdx.x; pg < 256; pg += gridDim.x) {
        const int p0 = pg * 16;
        for (int i = tid; i < 17 * 33; i += NTHR) { const int pp = i / 33, j = i % 33; const int p = p0 + pp; float val;
            if (j == 0) val = (float)p * (1.0f / 4095.0f);
            else { const int bi = (j - 1) & 15; const float f = 1e-4f + (float)bi * ((15.0f - 1e-4f) / 15.0f); const float w = 6.283185307179586f * (float)p / 4096.0f; const float ang = w * f;
                   val = (j <= 16) ? cosf(ang) : -sinf(ang); }
            zb[i] = val; }
        __syncthreads();
        for (int i = tid; i < 17 * 64; i += NTHR) { const int pp = i >> 6, j = i & 63; float acc = b1[j];
            for (int k = 0; k < 33; ++k) acc += zb[pp * 33 + k] * w1[k * 64 + j];
            h1[i] = sinf(fr[j] * acc); }
        __syncthreads();
        for (int i = tid; i < 17 * 64; i += NTHR) { const int pp = i >> 6, j = i & 63; float acc = b2[j];
#pragma unroll 16
            for (int k = 0; k < 64; ++k) acc += h1[pp * 64 + k] * w2[k * 64 + j];
            h2[i] = sinf(fr[j] * acc); }
        __syncthreads();
        for (int i = tid; i < 17 * 64; i += NTHR) { const int pp = i >> 6, j = i & 63; float acc = b3[j];
#pragma unroll 16
            for (int k = 0; k < 64; ++k) acc += h2[pp * 64 + k] * w3[k * 64 + j];
            hT[j * 20 + pp] = sinf(fr[j] * acc); }
        __syncthreads();
        for (int dir = 0; dir < 2; ++dir) { const int c = tid, o = dir * 512 + c; float acc[17];
#pragma unroll
            for (int pp = 0; pp < 17; ++pp) acc[pp] = 0.f;
#pragma unroll 4
            for (int j = 0; j < 64; ++j) { const float w = wo[j * 1024 + o]; const f32x4* hp = (const f32x4*)(hT + j * 20);
                const f32x4 q0 = hp[0], q1 = hp[1], q2 = hp[2], q3 = hp[3]; const float q4 = hT[j * 20 + 16];
                acc[0] += q0.x * w; acc[1] += q0.y * w; acc[2] += q0.z * w; acc[3] += q0.w * w; acc[4] += q1.x * w; acc[5] += q1.y * w; acc[6] += q1.z * w; acc[7] += q1.w * w;
                acc[8] += q2.x * w; acc[9] += q2.y * w; acc[10] += q2.z * w; acc[11] += q2.w * w; acc[12] += q3.x * w; acc[13] += q3.y * w; acc[14] += q3.z * w; acc[15] += q3.w * w; acc[16] += q4 * w; }
            const float delta = 3.0701134573253945f + (float)c * ((15.350567286626972f - 3.0701134573253945f) / 511.0f); float ssq = 0.f; float val[17];
#pragma unroll
            for (int pp = 0; pp < 17; ++pp) { const int p = p0 + pp; const float tn = (float)p * (1.0f / 4095.0f); val[pp] = p <= 4095 ? acc[pp] * expf(-tn * delta) : 0.f; }
            if (dir == 0) {
#pragma unroll
                for (int pp = 0; pp < 16; ++pp) ssq += val[pp] * val[pp];
                f32x4* kp = (f32x4*)(Kraw + (size_t)c * 8192 + 4096 + p0);
#pragma unroll
                for (int v = 0; v < 4; ++v) kp[v] = (f32x4){val[4 * v], val[4 * v + 1], val[4 * v + 2], val[4 * v + 3]};
            } else {
#pragma unroll
                for (int pp = 1; pp < 17; ++pp) ssq += val[pp] * val[pp];
                f32x4* kp = (f32x4*)(Kraw + (size_t)c * 8192 + 4096 - p0 - 16);
#pragma unroll
                for (int v = 0; v < 4; ++v) kp[v] = (f32x4){val[16 - 4 * v], val[15 - 4 * v], val[14 - 4 * v], val[13 - 4 * v]};
            }
            SSQ[pg * 1024 + o] = ssq; }
        __syncthreads();
    }
}

__device__ __forceinline__ void p0_mod(const Args& a, unsigned char* lds) {
    float* sc = (float*)lds;
    float* red = sc + 9 * 1024;
    const int tid = threadIdx.x;
    if ((int)blockIdx.x >= 192) return;
    for (int i = tid; i < 9 * 1024; i += NTHR) { const float v = (i < 8192) ? a.in[I_C][i] : a.in[I_CCTX][i - 8192]; sc[i] = siluf(v); }
    __syncthreads();
    const float* wa = a.in[I_WADA]; const float* ba = a.in[I_BADA]; float* mod = (float*)(a.ws + WS_MOD);
    for (int it = blockIdx.x; it < 192; it += gridDim.x) {
        const int col = tid & 31, ks = tid >> 5, c0 = it * 32; float acc[9];
#pragma unroll
        for (int r = 0; r < 9; ++r) acc[r] = 0.f;
#pragma unroll
        for (int kb = 0; kb < 4; ++kb) { float wv[16];
#pragma unroll
            for (int kk = 0; kk < 16; ++kk) wv[kk] = wa[(size_t)(ks * 64 + kb * 16 + kk) * MODW + c0 + col];
#pragma unroll
            for (int kk = 0; kk < 16; ++kk) { const int k = ks * 64 + kb * 16 + kk;
#pragma unroll
                for (int r = 0; r < 9; ++r) acc[r] += sc[r * 1024 + k] * wv[kk]; } }
#pragma unroll
        for (int r = 0; r < 9; ++r) red[(ks * 9 + r) * 32 + col] = acc[r];
        __syncthreads();
        if (tid < 288) { const int r = tid >> 5, cc = tid & 31; float s = ba[c0 + cc];
            for (int k2 = 0; k2 < 16; ++k2) s += red[(k2 * 9 + r) * 32 + cc];
            mod[r * MODW + c0 + cc] = s; }
        __syncthreads();
    }
}

__device__ __forceinline__ void p0_prologue(const Args& a, unsigned char* lds) {
    const int tid = threadIdx.x, lane = tid & 63, wave = tid >> 6;
    p0_filter(a, lds);
    __syncthreads();
    p0_mod(a, lds);
    __syncthreads();
    { v4u* z = (v4u*)((bf16*)(a.ws + WS_WIN) + (size_t)NIN * DM); const int n16 = (NINP - NIN) * DM * 2 / 16;
      for (int i = blockIdx.x * NTHR + tid; i < n16; i += gridDim.x * NTHR) z[i] = (v4u){0u, 0u, 0u, 0u}; }
    float* scr = (float*)(lds + wave * 16384);
    const int gw = blockIdx.x * NWAVES + wave, NGW = gridDim.x * NWAVES;
    constexpr int I_IN = (DM / 64) * (NIN / 32), I_O = (DM / 64) * (DM / 32), I_1 = (DM / 64) * (FF / 32), I_2 = (FF / 64) * (DM / 32);
    constexpr int NITEMS = I_IN + I_O + I_1 + I_2;
    for (int it = gw; it < NITEMS; it += NGW) {
        int r = it;
        if (r < I_IN) { p0_transpose_item(a.in[I_WIN], DM, NIN, (bf16*)(a.ws + WS_WIN), 0, scr, r, lane); continue; } r -= I_IN;
        if (r < I_O) { p0_transpose_item(a.in[I_WOUT], DM, DM, (bf16*)(a.ws + WS_WOUT), 0, scr, r, lane); continue; } r -= I_O;
        if (r < I_1) { p0_transpose_item(a.in[I_WM1], DM, FF, (bf16*)(a.ws + WS_W1), 0, scr, r, lane); continue; } r -= I_1;
        p0_transpose_item(a.in[I_WM2], FF, DM, (bf16*)(a.ws + WS_W2), 0, scr, r, lane);
    }
}

__device__ __forceinline__ void norm_mod_rows(const Args& a, const float* src_lat, const float* src_ctx, int nrows, const float* g, int sc_off, int sh_off, bf16* dst) {
    const int tid = threadIdx.x, lane = tid & 63, wave = tid >> 6;
    const int gw = blockIdx.x * NWAVES + wave, NGW = gridDim.x * NWAVES;
    const float* mod = (const float*)(a.ws + WS_MOD);
    for (int row = gw; row < nrows; row += NGW) {
        const float* src = row < MLAT ? src_lat + (size_t)row * DM : src_ctx + (size_t)(row - MLAT) * DM;
        const int mrow = row < MLAT ? row / SEQ : 8;
        const f32x4* xr = (const f32x4*)src + lane;
        f32x4 v[4]; float s = 0.f;
#pragma unroll
        for (int j = 0; j < 4; ++j) { v[j] = xr[64 * j]; s += (v[j].x * v[j].x + v[j].y * v[j].y) + (v[j].z * v[j].z + v[j].w * v[j].w); }
        const float rstd = rsqrtf(wave_sum(s) * (1.f / DM) + EPSF);
        unsigned long long* o8 = (unsigned long long*)(dst + (size_t)row * DM) + lane;
#pragma unroll
        for (int j = 0; j < 4; ++j) { const int col = 256 * j + 4 * lane;
            const f32x4 gg = *(const f32x4*)(g + col), scv = *(const f32x4*)(mod + mrow * MODW + sc_off + col), shv = *(const f32x4*)(mod + mrow * MODW + sh_off + col);
            const f32x4 y = (v[j] * rstd * gg) * (scv + 1.f) + shv;
            o8[64 * j] = (unsigned long long)pk2(y.x, y.y) | ((unsigned long long)pk2(y.z, y.w) << 32); }
    }
}
__device__ __forceinline__ void final_norm_rows(const Args& a) {
    const int tid = threadIdx.x, lane = tid & 63, wave = tid >> 6;
    const int gw = blockIdx.x * NWAVES + wave, NGW = gridDim.x * NWAVES;
    const float* g = a.in[I_NFIN];
    for (int row = gw; row < MLAT; row += NGW) {
        f32x4* xr = (f32x4*)(a.out + (size_t)row * DM) + lane;
        f32x4 v[4]; float s = 0.f;
#pragma unroll
        for (int j = 0; j < 4; ++j) { v[j] = xr[64 * j]; s += (v[j].x * v[j].x + v[j].y * v[j].y) + (v[j].z * v[j].z + v[j].w * v[j].w); }
        const float rstd = rsqrtf(wave_sum(s) * (1.f / DM) + EPSF);
#pragma unroll
        for (int j = 0; j < 4; ++j) { const f32x4 gg = *(const f32x4*)(g + 256 * j + 4 * lane); xr[64 * j] = v[j] * rstd * gg; }
    }
}

typedef short gbf16x8 __attribute__((ext_vector_type(8)));
typedef float gf32x16 __attribute__((ext_vector_type(16)));
constexpr int GL_ROWB = 144;
constexpr int G2_GR = 0;
constexpr int G2_WG = G2_GR + 2 * 64 * 17 * 4;
constexpr int G2_BG = G2_WG + 2 * 4096;
constexpr int G2_TOT = G2_BG + 512;
constexpr int G2_BCT = G2_TOT + 512;
constexpr int G2_OB = 0;
constexpr int G2_RS = G2_OB + 64 * 132 * 4;
constexpr int G2_QI = G2_BCT + 2 * 64 * 65 * 4;
constexpr int G2_KI = G2_QI + 2 * 64 * GL_ROWB;
constexpr int G2_ATT = G2_KI + 2 * 64 * GL_ROWB;
constexpr int G2_VT = G2_ATT + 2 * 64 * GL_ROWB;
constexpr int G2_END = G2_VT + 128 * GL_ROWB;
static_assert(G2_END <= MISC_OFF && G2_RS + 256 <= G2_QI && G2_QI % 16 == 0, "GLA LDS map");

#define LBAR() asm volatile("s_waitcnt lgkmcnt(0)\n\ts_barrier" ::: "memory")
__device__ __forceinline__ gbf16x8 gl_frag(const LAS unsigned char* p) { return __builtin_bit_cast(gbf16x8, *(const LAS v4u*)p); }
__device__ __forceinline__ void unpack8(const v4u r, float* o) {
    o[0] = bf2f(r.x & 0xffffu); o[1] = bf2f(r.x >> 16); o[2] = bf2f(r.y & 0xffffu); o[3] = bf2f(r.y >> 16);
    o[4] = bf2f(r.z & 0xffffu); o[5] = bf2f(r.z >> 16); o[6] = bf2f(r.w & 0xffffu); o[7] = bf2f(r.w >> 16);
}
__device__ __forceinline__ size_t gla_item(int b, int h, int dir, int ck) {
    const int sig = ck < 4 ? (dir == 0 ? ck : 3 - ck) : (dir == 0 ? ck : 71 - ck);
    return (size_t)((b * 4 + h) * 2 + dir) * NSIG + sig;
}
__device__ __forceinline__ float logsig16(float a) { return (fminf(a, 0.f) - __logf(1.0f + __expf(-fabsf(a)))) * (1.0f / 16.0f); }
struct GateRegs { v2u gr; float wg[4]; float bg; };
__device__ __forceinline__ void gla_gate_loads(const Args& a, GateRegs& g, const bf16* gp, size_t row0, int h) {
    const int tid = threadIdx.x;
    g.gr = *(const v2u*)(gp + (row0 + (tid >> 3)) * NGL + GGF + (tid & 7) * 4);
#pragma unroll
    for (int i = 0; i < 4; ++i) { const int idx = tid + NTHR * i, rem = idx & 1023; const float* w = a.in[(i >> 1) ? I_GKWB : I_GKWF]; g.wg[i] = w[(rem >> 6) * 256 + h * 64 + (rem & 63)]; }
    g.bg = tid < 128 ? a.in[(tid >> 6) ? I_GKBB : I_GKBF][h * 64 + (tid & 63)] : 0.f;
}
__device__ __forceinline__ void gla_gates2(LAS unsigned char* L, const GateRegs& g) {
    const int tid = threadIdx.x;
    LAS float* GR = (LAS float*)(L + G2_GR); LAS float* WG = (LAS float*)(L + G2_WG); LAS float* BG = (LAS float*)(L + G2_BG); LAS float* TOT = (LAS float*)(L + G2_TOT); LAS float* BCT = (LAS float*)(L + G2_BCT);
    { const int tok = tid >> 3, j = tid & 7, dir = j >> 2, r0 = (j & 3) * 4; LAS float* p = GR + dir * (16 * 68) + r0 * 68 + tok;
      p[0] = bf2f(g.gr.x & 0xffffu); p[68] = bf2f(g.gr.x >> 16); p[136] = bf2f(g.gr.y & 0xffffu); p[204] = bf2f(g.gr.y >> 16); }
#pragma unroll
    for (int i = 0; i < 4; ++i) WG[tid + NTHR * i] = g.wg[i];
    if (tid < 128) BG[tid] = g.bg;
    LBAR();
    { const int tb = tid & 15, db = (tid >> 4) & 15, dir = tid >> 8;
      const f32x4 bgv = *(const LAS f32x4*)(BG + dir * 64 + 4 * db); float acc[4][4];
#pragma unroll
      for (int i = 0; i < 4; ++i) { acc[i][0] = bgv.x; acc[i][1] = bgv.y; acc[i][2] = bgv.z; acc[i][3] = bgv.w; }
#pragma unroll
      for (int r = 0; r < 16; ++r) { const f32x4 gv = *(const LAS f32x4*)(GR + dir * (16 * 68) + r * 68 + 4 * tb), wv = *(const LAS f32x4*)(WG + dir * 1024 + r * 64 + 4 * db);
          const float ga[4] = {gv.x, gv.y, gv.z, gv.w}, wa[4] = {wv.x, wv.y, wv.z, wv.w};
#pragma unroll
          for (int i = 0; i < 4; ++i)
#pragma unroll
              for (int j = 0; j < 4; ++j) acc[i][j] += ga[i] * wa[j]; }
#pragma unroll
      for (int i = 0; i < 4; ++i)
#pragma unroll
          for (int j = 0; j < 4; ++j) BCT[dir * (64 * 65) + (4 * db + j) * 65 + 4 * tb + i] = logsig16(acc[i][j]); }
    LBAR();
    { const int d = tid >> 3, seg = tid & 7;
#pragma unroll
      for (int dir = 0; dir < 2; ++dir) { LAS float* bp = BCT + dir * (64 * 65) + d * 65; float v[8]; float run = 0.f;
#pragma unroll
          for (int j = 0; j < 8; ++j) { const int tp = seg * 8 + j, tok = dir ? 63 - tp : tp; run += bp[tok]; v[j] = run; }
          float inc = run;
#pragma unroll
          for (int o = 1; o < 8; o <<= 1) { const float t = __shfl_up(inc, o, 8); if (seg >= o) inc += t; }
          const float excl = inc - run;
#pragma unroll
          for (int j = 0; j < 8; ++j) { const int tp = seg * 8 + j, tok = dir ? 63 - tp : tp; bp[tok] = v[j] + excl; }
          if (seg == 7) TOT[dir * 64 + d] = inc; } }
    LBAR();
}
__device__ __forceinline__ void gla_put_vt(LAS unsigned char* L, const v4u r, int eg, int s) {
    LAS bf16* vt = (LAS bf16*)(L + G2_VT) + (eg * 8) * 72 + s;
    vt[0 * 72] = (bf16)(r.x & 0xffffu); vt[1 * 72] = (bf16)(r.x >> 16); vt[2 * 72] = (bf16)(r.y & 0xffffu); vt[3 * 72] = (bf16)(r.y >> 16);
    vt[4 * 72] = (bf16)(r.z & 0xffffu); vt[5 * 72] = (bf16)(r.z >> 16); vt[6 * 72] = (bf16)(r.w & 0xffffu); vt[7 * 72] = (bf16)(r.w >> 16);
}

__device__ __forceinline__ void gla_local_mfma(const Args& a, unsigned char* lds, int k0, int k1, unsigned long long& tp_) {
    LAS unsigned char* L = (LAS unsigned char*)lds;
    const int tid = threadIdx.x, lane = tid & 63, wave = __builtin_amdgcn_readfirstlane(tid >> 6), r = lane & 31, hh = lane >> 5;
    const bf16* gp = (const bf16*)(a.ws + WS_GPROJ); bf16* ST = (bf16*)(a.ws + WS_XN); float* DEC = (float*)(a.ws + WS_DEC);
    LAS float* TOT = (LAS float*)(L + G2_TOT); LAS float* BCT = (LAS float*)(L + G2_BCT);
    const int s = tid & 63, dg = tid >> 6;
    for (int kq = k0; kq < k1; ++kq) { const int ci = blockIdx.x + kq * gridDim.x; if (ci >= NB * 4 * NSIG) break;
        const int ck = ci % NSIG, h = (ci / NSIG) & 3, b = ci / (NSIG * 4);
        const size_t row0 = ck < 4 ? (size_t)MLAT + b * CTXL + ck * 64 : (size_t)b * SEQ + (ck - 4) * 64;
        const bf16* rowp = gp + (row0 + s) * NGL;
        GateRegs g; gla_gate_loads(a, g, gp, row0, h);
        const v4u kr = *(const v4u*)(rowp + GK + h * 64 + dg * 8), v0 = *(const v4u*)(rowp + GV + h * 128 + dg * 8), v1 = *(const v4u*)(rowp + GV + h * 128 + 64 + dg * 8);
        gla_gates2(L, g);
        { float kv[8]; unpack8(kr, kv);
#pragma unroll
          for (int dir = 0; dir < 2; ++dir) { LAS bf16* ke = (LAS bf16*)(L + G2_QI + dir * 64 * GL_ROWB);
#pragma unroll
              for (int i = 0; i < 8; ++i) { const int d = dg * 8 + i; ke[d * 72 + s] = (bf16)f2bf(kv[i] * __expf(TOT[dir * 64 + d] - BCT[dir * (64 * 65) + d * 65 + s])); } }
          gla_put_vt(L, v0, dg, s); gla_put_vt(L, v1, dg + 8, s);
          if (tid < 128) DEC[gla_item(b, h, tid >> 6, ck) * 64 + (tid & 63)] = __expf(TOT[tid]); }
        LBAR();
#pragma unroll
        for (int j = 0; j < 2; ++j) { const int tile = 2 * wave + j, dir = tile >> 3, mt = (tile >> 2) & 1, nt = tile & 3;
            gf32x16 acc;
#pragma unroll
            for (int i = 0; i < 16; ++i) acc[i] = 0.f;
            const LAS unsigned char* ap = L + G2_QI + dir * 64 * GL_ROWB + (mt * 32 + r) * GL_ROWB + 16 * hh;
            const LAS unsigned char* bp = L + G2_VT + (nt * 32 + r) * GL_ROWB + 16 * hh;
#pragma unroll
            for (int kk = 0; kk < 4; ++kk) acc = __builtin_amdgcn_mfma_f32_32x32x16_bf16(gl_frag(ap + 32 * kk), gl_frag(bp + 32 * kk), acc, 0, 0, 0);
            bf16* sp = ST + gla_item(b, h, dir, ck) * 8192 + (nt * 32 + r) * 64 + mt * 32 + 4 * hh;
#pragma unroll
            for (int gq = 0; gq < 4; ++gq) { v2u o; o.x = pk2(acc[4 * gq], acc[4 * gq + 1]); o.y = pk2(acc[4 * gq + 2], acc[4 * gq + 3]); *(v2u*)(sp + 8 * gq) = o; } }
        LBAR();
        STAMP(44);
    }
}

__device__ __forceinline__ void gla_scan(const Args& a) {
    bf16* ST = (bf16*)(a.ws + WS_XN); const float* DEC = (const float*)(a.ws + WS_DEC);
    for (int w = blockIdx.x * NTHR + threadIdx.x; w < 64 * 1024; w += gridDim.x * NTHR) {
        const int chain = w >> 10, el = (w & 1023) * 8, d0 = el & 63; float s[8];
#pragma unroll
        for (int i = 0; i < 8; ++i) s[i] = 0.f;
#pragma unroll 4
        for (int sig = 0; sig < NSIG; ++sig) { const size_t item = (size_t)chain * NSIG + sig;
            v4u* p = (v4u*)(ST + item * 8192 + el); const v4u dsv = *p;
            const f32x4 d0v = *(const f32x4*)(DEC + item * 64 + d0), d1v = *(const f32x4*)(DEC + item * 64 + d0 + 4);
            v4u o; o.x = pk2(s[0], s[1]); o.y = pk2(s[2], s[3]); o.z = pk2(s[4], s[5]); o.w = pk2(s[6], s[7]); *p = o;
            s[0] = d0v.x * s[0] + bf2f(dsv.x & 0xffffu); s[1] = d0v.y * s[1] + bf2f(dsv.x >> 16);
            s[2] = d0v.z * s[2] + bf2f(dsv.y & 0xffffu); s[3] = d0v.w * s[3] + bf2f(dsv.y >> 16);
            s[4] = d1v.x * s[4] + bf2f(dsv.z & 0xffffu); s[5] = d1v.y * s[5] + bf2f(dsv.z >> 16);
            s[6] = d1v.z * s[6] + bf2f(dsv.w & 0xffffu); s[7] = d1v.w * s[7] + bf2f(dsv.w >> 16); }
    }
}

__device__ __forceinline__ void gla_out_mfma(const Args& a, unsigned char* lds, unsigned long long& tp_) {
    LAS unsigned char* L = (LAS unsigned char*)lds;
    const int tid = threadIdx.x, lane = tid & 63, wave = __builtin_amdgcn_readfirstlane(tid >> 6), r = lane & 31, hh = lane >> 5;
    const bf16* gp = (const bf16*)(a.ws + WS_GPROJ); const bf16* ST = (const bf16*)(a.ws + WS_XN); bf16* ycat = (bf16*)(a.ws + WS_YCAT);
    LAS float* BCT = (LAS float*)(L + G2_BCT); LAS float* OB = (LAS float*)(L + G2_OB); LAS float* RS = (LAS float*)(L + G2_RS);
    const int s = tid & 63, dg = tid >> 6;
    float gnv[16];
#pragma unroll
    for (int i = 0; i < 8; ++i) { gnv[i] = a.in[I_GLAN][dg * 8 + i]; gnv[8 + i] = a.in[I_GLAN][64 + dg * 8 + i]; }
    for (int it = blockIdx.x; it < NB * 4 * 64; it += gridDim.x) {
        const int n = it & 63, h = (it >> 6) & 3, b = it >> 8; const size_t row0 = (size_t)b * SEQ + n * 64;
        const bf16* rowp = gp + (row0 + s) * NGL;
        GateRegs g; gla_gate_loads(a, g, gp, row0, h);
        const v4u qr = *(const v4u*)(rowp + GQ + h * 64 + dg * 8), kr = *(const v4u*)(rowp + GK + h * 64 + dg * 8);
        const v4u v0 = *(const v4u*)(rowp + GV + h * 128 + dg * 8), v1 = *(const v4u*)(rowp + GV + h * 128 + 64 + dg * 8);
        const v4u og0 = *(const v4u*)(rowp + GOG + h * 128 + dg * 8), og1 = *(const v4u*)(rowp + GOG + h * 128 + 64 + dg * 8);
        const int omt = wave >> 2, ont = wave & 3;
        v4u stf[2][4];
#pragma unroll
        for (int dir = 0; dir < 2; ++dir) { const bf16* sp = ST + gla_item(b, h, dir, n + 4) * 8192 + (ont * 32 + r) * 64 + 8 * hh;
#pragma unroll
            for (int kk = 0; kk < 4; ++kk) stf[dir][kk] = *(const v4u*)(sp + 16 * kk); }
        STAMP(50);
        gla_gates2(L, g);
        STAMP(45);
        { float qv[8], kv[8]; unpack8(qr, qv); unpack8(kr, kv);
#pragma unroll
          for (int dir = 0; dir < 2; ++dir) { float qo[8], ko[8];
#pragma unroll
              for (int i = 0; i < 8; ++i) { const float bc = BCT[dir * (64 * 65) + (dg * 8 + i) * 65 + s]; qo[i] = qv[i] * 0.125f * __expf(bc); ko[i] = kv[i] * __expf(-bc); }
              v4u qw, kw; qw.x = pk2(qo[0], qo[1]); qw.y = pk2(qo[2], qo[3]); qw.z = pk2(qo[4], qo[5]); qw.w = pk2(qo[6], qo[7]);
              kw.x = pk2(ko[0], ko[1]); kw.y = pk2(ko[2], ko[3]); kw.z = pk2(ko[4], ko[5]); kw.w = pk2(ko[6], ko[7]);
              *(LAS v4u*)(L + G2_QI + dir * 64 * GL_ROWB + s * GL_ROWB + dg * 16) = qw;
              *(LAS v4u*)(L + G2_KI + dir * 64 * GL_ROWB + s * GL_ROWB + dg * 16) = kw; }
          gla_put_vt(L, v0, dg, s); gla_put_vt(L, v1, dg + 8, s); }
        LBAR();
        STAMP(46);
        { const int dir = wave >> 2, mt = (wave >> 1) & 1, nt = wave & 1;
          gf32x16 acc;
#pragma unroll
          for (int i = 0; i < 16; ++i) acc[i] = 0.f;
          const LAS unsigned char* ap = L + G2_QI + dir * 64 * GL_ROWB + (mt * 32 + r) * GL_ROWB + 16 * hh;
          const LAS unsigned char* bp = L + G2_KI + dir * 64 * GL_ROWB + (nt * 32 + r) * GL_ROWB + 16 * hh;
#pragma unroll
          for (int kk = 0; kk < 4; ++kk) acc = __builtin_amdgcn_mfma_f32_32x32x16_bf16(gl_frag(ap + 32 * kk), gl_frag(bp + 32 * kk), acc, 0, 0, 0);
          LAS bf16* at = (LAS bf16*)(L + G2_ATT + dir * 64 * GL_ROWB); const int sc = nt * 32 + r;
#pragma unroll
          for (int i = 0; i < 16; ++i) { const int c = mt * 32 + (i & 3) + 8 * (i >> 2) + 4 * hh; const bool keep = dir == 0 ? (sc <= c) : (sc >= c);
              at[c * 72 + sc] = (bf16)f2bf(keep ? acc[i] : 0.f); } }
        LBAR();
        STAMP(47);
        { gf32x16 acc;
#pragma unroll
          for (int i = 0; i < 16; ++i) acc[i] = 0.f;
#pragma unroll
          for (int dir = 0; dir < 2; ++dir) {
              const LAS unsigned char* ap = L + G2_ATT + dir * 64 * GL_ROWB + (omt * 32 + r) * GL_ROWB + 16 * hh;
              const LAS unsigned char* bp = L + G2_VT + (ont * 32 + r) * GL_ROWB + 16 * hh;
#pragma unroll
              for (int kk = 0; kk < 4; ++kk) acc = __builtin_amdgcn_mfma_f32_32x32x16_bf16(gl_frag(ap + 32 * kk), gl_frag(bp + 32 * kk), acc, 0, 0, 0);
              const LAS unsigned char* qp = L + G2_QI + dir * 64 * GL_ROWB + (omt * 32 + r) * GL_ROWB + 16 * hh;
#pragma unroll
              for (int kk = 0; kk < 4; ++kk) acc = __builtin_amdgcn_mfma_f32_32x32x16_bf16(gl_frag(qp + 32 * kk), __builtin_bit_cast(gbf16x8, stf[dir][kk]), acc, 0, 0, 0);
          }
#pragma unroll
          for (int i = 0; i < 16; ++i) { const int c = omt * 32 + (i & 3) + 8 * (i >> 2) + 4 * hh; OB[c * 132 + ont * 32 + r] = acc[i]; } }
        LBAR();
        STAMP(48);
        for (int j = 0; j < 8; ++j) { const int c = wave * 8 + j; const float x0 = OB[c * 132 + lane], x1 = OB[c * 132 + 64 + lane];
            const float ss = wave_sum(x0 * x0 + x1 * x1); if (lane == 0) RS[c] = rsqrtf(ss * (1.f / 128.f) + EPSF); }
        LBAR();
        { const float rstd = RS[s]; float g0[8], g1[8]; unpack8(og0, g0); unpack8(og1, g1);
          const f32x4 a0 = *(const LAS f32x4*)(OB + s * 132 + dg * 8), a1 = *(const LAS f32x4*)(OB + s * 132 + dg * 8 + 4);
          const f32x4 b0 = *(const LAS f32x4*)(OB + s * 132 + 64 + dg * 8), b1 = *(const LAS f32x4*)(OB + s * 132 + 64 + dg * 8 + 4);
          const float ov0[8] = {a0.x, a0.y, a0.z, a0.w, a1.x, a1.y, a1.z, a1.w}, ov1[8] = {b0.x, b0.y, b0.z, b0.w, b1.x, b1.y, b1.z, b1.w};
          float y0[8], y1[8];
#pragma unroll
          for (int i = 0; i < 8; ++i) { y0[i] = ov0[i] * rstd * gnv[i] * siluf(g0[i]); y1[i] = ov1[i] * rstd * gnv[8 + i] * siluf(g1[i]); }
          v4u w0, w1; w0.x = pk2(y0[0], y0[1]); w0.y = pk2(y0[2], y0[3]); w0.z = pk2(y0[4], y0[5]); w0.w = pk2(y0[6], y0[7]);
          w1.x = pk2(y1[0], y1[1]); w1.y = pk2(y1[2], y1[3]); w1.z = pk2(y1[4], y1[5]); w1.w = pk2(y1[6], y1[7]);
          bf16* yp = ycat + (row0 + s) * DM + DH + h * 128 + dg * 8;
          *(v4u*)yp = w0; *(v4u*)(yp + 64) = w1; }
        LBAR();
        STAMP(49);
    }
}

typedef short hbf16x8 __attribute__((ext_vector_type(8)));
typedef float hf32x16 __attribute__((ext_vector_type(16)));
constexpr int HK_COPYB = 16448, HK_OFF = 0, HZ_OFF = 4 * HK_COPYB, HZ_ROWB = 8208, HZERO_OFF = HZ_OFF + 8 * HZ_ROWB, HRED_OFF = HZERO_OFF + 64;
constexpr int HK_VEC = 4 * HK_COPYB / 16;
static_assert(HRED_OFF + 64 <= MISC_OFF && 8 * HZ_ROWB <= 4 * HK_COPYB, "hyena LDS map");
__device__ __forceinline__ void hy_unpack8(const v4u r, float* o) {
    o[0] = bf2f(r.x & 0xffffu); o[1] = bf2f(r.x >> 16); o[2] = bf2f(r.y & 0xffffu); o[3] = bf2f(r.y >> 16);
    o[4] = bf2f(r.z & 0xffffu); o[5] = bf2f(r.z >> 16); o[6] = bf2f(r.w & 0xffffu); o[7] = bf2f(r.w >> 16);
}
__device__ __forceinline__ void hyena_conv_mfma(const Args& a, unsigned char* lds, int j0, int j1, unsigned long long& tp_) {
    LAS unsigned char* L = (LAS unsigned char*)lds;
    const int tid = threadIdx.x, lane = tid & 63, wave = __builtin_amdgcn_readfirstlane(tid >> 6), r = lane & 31, h = lane >> 5;
    const bf16* hyT = (const bf16*)(a.ws + WS_HYT); bf16* yT = (bf16*)(a.ws + WS_YT); const float* Kraw = (const float*)(a.ws + WS_KRAW); const float* SSQ = (const float*)(a.ws + WS_SSQ);
    const float* cw = a.in[I_CONVW]; const float* cbv = a.in[I_CONVB];
    for (int jq = j0; jq < j1; ++jq) { const int c = blockIdx.x + jq * gridDim.x; if (c >= DH) break;
        STAMP(40);
        { const float part = SSQ[(tid >> 1) * 1024 + (tid & 1) * 512 + c]; const float wsum = wave_sum(part); if (lane == 0) ((LAS float*)(L + HRED_OFF))[wave] = wsum; }
        { f32x4 kv[4];
#pragma unroll
          for (int i = 0; i < 4; ++i) kv[i] = *(const f32x4*)(Kraw + (size_t)c * 8192 + 4 * (tid + NTHR * i));
#pragma unroll
          for (int i = 0; i < 4; ++i) { const int x0 = 8192 - 4 * (tid + NTHR * i); const float kf[4] = {kv[i].x, kv[i].y, kv[i].z, kv[i].w};
#pragma unroll
              for (int e = 0; e < 4; ++e) { const bf16 hv = (bf16)f2bf(kf[e]);
#pragma unroll
                  for (int s = 0; s < 4; ++s) { const int y = x0 - e - s; if (y >= 0) *(LAS bf16*)(L + HK_OFF + s * HK_COPYB + 2 * y) = hv; } } } }
        if (tid < 4) ((LAS unsigned*)(L + HZERO_OFF))[tid] = 0u;
        { const int c1 = DH + c, c2 = 2 * DH + c;
          const float a0 = cw[c1], a1 = cw[NHY + c1], a2 = cw[2 * NHY + c1], ab = cbv[c1], b0 = cw[c2], b1 = cw[NHY + c2], b2 = cw[2 * NHY + c2], bb = cbv[c2];
#pragma unroll
          for (int ps = 0; ps < 2; ++ps) { v4u r1[4], r2[4]; bf16 e1[4][2], e2[4][2];
#pragma unroll
              for (int i = 0; i < 4; ++i) { const int gi = tid + NTHR * (4 * ps + i), b = gi >> 9, t0 = (gi & 511) * 8, col = b * SEQ + t0;
                  const bf16* p1 = hyT + (size_t)c1 * MLAT + col; const bf16* p2 = hyT + (size_t)c2 * MLAT + col;
                  r1[i] = *(const v4u*)p1; r2[i] = *(const v4u*)p2;
                  const bool hl = (t0 & 63) != 0, hr = ((t0 + 8) & 63) != 0;
                  e1[i][0] = p1[hl ? -1 : 0]; e2[i][0] = p2[hl ? -1 : 0]; e1[i][1] = p1[hr ? 8 : 7]; e2[i][1] = p2[hr ? 8 : 7]; }
#pragma unroll
              for (int i = 0; i < 4; ++i) { const int gi = tid + NTHR * (4 * ps + i), b = gi >> 9, t0 = (gi & 511) * 8;
                  float u[10], w[10]; hy_unpack8(r1[i], u + 1); hy_unpack8(r2[i], w + 1);
                  const bool hl = (t0 & 63) != 0, hr = ((t0 + 8) & 63) != 0;
                  u[0] = hl ? bf2f(e1[i][0]) : 0.f; w[0] = hl ? bf2f(e2[i][0]) : 0.f; u[9] = hr ? bf2f(e1[i][1]) : 0.f; w[9] = hr ? bf2f(e2[i][1]) : 0.f;
                  float z[8];
#pragma unroll
                  for (int k = 0; k < 8; ++k) z[k] = (ab + a0 * u[k] + a1 * u[k + 1] + a2 * u[k + 2]) * (bb + b0 * w[k] + b1 * w[k + 1] + b2 * w[k + 2]);
                  v4u o; o.x = pk2(z[0], z[1]); o.y = pk2(z[2], z[3]); o.z = pk2(z[4], z[5]); o.w = pk2(z[6], z[7]);
                  *(LAS v4u*)(L + HZ_OFF + b * HZ_ROWB + 2 * t0) = o; } } }
        LBAR();
        STAMP(41);
        float sc;
        { float tot = 0.f;
#pragma unroll
          for (int i = 0; i < 8; ++i) tot += ((const LAS float*)(L + HRED_OFF))[i];
          sc = rsqrtf(tot + EPSF); }
        hf32x16 acc[2][2];
#pragma unroll
        for (int m = 0; m < 2; ++m)
#pragma unroll
            for (int n = 0; n < 2; ++n)
#pragma unroll
                for (int i = 0; i < 16; ++i) acc[m][n][i] = 0.f;
        const int I0 = 8 * wave, q = r >> 3, b = r & 7, sh = (-r) & 3;
        const int a_lane = HK_OFF + sh * HK_COPYB + 2 * (4096 - r + 8 * h - sh);
        const int b_lane = HZ_OFF + b * HZ_ROWB + 16 * h;
#define HY_LOADA(dd, AF) do { const int ab_ = a_lane - 128 * (dd); _Pragma("unroll") for (int f = 0; f < 6; ++f) { const int ad = ab_ - 64 + 32 * f; \
            const v2u lo = *(const volatile LAS v2u*)(L + ad), hi = *(const volatile LAS v2u*)(L + ad + 8); AF[f] = __builtin_bit_cast(hbf16x8, (v4u){lo.x, lo.y, hi.x, hi.y}); } } while (0)
#define HY_LOADB(dd, kk_, BF) do { const int J0_ = I0 + q - (dd), J1_ = J0_ + 4; const bool k0_ = (unsigned)J0_ < 64u, k1_ = (unsigned)J1_ < 64u; \
            BF[0] = __builtin_bit_cast(hbf16x8, *(const LAS v4u*)(L + (k0_ ? b_lane + 128 * J0_ + 32 * (kk_) : HZERO_OFF))); \
            BF[1] = __builtin_bit_cast(hbf16x8, *(const LAS v4u*)(L + (k1_ ? b_lane + 128 * J1_ + 32 * (kk_) : HZERO_OFF))); } while (0)
        for (int rep_ = 0; rep_ < 1 + ((PROBE_REPEAT >> 5) & 1); ++rep_) {
        const int dlo = I0 - 63, dhi = I0 + 7;
        hbf16x8 afc[6], bfc[2];
        HY_LOADA(dlo, afc); HY_LOADB(dlo, 0, bfc);
        for (int d = dlo; d <= dhi; ++d) {
            const int dn = d < dhi ? d + 1 : dhi;
            hbf16x8 afn[6], bfn[2];
#pragma unroll
            for (int kk = 0; kk < 4; ++kk) {
                if (kk == 0) HY_LOADA(dn, afn);
                if (kk < 3) HY_LOADB(d, kk + 1, bfn); else HY_LOADB(dn, 0, bfn);
                __builtin_amdgcn_sched_barrier(0);
#pragma unroll
                for (int m = 0; m < 2; ++m)
#pragma unroll
                    for (int n = 0; n < 2; ++n) acc[m][n] = __builtin_amdgcn_mfma_f32_32x32x16_bf16(afc[kk + 2 - 2 * m], bfc[n], acc[m][n], 0, 0, 0);
                __builtin_amdgcn_sched_barrier(0);
                bfc[0] = bfn[0]; bfc[1] = bfn[1];
            }
#pragma unroll
            for (int f = 0; f < 6; ++f) afc[f] = afn[f];
        }
        }
#undef HY_LOADA
#undef HY_LOADB
        v4u x0v[8];
#pragma unroll
        for (int i = 0; i < 8; ++i) { const int gi = tid + NTHR * i, bb = gi >> 9, t0 = (gi & 511) * 8; x0v[i] = *(const v4u*)(hyT + (size_t)c * MLAT + bb * SEQ + t0); }
        STAMP(42);
        LBAR();  STAMP(51);
#pragma unroll
        for (int i = 0; i < 8; ++i) { const int gi = tid + NTHR * i, bb = gi >> 9, t0 = (gi & 511) * 8; *(LAS v4u*)(L + HK_OFF + bb * HZ_ROWB + 2 * t0) = x0v[i]; }
        LBAR();
        STAMP(52);
        for (int repe_ = 0; repe_ < 1 + ((PROBE_REPEAT >> 7) & 1); ++repe_)
        { const float w0 = cw[c], w1 = cw[NHY + c], w2 = cw[2 * NHY + c], wb = cbv[c], hb = a.in[I_HBIAS][c];
#pragma unroll
          for (int m = 0; m < 2; ++m)
#pragma unroll
              for (int n = 0; n < 2; ++n)
#pragma unroll
                  for (int g = 0; g < 4; ++g) { const int t0 = 64 * (I0 + 4 * n + q) + 32 * m + 8 * g + 4 * h;
                      const LAS bf16* xp = (const LAS bf16*)(L + HK_OFF + b * HZ_ROWB + 2 * t0);
                      const v2u xr = *(const LAS v2u*)xp; const v2u zr = *(const LAS v2u*)(L + HZ_OFF + b * HZ_ROWB + 2 * t0);
                      float xv[6];
                      const bool xl = (t0 & 63) != 0, xh = ((t0 + 4) & 63) != 0; const bf16 xlv = xp[xl ? -1 : 0], xhv = xp[xh ? 4 : 3];
                      xv[0] = xl ? bf2f(xlv) : 0.f; xv[5] = xh ? bf2f(xhv) : 0.f;
                      xv[1] = bf2f(xr.x & 0xffffu); xv[2] = bf2f(xr.x >> 16); xv[3] = bf2f(xr.y & 0xffffu); xv[4] = bf2f(xr.y >> 16);
                      const float zv[4] = {bf2f(zr.x & 0xffffu), bf2f(zr.x >> 16), bf2f(zr.y & 0xffffu), bf2f(zr.y >> 16)};
                      float y[4];
#pragma unroll
                      for (int k = 0; k < 4; ++k) y[k] = (wb + w0 * xv[k] + w1 * xv[k + 1] + w2 * xv[k + 2]) * (acc[m][n][4 * g + k] * (((PROBE_REPEAT >> 5) & 1) ? 0.5f * sc : sc) + hb * zv[k]);
                      v2u o; o.x = pk2(y[0], y[1]); o.y = pk2(y[2], y[3]);
                      *(LAS v2u*)(L + HZ_OFF + b * HZ_ROWB + 2 * t0) = o; } }
        LBAR();
        STAMP(53);
#pragma unroll
        for (int i = 0; i < 8; ++i) { const int gi = tid + NTHR * i, bb = gi >> 9, t0 = (gi & 511) * 8;
            *(v4u*)(yT + (size_t)c * MLAT + bb * SEQ + t0) = *(const LAS v4u*)(L + HZ_OFF + bb * HZ_ROWB + 2 * t0); }
        LBAR();
        STAMP(43);
    }
}
__device__ __forceinline__ void hyena_transpose(const Args& a, unsigned char* lds) {
    const int tid = threadIdx.x, lane = tid & 63, wave = tid >> 6;
    bf16* scr = (bf16*)(lds + wave * 16384);
    const bf16* yT = (const bf16*)(a.ws + WS_YT); bf16* ycat = (bf16*)(a.ws + WS_YCAT);
    const int gw = blockIdx.x * NWAVES + wave, NGW = gridDim.x * NWAVES;
    for (int t = gw; t < (DH / 64) * (MLAT / 64); t += NGW) { const int cb = t & 7, tb = t >> 3, c0 = cb * 64, k0 = tb * 64;
        for (int r = 0; r < 64; ++r) scr[r * 66 + lane] = yT[(size_t)(c0 + r) * MLAT + k0 + lane];
        LDS_WAIT(); asm volatile("" ::: "memory");
        for (int r = 0; r < 64; ++r) ycat[(size_t)(k0 + r) * DM + c0 + lane] = scr[lane * 66 + r];
        LDS_WAIT(); asm volatile("" ::: "memory"); }
}

#define XB_TMO      128
#define XB_XCNT(j)  (256  + 64 * (j))
#define XB_XSUB(j)  (1280 + 64 * (j))
#define XB_XGEN(j)  (2304 + 64 * (j))
#define XB_TOP      3328
#define XB_TOPGEN   3392
#define XCD_BAR_WORDS 3456
#define XB_SPIN_CAP (1u << 18)

__device__ __forceinline__ unsigned xb_ld(unsigned* p)              { return __hip_atomic_load(p, __ATOMIC_RELAXED, __HIP_MEMORY_SCOPE_AGENT); }
__device__ __forceinline__ unsigned xb_add(unsigned* p, unsigned v) { return __hip_atomic_fetch_add(p, v, __ATOMIC_RELAXED, __HIP_MEMORY_SCOPE_AGENT); }
__device__ __forceinline__ unsigned xb_xcc_id() { return (unsigned)__builtin_amdgcn_s_getreg((3 << 11) | 20) & 0xFu; }
#define XB_SPIN(cond, bar) do { unsigned _sp = 0; while (cond) { __builtin_amdgcn_s_sleep(1); \
    if ((++_sp & 255u) == 0u) { if (xb_ld(&(bar)[XB_TMO])) break; if (_sp > XB_SPIN_CAP) { atomicAdd(&(bar)[XB_TMO], 1u); break; } } } } while (0)

struct XcdBarrier {
    unsigned* bar; unsigned x;
    volatile LAS unsigned* st;
};

__device__ __forceinline__ XcdBarrier xcd_barrier_post(unsigned* bar, volatile LAS unsigned* st) {
    XcdBarrier b; b.bar = bar; b.x = xb_xcc_id(); b.st = st;
    if (threadIdx.x == 0) (void)xb_add(&bar[XB_XCNT(b.x)], 1u);
    return b;
}
__device__ __forceinline__ void xcd_barrier_complete(unsigned* bar, unsigned x, unsigned& nloc, unsigned& nx) {
    const unsigned G = gridDim.x * gridDim.y * gridDim.z;
    unsigned sum, cnt, mine, sp = 0u;
    for (;;) {
        sum = 0u; cnt = 0u; mine = 0u;
#pragma unroll
        for (unsigned j = 0; j < 16; ++j) { const unsigned c = xb_ld(&bar[XB_XCNT(j)]); sum += c; cnt += (c > 0u) ? 1u : 0u; mine = (j == x) ? c : mine; }
        if (sum == G) break;
        __builtin_amdgcn_s_sleep(1);
        if ((++sp & 255u) == 0u) { if (xb_ld(&bar[XB_TMO])) break; if (sp > XB_SPIN_CAP) { atomicAdd(&bar[XB_TMO], 1u); break; } }
    }
    nloc = mine > 0u ? mine : 1u; nx = cnt > 0u ? cnt : 1u;
}

__device__ __forceinline__ void xcd_barrier(const XcdBarrier& b) {
    asm volatile("s_waitcnt vmcnt(0)" ::: "memory");
    __syncthreads();
    if (threadIdx.x == 0) {
        unsigned* bar = b.bar;
        __builtin_amdgcn_s_waitcnt(0);
        unsigned nloc = b.st[0], nx = b.st[1];
        if (nloc == 0u) { xcd_barrier_complete(bar, b.x, nloc, nx); b.st[0] = nloc; b.st[1] = nx; }
        const unsigned old = xb_add(&bar[XB_XSUB(b.x)], 1u);
        const unsigned gen = old / nloc;
        if (old + 1u == (gen + 1u) * nloc) {
            __builtin_amdgcn_fence(__ATOMIC_RELEASE, "agent");
            asm volatile("s_waitcnt vmcnt(0)" ::: "memory");
            const unsigned og = xb_add(&bar[XB_TOP], 1u);
            const unsigned tg = og / nx;
            if (og + 1u == (tg + 1u) * nx) xb_add(&bar[XB_TOPGEN], 1u);
            else XB_SPIN(xb_ld(&bar[XB_TOPGEN]) == tg, bar);
            __builtin_amdgcn_fence(__ATOMIC_ACQUIRE, "agent");
            xb_add(&bar[XB_XGEN(b.x)], 1u);
            asm volatile("s_waitcnt vmcnt(0)" ::: "memory");
        } else {
            XB_SPIN(xb_ld(&bar[XB_XGEN(b.x)]) == gen, bar);
            __builtin_amdgcn_fence(__ATOMIC_ACQUIRE, "agent");
            asm volatile("s_waitcnt vmcnt(0)" ::: "memory");
        }
    }
    __syncthreads();
}

constexpr int NPHASE = 11;
__global__ void __launch_bounds__(NTHR, 2) fwd_kernel(Args a) {
    extern __shared__ __attribute__((aligned(16))) unsigned char lds[];
    const int lo = a.ph_lo, hi = a.ph_hi;
    unsigned long long tp_ = PROBE_TS >= 0 ? __builtin_amdgcn_s_memrealtime() : 0ull;
    volatile LAS unsigned* MISC = (volatile LAS unsigned*)((LAS unsigned char*)lds + MISC_OFF);
    if (threadIdx.x < 16) MISC[threadIdx.x] = 0u;
    __syncthreads();
    XcdBarrier bar = xcd_barrier_post((unsigned*)(a.ws + WS_CTL) + CW_BAR, MISC + 8);
#define IN(k) (lo <= (k) && (k) < hi)
#define SEAM(k) do { STAMP(2 * (k)); if (IN(k) && IN((k) + 1)) xcd_barrier(bar); STAMP(2 * (k) + 1); } while (0)
    unsigned char* ws = a.ws;
    PG8_LAS unsigned char* ldsg = (PG8_LAS unsigned char*)lds;
    if (IN(0)) { for (int rep = 0; rep < 1 + ((PROBE_REPEAT >> 4) & 1); ++rep) { p0_prologue(a, lds); __syncthreads(); } } SEAM(0);
    if (IN(1)) { norm_mod_rows(a, a.in[I_X], a.in[I_CTX], MALL, a.in[I_NMIX], MOD_SC1, MOD_SH1, (bf16*)(ws + WS_XN)); } SEAM(1);
    if (IN(2)) {
        { pg8::Gemm g{(const pg8::bf16_t*)(ws + WS_WIN), (const pg8::bf16_t*)(ws + WS_XN), NHY, MLAT, DM}; pg8::StaticOrder S; S.init(NHY, MLAT, gridDim.x, blockIdx.x);
          pg8::EpiBf16<0> E{(pg8::bf16_t*)(ws + WS_HYT), MLAT};
          pg8::gemm_phase<pg8::EpiBf16<0>, pg8::StaticOrder, true, true>(ldsg, g, S, E); }
        __syncthreads();
        { pg8::Gemm g{(const pg8::bf16_t*)(ws + WS_XN), (const pg8::bf16_t*)(ws + WS_WIN) + (size_t)NHY * DM, MALL, NGL, DM}; pg8::StaticOrder S; S.init(MALL, NGL, gridDim.x, blockIdx.x);
          pg8::EpiBf16<0> E{(pg8::bf16_t*)(ws + WS_GPROJ), NGL};
          pg8::gemm_phase<pg8::EpiBf16<0>, pg8::StaticOrder, true, true>(ldsg, g, S, E); }
    } SEAM(2);
    if (IN(3)) {
        const int nG = (NB * 4 * NSIG - (int)blockIdx.x + (int)gridDim.x - 1) / (int)gridDim.x, nH = (DH - (int)blockIdx.x + (int)gridDim.x - 1) / (int)gridDim.x;
        const int pos0 = blockIdx.x & 7, hstep = 4; int kG = 0, jH = 0;
        for (;;) {
            const bool wantH = jH < nH && (kG >= nG || kG >= pos0 + hstep * jH);
            if (wantH) { hyena_conv_mfma(a, lds, jH, jH + 1, tp_); ++jH; }
            else if (kG < nG) { gla_local_mfma(a, lds, kG, kG + 1, tp_); ++kG; }
            else break;
        }
    } SEAM(3);
    if (IN(4)) { gla_scan(a); } SEAM(4);
    if (IN(5)) { for (int rep = 0; rep < 1 + ((PROBE_REPEAT >> 2) & 1); ++rep) { gla_out_mfma(a, lds, tp_); __syncthreads(); }
                 for (int rep = 0; rep < 1 + ((PROBE_REPEAT >> 3) & 1); ++rep) { hyena_transpose(a, lds); __syncthreads(); } } SEAM(5);
    if (IN(6)) { pg8::Gemm g{(const pg8::bf16_t*)(ws + WS_YCAT), (const pg8::bf16_t*)(ws + WS_WOUT), MLAT, DM, DM}; pg8::StaticOrder S; S.init(MLAT, DM, gridDim.x, blockIdx.x);
        pg8::EpiResid E{a.in[I_X], a.out, DM, (const float*)(ws + WS_MOD) + MOD_G1, SEQ, MODW};
        pg8::gemm_phase<pg8::EpiResid, pg8::StaticOrder, true, true>(ldsg, g, S, E); } SEAM(6);
    if (IN(7)) { norm_mod_rows(a, a.out, a.out, MLAT, a.in[I_NMLP], MOD_SC2, MOD_SH2, (bf16*)(ws + WS_XN)); } SEAM(7);
    if (IN(8)) { pg8::Gemm g{(const pg8::bf16_t*)(ws + WS_XN), (const pg8::bf16_t*)(ws + WS_W1), MLAT, FF, DM}; pg8::StaticOrder S; S.init(MLAT, FF, gridDim.x, blockIdx.x);
        pg8::EpiBf16<1> E{(pg8::bf16_t*)(ws + WS_HID), FF};
        pg8::gemm_phase<pg8::EpiBf16<1>, pg8::StaticOrder, true, true>(ldsg, g, S, E); } SEAM(8);
    if (IN(9)) { pg8::Gemm g{(const pg8::bf16_t*)(ws + WS_HID), (const pg8::bf16_t*)(ws + WS_W2), MLAT, DM, FF}; pg8::StaticOrder S; S.init(MLAT, DM, gridDim.x, blockIdx.x);
        pg8::EpiResid E{a.out, a.out, DM, (const float*)(ws + WS_MOD) + MOD_G2, SEQ, MODW};
        pg8::gemm_phase<pg8::EpiResid, pg8::StaticOrder, true, true>(ldsg, g, S, E); } SEAM(9);
    if (IN(10)) { final_norm_rows(a); }
    STAMP(20);
    if (PROBE_TS >= 0 && blockIdx.x == 0 && threadIdx.x == 0) a.out[0] = (float)((unsigned long long*)(a.ws + 32768))[PROBE_TS < 0 ? 0 : PROBE_TS] * 0.01f;
#undef IN
#undef SEAM
}

#ifndef N_LAUNCH_MODE
#define N_LAUNCH_MODE 1
#endif
extern "C" void kernel_launch(void* const* d_in, const int* in_sizes, int n_in, void* d_out, int out_size, void* d_ws, size_t ws_size, hipStream_t stream) {
    static int grid = 0;
    if (grid == 0) {
        if (n_in != 29 || out_size != MLAT * DM || ws_size < WS_END) { fprintf(stderr, "kernel_launch: unexpected shapes (n_in %d out %d ws %zu)\n", n_in, out_size, ws_size); grid = -1; return; }
        int dev = 0, cus = 0, per_cu = 0;
        if (hipGetDevice(&dev) != hipSuccess || hipDeviceGetAttribute(&cus, hipDeviceAttributeMultiprocessorCount, dev) != hipSuccess) { grid = -1; return; }
        if (hipFuncSetAttribute((const void*)fwd_kernel, hipFuncAttributeMaxDynamicSharedMemorySize, LDS_BYTES) != hipSuccess) { fprintf(stderr, "kernel_launch: hipFuncSetAttribute failed\n"); grid = -1; return; }
        if (hipOccupancyMaxActiveBlocksPerMultiprocessor(&per_cu, (const void*)fwd_kernel, NTHR, LDS_BYTES) != hipSuccess || per_cu < 1) { fprintf(stderr, "kernel_launch: occupancy query says %d blocks per CU\n", per_cu); (void)hipGetLastError(); grid = -1; return; }
        grid = cus;
    }
    if (grid < 0) return;
    Args a{};
    for (int i = 0; i < 29; ++i) a.in[i] = (const float*)d_in[i];
    a.out = (float*)d_out; a.ws = (unsigned char*)d_ws;
#if N_LAUNCH_MODE == 0
    for (int p = 0; p < NPHASE; ++p) { a.ph_lo = p; a.ph_hi = p + 1; hipLaunchKernelGGL(fwd_kernel, dim3(grid), dim3(NTHR), LDS_BYTES, stream, a); }
#else
    a.ph_lo = 0; a.ph_hi = NPHASE;
    if (hipMemsetAsync((char*)d_ws + WS_CTL, 0, CTL_ZERO_BYTES, stream) != hipSuccess) { fprintf(stderr, "kernel_launch: memset of the control words failed\n"); return; }
    hipLaunchKernelGGL(fwd_kernel, dim3(grid), dim3(NTHR), LDS_BYTES, stream, a);
#endif
}
```

```cpp
#include <hip/hip_runtime.h>
#include <hip/hip_cooperative_groups.h>
#include <cstdio>
#include <cstdint>
#include <cmath>
namespace cg = cooperative_groups;
namespace pg8 {
#define PG8_LAS __attribute__((address_space(3)))
typedef unsigned short bf16_t;
typedef short bf16x8 __attribute__((ext_vector_type(8)));
typedef float f32x4 __attribute__((ext_vector_type(4)));
typedef unsigned u32x4 __attribute__((ext_vector_type(4)));
constexpr int BM = 256, BK = 64, HALF = 128, HTB = HALF * BK * 2  , STAGE_BYTES = 8 * HTB, NXCD = 8, WGM = 8;

__host__ __device__ __forceinline__ int lds_byte(int r, int c) { const int st = (r >> 4) * 2 + (c >> 5), rr = r & 15, cc = c & 31, ob = rr * 64 + cc * 2; return st * 1024 + (ob ^ (((ob >> 9) & 1) << 5)); }
__host__ __device__ __forceinline__ void stage_rc(int b, int& R, int& C) { const int st = b / 1024, sb = b % 1024, swz = sb ^ (((sb >> 9) & 1) << 5); R = (st >> 1) * 16 + swz / 64; C = (st & 1) * 32 + (swz % 64) / 2; }
__host__ __device__ __forceinline__ int perm32(int rho) { const int n = rho >> 4, i = rho & 15; return 8 * (i >> 2) + 4 * n + (i & 3); }

struct Unit { int pm, pn; };
struct Gemm { const bf16_t* A; const bf16_t* Bt; int M, N, K; };

struct StaticOrder {
    int nM, nN, nwg, G, c;
    __host__ __device__ void init(int M, int N, int G_, int c_) { nM = M / BM; nN = N / BM; nwg = nM * nN; G = G_; c = c_; }
    __host__ __device__ bool next(int i, Unit& u) const {
        const long L = (long)i * G + c; if (L >= nwg) return false;
        int wgid = (int)L; { const int q = nwg / NXCD, r = nwg % NXCD, xcd = wgid % NXCD, off = wgid / NXCD; wgid = (xcd < r ? xcd * (q + 1) : r * (q + 1) + (xcd - r) * q) + off; }
        const int nig = WGM * nN, gid = wgid / nig, fm = gid * WGM, gsz = (nM - fm) < WGM ? (nM - fm) : WGM;
        u.pm = fm + ((wgid % nig) % gsz); u.pn = (wgid % nig) / gsz; return true;
    }
    __device__ __forceinline__ void a_ready(const Unit&) const {}
    __device__ __forceinline__ void done(const Unit&) const {}
};


__device__ __forceinline__ unsigned cvt_pk_bf16(float lo, float hi) { unsigned r; asm volatile("v_cvt_pk_bf16_f32 %0, %1, %2" : "=v"(r) : "v"(lo), "v"(hi)); return r; }

template <int ACT> struct EpiBf16 {
    static constexpr bool PERM = true, AFTER_DRAIN = false;
    bf16_t* O; int ldc;
    __device__ __forceinline__ void operator()(const f32x4 (&acc)[2][2][4][2], const Unit& u, int wr, int wc, int fr, int fq) const {
        const int row0 = u.pm * BM + wr * 64 + fr; const int col0 = u.pn * BM + wc * 32 + 8 * fq;
#pragma unroll
        for (int ai = 0; ai < 2; ++ai)
#pragma unroll
            for (int m = 0; m < 4; ++m) { bf16_t* rowp = O + (size_t)(row0 + ai * HALF + m * 16) * ldc + col0;
#pragma unroll
                for (int bj = 0; bj < 2; ++bj) { f32x4 v0 = acc[ai][bj][m][0], v1 = acc[ai][bj][m][1];
                    if (ACT == 1) {
#pragma unroll
                        for (int q = 0; q < 4; ++q) { const float a0 = fmaxf(v0[q], 0.f), a1 = fmaxf(v1[q], 0.f); v0[q] = a0 * a0; v1[q] = a1 * a1; } }
                    u32x4 w; w.x = cvt_pk_bf16(v0[0], v0[1]); w.y = cvt_pk_bf16(v0[2], v0[3]); w.z = cvt_pk_bf16(v1[0], v1[1]); w.w = cvt_pk_bf16(v1[2], v1[3]);
                    *(u32x4*)(rowp + bj * HALF) = w; } }
    }
};
struct EpiResid {
    static constexpr bool PERM = false, AFTER_DRAIN = false;
    const float* base; float* out; int ldc; const float* gate; int rows_per_gate; int gate_stride;
    __device__ __forceinline__ void operator()(const f32x4 (&acc)[2][2][4][2], const Unit& u, int wr, int wc, int fr, int fq) const {
        const int row0 = u.pm * BM + wr * 64 + fr, col0 = u.pn * BM + wc * 32 + 4 * fq;
        const float* gp = gate + (size_t)((u.pm * BM) / rows_per_gate) * gate_stride + col0;
        f32x4 gv[2][2];
#pragma unroll
        for (int bj = 0; bj < 2; ++bj)
#pragma unroll
            for (int n = 0; n < 2; ++n) gv[bj][n] = *(const f32x4*)(gp + bj * HALF + n * 16);
#pragma unroll
        for (int ai = 0; ai < 2; ++ai)
#pragma unroll
            for (int m = 0; m < 4; ++m) { const size_t off = (size_t)(row0 + ai * HALF + m * 16) * ldc + col0;
#pragma unroll
                for (int bj = 0; bj < 2; ++bj)
#pragma unroll
                    for (int n = 0; n < 2; ++n) { const f32x4 bs = *(const f32x4*)(base + off + bj * HALF + n * 16);
                        *(f32x4*)(out + off + bj * HALF + n * 16) = bs + gv[bj][n] * acc[ai][bj][m][n]; } }
    }
};

struct EpiResidH2 {
    static constexpr bool PERM = false, AFTER_DRAIN = false;
    const float* base; float* out; int ldc; const float* gate; const float* sc; const float* nm; int rows_per_gate; int gate_stride; bf16_t* h2; float* ssq;
    __device__ __forceinline__ void operator()(const f32x4 (&acc)[2][2][4][2], const Unit& u, int wr, int wc, int fr, int fq) const {
        const int row0 = u.pm * BM + wr * 64 + fr, col0 = u.pn * BM + wc * 32 + 4 * fq;
        const size_t gofs = (size_t)((u.pm * BM) / rows_per_gate) * gate_stride + col0;
        f32x4 gv[2][2], cv[2][2];
#pragma unroll
        for (int bj = 0; bj < 2; ++bj)
#pragma unroll
            for (int n = 0; n < 2; ++n) { gv[bj][n] = *(const f32x4*)(gate + gofs + bj * HALF + n * 16);
                cv[bj][n] = *(const f32x4*)(nm + col0 + bj * HALF + n * 16) * (*(const f32x4*)(sc + gofs + bj * HALF + n * 16) + 1.0f); }
#pragma unroll
        for (int ai = 0; ai < 2; ++ai)
#pragma unroll
            for (int m = 0; m < 4; ++m) { const int row = row0 + ai * HALF + m * 16; const size_t off = (size_t)row * ldc + col0; float ss = 0.f;
#pragma unroll
                for (int bj = 0; bj < 2; ++bj)
#pragma unroll
                    for (int n = 0; n < 2; ++n) { const f32x4 bs = *(const f32x4*)(base + off + bj * HALF + n * 16); const f32x4 x1 = bs + gv[bj][n] * acc[ai][bj][m][n];
                        *(f32x4*)(out + off + bj * HALF + n * 16) = x1; ss += (x1.x * x1.x + x1.y * x1.y) + (x1.z * x1.z + x1.w * x1.w);
                        const f32x4 hv = x1 * cv[bj][n]; unsigned long long w = (unsigned long long)cvt_pk_bf16(hv.x, hv.y) | ((unsigned long long)cvt_pk_bf16(hv.z, hv.w) << 32);
                        *(unsigned long long*)(h2 + off + bj * HALF + n * 16) = w; }
                ss += __shfl_xor(ss, 16); ss += __shfl_xor(ss, 32);
                if (fq == 0) ssq[(size_t)row * 16 + u.pn * 4 + wc] = ss; }
    }
};
struct EpiSqReluRstd {
    static constexpr bool PERM = true, AFTER_DRAIN = false;
    bf16_t* O; int ldc; const float* ssq; const float* bias; int rows_per_bias; int bias_stride; float inv_k, eps;
    __device__ __forceinline__ void operator()(const f32x4 (&acc)[2][2][4][2], const Unit& u, int wr, int wc, int fr, int fq) const {
        const int row0 = u.pm * BM + wr * 64 + fr; const int col0 = u.pn * BM + wc * 32 + 8 * fq;
        const float* bp = bias + (size_t)((u.pm * BM) / rows_per_bias) * bias_stride + col0;
        f32x4 bv[2][2];
#pragma unroll
        for (int bj = 0; bj < 2; ++bj)
#pragma unroll
            for (int n = 0; n < 2; ++n) bv[bj][n] = *(const f32x4*)(bp + bj * HALF + 4 * n);
#pragma unroll
        for (int ai = 0; ai < 2; ++ai)
#pragma unroll
            for (int m = 0; m < 4; ++m) { const int row = row0 + ai * HALF + m * 16; const f32x4* sp = (const f32x4*)(ssq + (size_t)row * 16);
                const f32x4 s0 = sp[0], s1 = sp[1], s2 = sp[2], s3 = sp[3];
                const float tot = ((s0.x + s0.y) + (s0.z + s0.w)) + ((s1.x + s1.y) + (s1.z + s1.w)) + ((s2.x + s2.y) + (s2.z + s2.w)) + ((s3.x + s3.y) + (s3.z + s3.w));
                const float rstd = rsqrtf(tot * inv_k + eps);
                bf16_t* rowp = O + (size_t)row * ldc + col0;
#pragma unroll
                for (int bj = 0; bj < 2; ++bj) { f32x4 v0 = acc[ai][bj][m][0] * rstd + bv[bj][0], v1 = acc[ai][bj][m][1] * rstd + bv[bj][1];
#pragma unroll
                    for (int q = 0; q < 4; ++q) { const float a0 = fmaxf(v0[q], 0.f), a1 = fmaxf(v1[q], 0.f); v0[q] = a0 * a0; v1[q] = a1 * a1; }
                    u32x4 w; w.x = cvt_pk_bf16(v0[0], v0[1]); w.y = cvt_pk_bf16(v0[2], v0[3]); w.z = cvt_pk_bf16(v1[0], v1[1]); w.w = cvt_pk_bf16(v1[2], v1[3]);
                    *(u32x4*)(rowp + bj * HALF) = w; } }
    }
};

template <class Epi, class Sched, bool ALIGN_EPI = false, bool SP2 = false>
__device__ __forceinline__ void gemm_phase(PG8_LAS unsigned char* lds, const Gemm g, const Sched& S, const Epi& E) {
    const int tid = threadIdx.x, wid = __builtin_amdgcn_readfirstlane(tid >> 6), lane = tid & 63, wr = wid >> 2, wc = wid & 3, fr = lane & 15, fq = lane >> 4;
    const int K = g.K, nt = K / BK;
    unsigned voffA[2], voffB[2];
#pragma unroll
    for (int i = 0; i < 2; ++i) { int R, C; stage_rc(tid * 16 + i * 8192, R, C); const int Rb = Epi::PERM ? ((R & ~31) + perm32(R & 31)) : R;
        voffA[i] = (unsigned)(R * K + C) * 2u; voffB[i] = (unsigned)(Rb * K + C) * 2u; }
    const size_t kstep = (size_t)(BK * 2);
    const size_t hstep = (size_t)HALF * K * 2;
    const size_t tstep = 2 * hstep;
    const unsigned ldsw = (unsigned)wid * 1024u;
    const int aoff = lds_byte(wr * 64 + fr, fq * 8), boff = lds_byte(wc * 32 + fr, fq * 8);
#define PG8_SA(b, h) (((b) * 2 + (h)) * HTB)
#define PG8_SB(b, h) ((4 + (b) * 2 + (h)) * HTB)
#define PG8_STAGE(bufoff, gbase, voff) do { _Pragma("unroll") for (int _i = 0; _i < 2; ++_i) \
        __builtin_amdgcn_global_load_lds((const unsigned*)((const char*)(gbase) + (voff)[_i]), (PG8_LAS unsigned*)(lds + (bufoff) + ldsw + _i * 8192), 16, 0, 0); } while (0)
#define PG8_LDA(dst, b, h) do { _Pragma("unroll") for (int m = 0; m < 4; ++m) _Pragma("unroll") for (int k = 0; k < 2; ++k) dst[m][k] = *(const PG8_LAS bf16x8*)(lds + PG8_SA(b, h) + aoff + m * 2048 + k * 1024); } while (0)
#define PG8_LDB(dst, b, h) do { _Pragma("unroll") for (int n = 0; n < 2; ++n) _Pragma("unroll") for (int k = 0; k < 2; ++k) dst[n][k] = *(const PG8_LAS bf16x8*)(lds + PG8_SB(b, h) + boff + n * 2048 + k * 1024); } while (0)
#define PG8_MMA(ai, bj, At, Bt) do { __builtin_amdgcn_s_setprio(1); _Pragma("unroll") for (int m = 0; m < 4; ++m) _Pragma("unroll") for (int n = 0; n < 2; ++n) _Pragma("unroll") for (int k = 0; k < 2; ++k) \
        acc[ai][bj][m][n] = __builtin_amdgcn_mfma_f32_16x16x32_bf16(Bt[n][k], At[m][k], acc[ai][bj][m][n], 0, 0, 0); __builtin_amdgcn_s_setprio(0); } while (0)
#define PG8_WAIT_V(n) asm volatile("s_waitcnt vmcnt(" #n ")" ::: "memory")
#define PG8_WAIT_L(n) asm volatile("s_waitcnt lgkmcnt(" #n ")" ::: "memory")
#define PG8_BAR __builtin_amdgcn_s_barrier()
#define PG8_SCHED __builtin_amdgcn_sched_barrier(0)
    Unit cur, nxt; int ui = 0;
    if (!S.next(0, cur)) return;
    f32x4 acc[2][2][4][2];
#pragma unroll
    for (int a = 0; a < 2; ++a)
#pragma unroll
        for (int b = 0; b < 2; ++b)
#pragma unroll
            for (int m = 0; m < 4; ++m)
#pragma unroll
                for (int n = 0; n < 2; ++n) acc[a][b][m][n] = (f32x4){0.f, 0.f, 0.f, 0.f};
    bf16x8 At[4][2], B0[2][2], B1[2][2];
    const char* cA = (const char*)g.A + (size_t)cur.pm * tstep; const char* cB = (const char*)g.Bt + (size_t)cur.pn * tstep;
    S.a_ready(cur);
    if constexpr (SP2) {
        PG8_STAGE(PG8_SB(0, 0), cB, voffB); PG8_STAGE(PG8_SB(0, 1), cB + hstep, voffB); PG8_STAGE(PG8_SA(0, 0), cA, voffA); PG8_STAGE(PG8_SA(0, 1), cA + hstep, voffA);
        if (wr == 1) PG8_BAR;
        PG8_WAIT_V(2); PG8_BAR;
        PG8_STAGE(PG8_SB(1, 0), cB + kstep, voffB); PG8_STAGE(PG8_SA(1, 0), cA + kstep, voffA); PG8_STAGE(PG8_SB(1, 1), cB + hstep + kstep, voffB);
        PG8_WAIT_V(6); PG8_BAR;
    } else {
        PG8_STAGE(PG8_SB(0, 0), cB, voffB); PG8_STAGE(PG8_SA(0, 0), cA, voffA); PG8_STAGE(PG8_SB(0, 1), cB + hstep, voffB); PG8_STAGE(PG8_SA(0, 1), cA + hstep, voffA);
        if (wr == 1) PG8_BAR;
        PG8_WAIT_V(4); PG8_BAR;
        PG8_STAGE(PG8_SB(1, 0), cB + kstep, voffB); PG8_STAGE(PG8_SA(1, 0), cA + kstep, voffA); PG8_STAGE(PG8_SB(1, 1), cB + hstep + kstep, voffB);
        PG8_WAIT_V(6); PG8_BAR;
    }
    for (;;) {
        const bool has_next = S.next(ui + 1, nxt);
        const char* nA = has_next ? (const char*)g.A + (size_t)nxt.pm * tstep : cA; const char* nB = has_next ? (const char*)g.Bt + (size_t)nxt.pn * tstep : cB;
        for (int t = 0; t < nt; t += 2) {
            const bool last = (t == nt - 2);
            const char* a1 = cA + (size_t)(t + 1) * kstep;
            const char* a2 = last ? nA : cA + (size_t)(t + 2) * kstep; const char* b2 = last ? nB : cB + (size_t)(t + 2) * kstep;
            const char* a3 = a2 + kstep; const char* b3 = b2 + kstep;
            if (last && has_next) S.a_ready(nxt);
            if constexpr (SP2) {
            PG8_LDB(B0, 0, 0); PG8_LDB(B1, 0, 1); PG8_SCHED; PG8_LDA(At, 0, 0); PG8_STAGE(PG8_SA(1, 1), a1 + hstep, voffA);
            PG8_WAIT_V(8); PG8_WAIT_L(0); PG8_BAR; PG8_MMA(0, 0, At, B0); PG8_MMA(0, 1, At, B1); PG8_BAR; PG8_SCHED;
            PG8_LDA(At, 0, 1); PG8_STAGE(PG8_SB(0, 0), b2, voffB); PG8_STAGE(PG8_SB(0, 1), b2 + hstep, voffB); PG8_STAGE(PG8_SA(0, 0), a2, voffA);
            PG8_WAIT_V(8); PG8_WAIT_L(0); PG8_BAR; PG8_MMA(1, 0, At, B0); PG8_MMA(1, 1, At, B1); PG8_BAR; PG8_SCHED;
            PG8_LDB(B0, 1, 0); PG8_LDB(B1, 1, 1); PG8_SCHED; PG8_LDA(At, 1, 0); PG8_STAGE(PG8_SA(0, 1), a2 + hstep, voffA);
            PG8_WAIT_V(8); PG8_WAIT_L(0); PG8_BAR; PG8_MMA(0, 0, At, B0); PG8_MMA(0, 1, At, B1); PG8_BAR; PG8_SCHED;
            PG8_LDA(At, 1, 1); PG8_STAGE(PG8_SB(1, 0), b3, voffB); PG8_STAGE(PG8_SB(1, 1), b3 + hstep, voffB); PG8_STAGE(PG8_SA(1, 0), a3, voffA);
            PG8_WAIT_V(8); PG8_WAIT_L(0); PG8_BAR; PG8_MMA(1, 0, At, B0); PG8_MMA(1, 1, At, B1); PG8_BAR; PG8_SCHED;
            } else {
            PG8_LDB(B0, 0, 0); PG8_SCHED; PG8_LDA(At, 0, 0); PG8_STAGE(PG8_SA(1, 1), a1 + hstep, voffA);
            PG8_WAIT_L(8); PG8_BAR; PG8_WAIT_L(0); PG8_MMA(0, 0, At, B0); PG8_BAR; PG8_SCHED;
            PG8_LDB(B1, 0, 1); PG8_STAGE(PG8_SB(0, 0), b2, voffB);
            PG8_BAR; PG8_WAIT_L(0); PG8_MMA(0, 1, At, B1); PG8_BAR;
            PG8_LDA(At, 0, 1); PG8_STAGE(PG8_SA(0, 0), a2, voffA);
            PG8_BAR; PG8_WAIT_L(0); PG8_MMA(1, 0, At, B0); PG8_BAR; PG8_SCHED;
            PG8_STAGE(PG8_SB(0, 1), b2 + hstep, voffB);
            PG8_WAIT_V(6); PG8_BAR; PG8_MMA(1, 1, At, B1); PG8_BAR;
            PG8_LDB(B0, 1, 0); PG8_SCHED; PG8_LDA(At, 1, 0); PG8_STAGE(PG8_SA(0, 1), a2 + hstep, voffA);
            PG8_WAIT_L(8); PG8_BAR; PG8_WAIT_L(0); PG8_MMA(0, 0, At, B0); PG8_BAR; PG8_SCHED;
            PG8_LDB(B1, 1, 1); PG8_STAGE(PG8_SB(1, 0), b3, voffB);
            PG8_BAR; PG8_WAIT_L(0); PG8_MMA(0, 1, At, B1); PG8_BAR;
            PG8_LDA(At, 1, 1); PG8_STAGE(PG8_SA(1, 0), a3, voffA);
            PG8_BAR; PG8_WAIT_L(0); PG8_MMA(1, 0, At, B0); PG8_BAR; PG8_SCHED;
            PG8_STAGE(PG8_SB(1, 1), b3 + hstep, voffB);
            PG8_WAIT_V(6); PG8_BAR; PG8_MMA(1, 1, At, B1); PG8_BAR;
            }
        }
        if constexpr (ALIGN_EPI) { if (wr == 0) PG8_BAR; }
        if constexpr (!Epi::AFTER_DRAIN) { E(acc, cur, wr, wc, fr, fq); S.done(cur); }
        if (!has_next) break;
#pragma unroll
        for (int a = 0; a < 2; ++a)
#pragma unroll
            for (int b = 0; b < 2; ++b)
#pragma unroll
                for (int m = 0; m < 4; ++m)
#pragma unroll
                    for (int n = 0; n < 2; ++n) acc[a][b][m][n] = (f32x4){0.f, 0.f, 0.f, 0.f};
        cur = nxt; cA = nA; cB = nB; ++ui;
        if constexpr (ALIGN_EPI) { if (wr == 1) PG8_BAR; }
    }
    PG8_WAIT_V(0);
    if constexpr (!ALIGN_EPI) { if (wr == 0) PG8_BAR; }
    PG8_BAR;
    if constexpr (Epi::AFTER_DRAIN) { E.fused(acc, cur, wr, wc, fr, fq, lds, wid, lane); S.done(cur); }
#undef PG8_SA
#undef PG8_SB
#undef PG8_STAGE
#undef PG8_LDA
#undef PG8_LDB
#undef PG8_MMA
#undef PG8_WAIT_V
#undef PG8_WAIT_L
#undef PG8_BAR
#undef PG8_SCHED
}
}

constexpr int NB = 8, SEQ = 4096, DM = 1024, CTXL = 256;
constexpr int MLAT = NB * SEQ, MCTX = NB * CTXL, MALL = MLAT + MCTX;
constexpr int DH = 512, NHY = 1536, NGL = 1792, NINP = NHY + NGL, NIN = 3104, FF = 4096;
constexpr int GQ = 0, GK = 256, GV = 512, GOG = 1024, GGF = 1536;
constexpr int NSIG = 68, NITEM = NB * 4 * 2 * NSIG;
constexpr float EPSF = 1e-6f;
constexpr int MOD_SH1 = 0, MOD_SC1 = 1024, MOD_G1 = 2048, MOD_SH2 = 3072, MOD_SC2 = 4096, MOD_G2 = 5120, MODW = 6144;

constexpr size_t MiB = 1u << 20;
constexpr size_t WS_CTL = 0, WS_MOD = 1 * MiB, WS_SSQ = 2 * MiB, WS_WIN = 4 * MiB, WS_WOUT = 11 * MiB, WS_W1 = 13 * MiB, WS_W2 = 21 * MiB;
constexpr size_t WS_KRAW = 30 * MiB, WS_DEC = 46 * MiB, WS_XN = 48 * MiB  , WS_HYT = 116 * MiB, WS_GPROJ = 212 * MiB;
constexpr size_t WS_YT = 331 * MiB, WS_YCAT = 363 * MiB, WS_HID = 116 * MiB  , WS_SSQ2 = 427 * MiB  , WS_BIAS2 = 430 * MiB  , WS_END = 431 * MiB;
static_assert(WS_WIN + (size_t)NINP * DM * 2 <= WS_WOUT && WS_W2 + (size_t)DM * FF * 2 <= WS_KRAW && WS_KRAW + (size_t)DH * 8192 * 4 <= WS_DEC, "ws map 1");
static_assert(WS_DEC + (size_t)NITEM * 64 * 4 <= WS_XN && WS_XN + (size_t)MALL * DM * 2 <= WS_HYT && WS_XN + (size_t)NITEM * 8192 * 2 <= WS_HYT, "ws map 2");
static_assert(WS_HYT + (size_t)NHY * MLAT * 2 <= WS_GPROJ && WS_GPROJ + (size_t)MALL * NGL * 2 <= WS_YT && WS_YT + (size_t)DH * MLAT * 2 <= WS_YCAT, "ws map 3");
static_assert(WS_HID + (size_t)MLAT * FF * 2 <= WS_YCAT + (size_t)MLAT * DM * 2 && WS_YCAT + (size_t)MLAT * DM * 2 <= WS_SSQ2 && WS_SSQ2 + (size_t)MLAT * 64 <= WS_BIAS2 && WS_BIAS2 + (size_t)NB * FF * 4 <= WS_END, "ws map 4");

#define PROBE_REPEAT 0
#define PROBE_TS (-1)
#define STAMP(k) do { if (PROBE_TS >= 0) { const unsigned long long t__ = __builtin_amdgcn_s_memrealtime(); if (blockIdx.x == 0 && threadIdx.x == 0) ((unsigned long long*)(a.ws + 32768))[k] += t__ - tp_; tp_ = t__; } } while (0)
constexpr int NTHR = 512, NWAVES = 8;
constexpr int LDS_BYTES = 147456;
constexpr int MISC_OFF = LDS_BYTES - 256;
constexpr int CW_BAR = 4096, CTL_ZERO_BYTES = 65536;

#define LAS __attribute__((address_space(3)))
typedef unsigned short bf16;
typedef unsigned v4u __attribute__((ext_vector_type(4)));
typedef unsigned v2u __attribute__((ext_vector_type(2)));
typedef float f32x4 __attribute__((ext_vector_type(4)));
#define LDS_WAIT() asm volatile("s_waitcnt lgkmcnt(0)" ::: "memory")

__device__ __forceinline__ unsigned f2bf(float f) { unsigned u = __builtin_bit_cast(unsigned, f); return (u + 0x7fffu + ((u >> 16) & 1u)) >> 16; }
__device__ __forceinline__ unsigned pk2(float lo, float hi) { return f2bf(lo) | (f2bf(hi) << 16); }
__device__ __forceinline__ float bf2f(unsigned h) { return __builtin_bit_cast(float, h << 16); }
__device__ __forceinline__ float wave_sum(float v) {
#pragma unroll
    for (int o = 1; o < 64; o <<= 1) v += __shfl_xor(v, o);
    return v;
}
__device__ __forceinline__ float siluf(float v) { return v / (1.f + __expf(-v)); }
__device__ __forceinline__ float logsigmoidf(float a) { return fminf(a, 0.f) - log1pf(__expf(-fabsf(a))); }

struct Args { const float* in[29]; float* out; unsigned char* ws; int ph_lo, ph_hi; };

enum { I_X = 0, I_C, I_CTX, I_CCTX, I_WADA, I_BADA, I_NMIX, I_NMLP, I_WIN, I_CONVW, I_CONVB, I_FW1, I_FB1, I_FW2, I_FB2, I_FW3, I_FB3, I_FFREQ, I_FWOUT,
       I_HBIAS, I_GKWF, I_GKBF, I_GKWB, I_GKBB, I_GLAN, I_WOUT, I_WM1, I_WM2, I_NFIN };

__device__ __forceinline__ void p0_transpose_item(const float* W, int K, int N, bf16* WT, int row_off, float* scr, int item, int lane) {
    const int nblk = N / 32, kb = item / nblk, nb = item % nblk, k0 = 64 * kb, n0 = 32 * nb;
    float wv[32];
#pragma unroll
    for (int i = 0; i < 32; ++i) { const int kk = 2 * i + (lane >> 5); wv[i] = W[(size_t)(k0 + kk) * N + n0 + (lane & 31)]; }
#pragma unroll
    for (int i = 0; i < 32; ++i) { const int kk = 2 * i + (lane >> 5); scr[kk * 33 + (lane & 31)] = wv[i]; }
    LDS_WAIT(); asm volatile("" ::: "memory");
    const int c = lane & 7;
#pragma unroll
    for (int j = 0; j < 4; ++j) { const int n = (lane >> 3) + 8 * j; const float* s = scr + (8 * c) * 33 + n;
        v4u o; o.x = pk2(s[0 * 33], s[1 * 33]); o.y = pk2(s[2 * 33], s[3 * 33]); o.z = pk2(s[4 * 33], s[5 * 33]); o.w = pk2(s[6 * 33], s[7 * 33]);
        *(v4u*)(WT + (size_t)(row_off + n0 + n) * K + k0 + 8 * c) = o; }
    LDS_WAIT(); asm volatile("" ::: "memory");
}

__device__ __forceinline__ void p0_filter(const Args& a, unsigned char* lds) {
    float* zb = (float*)lds;
    float* h1 = zb + 17 * 33 + 3;
    float* h2 = h1 + 17 * 64;
    float* hT = h2 + 17 * 64;
    const int tid = threadIdx.x;
    float* Kraw = (float*)(a.ws + WS_KRAW); float* SSQ = (float*)(a.ws + WS_SSQ);
    const float* w1 = a.in[I_FW1]; const float* b1 = a.in[I_FB1]; const float* w2 = a.in[I_FW2]; const float* b2 = a.in[I_FB2];
    const float* w3 = a.in[I_FW3]; const float* b3 = a.in[I_FB3]; const float* fr = a.in[I_FFREQ]; const float* wo = a.in[I_FWOUT];
    for (int pg = blockIdx.x; pg < 256; pg += gridDim.x) {
        const int p0 = pg * 16;
        for (int i = tid; i < 17 * 33; i += NTHR) { const int pp = i / 33, j = i % 33; const int p = p0 + pp; float val;
            if (j == 0) val = (float)p * (1.0f / 4095.0f);
            else { const int bi = (j - 1) & 15; const float f = 1e-4f + (float)bi * ((15.0f - 1e-4f) / 15.0f); const float w = 6.283185307179586f * (float)p / 4096.0f; const float ang = w * f;
                   val = (j <= 16) ? cosf(ang) : -sinf(ang); }
            zb[i] = val; }
        __syncthreads();
        for (int i = tid; i < 17 * 64; i += NTHR) { const int pp = i >> 6, j = i & 63; float acc = b1[j];
            for (int k = 0; k < 33; ++k) acc += zb[pp * 33 + k] * w1[k * 64 + j];
            h1[i] = sinf(fr[j] * acc); }
        __syncthreads();
        for (int i = tid; i < 17 * 64; i += NTHR) { const int pp = i >> 6, j = i & 63; float acc = b2[j];
#pragma unroll 16
            for (int k = 0; k < 64; ++k) acc += h1[pp * 64 + k] * w2[k * 64 + j];
            h2[i] = sinf(fr[j] * acc); }
        __syncthreads();
        for (int i = tid; i < 17 * 64; i += NTHR) { const int pp = i >> 6, j = i & 63; float acc = b3[j];
#pragma unroll 16
            for (int k = 0; k < 64; ++k) acc += h2[pp * 64 + k] * w3[k * 64 + j];
            hT[j * 20 + pp] = sinf(fr[j] * acc); }
        __syncthreads();
        for (int dir = 0; dir < 2; ++dir) { const int c = tid, o = dir * 512 + c; float acc[17];
#pragma unroll
            for (int pp = 0; pp < 17; ++pp) acc[pp] = 0.f;
#pragma unroll 4
            for (int j = 0; j < 64; ++j) { const float w = wo[j * 1024 + o]; const f32x4* hp = (const f32x4*)(hT + j * 20);
                const f32x4 q0 = hp[0], q1 = hp[1], q2 = hp[2], q3 = hp[3]; const float q4 = hT[j * 20 + 16];
                acc[0] += q0.x * w; acc[1] += q0.y * w; acc[2] += q0.z * w; acc[3] += q0.w * w; acc[4] += q1.x * w; acc[5] += q1.y * w; acc[6] += q1.z * w; acc[7] += q1.w * w;
                acc[8] += q2.x * w; acc[9] += q2.y * w; acc[10] += q2.z * w; acc[11] += q2.w * w; acc[12] += q3.x * w; acc[13] += q3.y * w; acc[14] += q3.z * w; acc[15] += q3.w * w; acc[16] += q4 * w; }
            const float delta = 3.0701134573253945f + (float)c * ((15.350567286626972f - 3.0701134573253945f) / 511.0f); float ssq = 0.f; float val[17];
#pragma unroll
            for (int pp = 0; pp < 17; ++pp) { const int p = p0 + pp; const float tn = (float)p * (1.0f / 4095.0f); val[pp] = p <= 4095 ? acc[pp] * expf(-tn * delta) : 0.f; }
            if (dir == 0) {
#pragma unroll
                for (int pp = 0; pp < 16; ++pp) ssq += val[pp] * val[pp];
                f32x4* kp = (f32x4*)(Kraw + (size_t)c * 8192 + 4096 + p0);
#pragma unroll
                for (int v = 0; v < 4; ++v) kp[v] = (f32x4){val[4 * v], val[4 * v + 1], val[4 * v + 2], val[4 * v + 3]};
            } else {
#pragma unroll
                for (int pp = 1; pp < 17; ++pp) ssq += val[pp] * val[pp];
                f32x4* kp = (f32x4*)(Kraw + (size_t)c * 8192 + 4096 - p0 - 16);
#pragma unroll
                for (int v = 0; v < 4; ++v) kp[v] = (f32x4){val[16 - 4 * v], val[15 - 4 * v], val[14 - 4 * v], val[13 - 4 * v]};
            }
            SSQ[pg * 1024 + o] = ssq; }
        __syncthreads();
    }
}

__device__ __forceinline__ void p0_mod(const Args& a, unsigned char* lds) {
    float* sc = (float*)lds;
    float* red = sc + 9 * 1024;
    const int tid = threadIdx.x;
    if ((int)blockIdx.x >= 192) return;
    for (int i = tid; i < 9 * 1024; i += NTHR) { const float v = (i < 8192) ? a.in[I_C][i] : a.in[I_CCTX][i - 8192]; sc[i] = siluf(v); }
    __syncthreads();
    const float* wa = a.in[I_WADA]; const float* ba = a.in[I_BADA]; float* mod = (float*)(a.ws + WS_MOD);
    for (int it = blockIdx.x; it < 192; it += gridDim.x) {
        const int col = tid & 31, ks = tid >> 5, c0 = it * 32; float acc[9];
#pragma unroll
        for (int r = 0; r < 9; ++r) acc[r] = 0.f;
#pragma unroll
        for (int kb = 0; kb < 4; ++kb) { float wv[16];
#pragma unroll
            for (int kk = 0; kk < 16; ++kk) wv[kk] = wa[(size_t)(ks * 64 + kb * 16 + kk) * MODW + c0 + col];
#pragma unroll
            for (int kk = 0; kk < 16; ++kk) { const int k = ks * 64 + kb * 16 + kk;
#pragma unroll
                for (int r = 0; r < 9; ++r) acc[r] += sc[r * 1024 + k] * wv[kk]; } }
#pragma unroll
        for (int r = 0; r < 9; ++r) red[(ks * 9 + r) * 32 + col] = acc[r];
        __syncthreads();
        if (tid < 288) { const int r = tid >> 5, cc = tid & 31; float s = ba[c0 + cc];
            for (int k2 = 0; k2 < 16; ++k2) s += red[(k2 * 9 + r) * 32 + cc];
            mod[r * MODW + c0 + cc] = s; }
        __syncthreads();
    }
}

__device__ __forceinline__ void p0_prologue(const Args& a, unsigned char* lds) {
    const int tid = threadIdx.x, lane = tid & 63, wave = tid >> 6;
    p0_filter(a, lds);
    __syncthreads();
    p0_mod(a, lds);
    __syncthreads();
    { v4u* z = (v4u*)((bf16*)(a.ws + WS_WIN) + (size_t)NIN * DM); const int n16 = (NINP - NIN) * DM * 2 / 16;
      for (int i = blockIdx.x * NTHR + tid; i < n16; i += gridDim.x * NTHR) z[i] = (v4u){0u, 0u, 0u, 0u}; }
    float* scr = (float*)(lds + wave * 16384);
    const int gw = blockIdx.x * NWAVES + wave, NGW = gridDim.x * NWAVES;
    constexpr int I_IN = (DM / 64) * (NIN / 32), I_O = (DM / 64) * (DM / 32), I_1 = (DM / 64) * (FF / 32), I_2 = (FF / 64) * (DM / 32);
    constexpr int NITEMS = I_IN + I_O + I_1 + I_2;
    for (int it = gw; it < NITEMS; it += NGW) {
        int r = it;
        if (r < I_IN) { p0_transpose_item(a.in[I_WIN], DM, NIN, (bf16*)(a.ws + WS_WIN), 0, scr, r, lane); continue; } r -= I_IN;
        if (r < I_O) { p0_transpose_item(a.in[I_WOUT], DM, DM, (bf16*)(a.ws + WS_WOUT), 0, scr, r, lane); continue; } r -= I_O;
        if (r < I_1) { p0_transpose_item(a.in[I_WM1], DM, FF, (bf16*)(a.ws + WS_W1), 0, scr, r, lane); continue; } r -= I_1;
        p0_transpose_item(a.in[I_WM2], FF, DM, (bf16*)(a.ws + WS_W2), 0, scr, r, lane);
    }
}

__device__ __forceinline__ void norm_mod_rows(const Args& a, const float* src_lat, const float* src_ctx, int nrows, const float* g, int sc_off, int sh_off, bf16* dst) {
    const int tid = threadIdx.x, lane = tid & 63, wave = tid >> 6;
    const int gw = blockIdx.x * NWAVES + wave, NGW = gridDim.x * NWAVES;
    const float* mod = (const float*)(a.ws + WS_MOD);
    for (int row = gw; row < nrows; row += NGW) {
        const float* src = row < MLAT ? src_lat + (size_t)row * DM : src_ctx + (size_t)(row - MLAT) * DM;
        const int mrow = row < MLAT ? row / SEQ : 8;
        const f32x4* xr = (const f32x4*)src + lane;
        f32x4 v[4]; float s = 0.f;
#pragma unroll
        for (int j = 0; j < 4; ++j) { v[j] = xr[64 * j]; s += (v[j].x * v[j].x + v[j].y * v[j].y) + (v[j].z * v[j].z + v[j].w * v[j].w); }
        const float rstd = rsqrtf(wave_sum(s) * (1.f / DM) + EPSF);
        unsigned long long* o8 = (unsigned long long*)(dst + (size_t)row * DM) + lane;
#pragma unroll
        for (int j = 0; j < 4; ++j) { const int col = 256 * j + 4 * lane;
            const f32x4 gg = *(const f32x4*)(g + col), scv = *(const f32x4*)(mod + mrow * MODW + sc_off + col), shv = *(const f32x4*)(mod + mrow * MODW + sh_off + col);
            const f32x4 y = (v[j] * rstd * gg) * (scv + 1.f) + shv;
            o8[64 * j] = (unsigned long long)pk2(y.x, y.y) | ((unsigned long long)pk2(y.z, y.w) << 32); }
    }
}
__device__ __forceinline__ void final_norm_rows(const Args& a) {
    const int tid = threadIdx.x, lane = tid & 63, wave = tid >> 6;
    const int gw = blockIdx.x * NWAVES + wave, NGW = gridDim.x * NWAVES;
    const float* g = a.in[I_NFIN];
    for (int row = gw; row < MLAT; row += NGW) {
        f32x4* xr = (f32x4*)(a.out + (size_t)row * DM) + lane;
        f32x4 v[4]; float s = 0.f;
#pragma unroll
        for (int j = 0; j < 4; ++j) { v[j] = xr[64 * j]; s += (v[j].x * v[j].x + v[j].y * v[j].y) + (v[j].z * v[j].z + v[j].w * v[j].w); }
        const float rstd = rsqrtf(wave_sum(s) * (1.f / DM) + EPSF);
#pragma unroll
        for (int j = 0; j < 4; ++j) { const f32x4 gg = *(const f32x4*)(g + 256 * j + 4 * lane); xr[64 * j] = v[j] * rstd * gg; }
    }
}

typedef short gbf16x8 __attribute__((ext_vector_type(8)));
typedef float gf32x16 __attribute__((ext_vector_type(16)));
constexpr int GL_ROWB = 144;
constexpr int G2_GR = 0;
constexpr int G2_WG = G2_GR + 2 * 64 * 17 * 4;
constexpr int G2_BG = G2_WG + 2 * 4096;
constexpr int G2_TOT = G2_BG + 512;
constexpr int G2_BCT = G2_TOT + 512;
constexpr int G2_OB = 0;
constexpr int G2_RS = G2_OB + 64 * 132 * 4;
constexpr int G2_QI = G2_BCT + 2 * 64 * 65 * 4;
constexpr int G2_KI = G2_QI + 2 * 64 * GL_ROWB;
constexpr int G2_ATT = G2_KI + 2 * 64 * GL_ROWB;
constexpr int G2_VT = G2_ATT + 2 * 64 * GL_ROWB;
constexpr int G2_END = G2_VT + 128 * GL_ROWB;
static_assert(G2_END <= MISC_OFF && G2_RS + 256 <= G2_QI && G2_QI % 16 == 0, "GLA LDS map");

#define LBAR() asm volatile("s_waitcnt lgkmcnt(0)\n\ts_barrier" ::: "memory")
__device__ __forceinline__ gbf16x8 gl_frag(const LAS unsigned char* p) { return __builtin_bit_cast(gbf16x8, *(const LAS v4u*)p); }
__device__ __forceinline__ void unpack8(const v4u r, float* o) {
    o[0] = bf2f(r.x & 0xffffu); o[1] = bf2f(r.x >> 16); o[2] = bf2f(r.y & 0xffffu); o[3] = bf2f(r.y >> 16);
    o[4] = bf2f(r.z & 0xffffu); o[5] = bf2f(r.z >> 16); o[6] = bf2f(r.w & 0xffffu); o[7] = bf2f(r.w >> 16);
}
__device__ __forceinline__ size_t gla_item(int b, int h, int dir, int ck) {
    const int sig = ck < 4 ? (dir == 0 ? ck : 3 - ck) : (dir == 0 ? ck : 71 - ck);
    return (size_t)((b * 4 + h) * 2 + dir) * NSIG + sig;
}
__device__ __forceinline__ float logsig16(float a) { return (fminf(a, 0.f) - __logf(1.0f + __expf(-fabsf(a)))) * (1.0f / 16.0f); }
struct GateRegs { v2u gr; float wg[4]; float bg; };
__device__ __forceinline__ void gla_gate_loads(const Args& a, GateRegs& g, const bf16* gp, size_t row0, int h) {
    const int tid = threadIdx.x;
    g.gr = *(const v2u*)(gp + (row0 + (tid >> 3)) * NGL + GGF + (tid & 7) * 4);
#pragma unroll
    for (int i = 0; i < 4; ++i) { const int idx = tid + NTHR * i, rem = idx & 1023; const float* w = a.in[(i >> 1) ? I_GKWB : I_GKWF]; g.wg[i] = w[(rem >> 6) * 256 + h * 64 + (rem & 63)]; }
    g.bg = tid < 128 ? a.in[(tid >> 6) ? I_GKBB : I_GKBF][h * 64 + (tid & 63)] : 0.f;
}
__device__ __forceinline__ void gla_gates2(LAS unsigned char* L, const GateRegs& g) {
    const int tid = threadIdx.x;
    LAS float* GR = (LAS float*)(L + G2_GR); LAS float* WG = (LAS float*)(L + G2_WG); LAS float* BG = (LAS float*)(L + G2_BG); LAS float* TOT = (LAS float*)(L + G2_TOT); LAS float* BCT = (LAS float*)(L + G2_BCT);
    { const int tok = tid >> 3, j = tid & 7, dir = j >> 2, r0 = (j & 3) * 4; LAS float* p = GR + dir * (16 * 68) + r0 * 68 + tok;
      p[0] = bf2f(g.gr.x & 0xffffu); p[68] = bf2f(g.gr.x >> 16); p[136] = bf2f(g.gr.y & 0xffffu); p[204] = bf2f(g.gr.y >> 16); }
#pragma unroll
    for (int i = 0; i < 4; ++i) WG[tid + NTHR * i] = g.wg[i];
    if (tid < 128) BG[tid] = g.bg;
    LBAR();
    { const int tb = tid & 15, db = (tid >> 4) & 15, dir = tid >> 8;
      const f32x4 bgv = *(const LAS f32x4*)(BG + dir * 64 + 4 * db); float acc[4][4];
#pragma unroll
      for (int i = 0; i < 4; ++i) { acc[i][0] = bgv.x; acc[i][1] = bgv.y; acc[i][2] = bgv.z; acc[i][3] = bgv.w; }
#pragma unroll
      for (int r = 0; r < 16; ++r) { const f32x4 gv = *(const LAS f32x4*)(GR + dir * (16 * 68) + r * 68 + 4 * tb), wv = *(const LAS f32x4*)(WG + dir * 1024 + r * 64 + 4 * db);
          const float ga[4] = {gv.x, gv.y, gv.z, gv.w}, wa[4] = {wv.x, wv.y, wv.z, wv.w};
#pragma unroll
          for (int i = 0; i < 4; ++i)
#pragma unroll
              for (int j = 0; j < 4; ++j) acc[i][j] += ga[i] * wa[j]; }
#pragma unroll
      for (int i = 0; i < 4; ++i)
#pragma unroll
          for (int j = 0; j < 4; ++j) BCT[dir * (64 * 65) + (4 * db + j) * 65 + 4 * tb + i] = logsig16(acc[i][j]); }
    LBAR();
    { const int d = tid >> 3, seg = tid & 7;
#pragma unroll
      for (int dir = 0; dir < 2; ++dir) { LAS float* bp = BCT + dir * (64 * 65) + d * 65; float v[8]; float run = 0.f;
#pragma unroll
          for (int j = 0; j < 8; ++j) { const int tp = seg * 8 + j, tok = dir ? 63 - tp : tp; run += bp[tok]; v[j] = run; }
          float inc = run;
#pragma unroll
          for (int o = 1; o < 8; o <<= 1) { const float t = __shfl_up(inc, o, 8); if (seg >= o) inc += t; }
          const float excl = inc - run;
#pragma unroll
          for (int j = 0; j < 8; ++j) { const int tp = seg * 8 + j, tok = dir ? 63 - tp : tp; bp[tok] = v[j] + excl; }
          if (seg == 7) TOT[dir * 64 + d] = inc; } }
    LBAR();
}
constexpr int G3_KEROWB = 192, G3_VROWB = 320;
constexpr int G3_KE = G2_QI;
constexpr int G3_V = G2_VT;
constexpr int G3_STI = 0;
static_assert(G3_KE + 2 * 64 * G3_KEROWB <= G3_V && G3_V + 64 * G3_VROWB <= MISC_OFF && 2 * 128 * GL_ROWB <= G2_QI, "GLA v3 LDS map");
typedef short v4i16_t __attribute__((ext_vector_type(4)));
__device__ __forceinline__ gbf16x8 gl_frag_tr(const LAS unsigned char* p, int rowb) {
    const v4i16_t lo = __builtin_amdgcn_ds_read_tr16_b64_v4i16((LAS v4i16_t*)p);
    const v4i16_t hi = __builtin_amdgcn_ds_read_tr16_b64_v4i16((LAS v4i16_t*)(p + 4 * rowb));
    return (gbf16x8){lo[0], lo[1], lo[2], lo[3], hi[0], hi[1], hi[2], hi[3]};
}

__device__ __forceinline__ void gla_local_mfma(const Args& a, unsigned char* lds, int k0, int k1, unsigned long long& tp_) {
    LAS unsigned char* L = (LAS unsigned char*)lds;
    const int tid = threadIdx.x, lane = tid & 63, wave = __builtin_amdgcn_readfirstlane(tid >> 6), r = lane & 31, hh = lane >> 5, g1 = (lane >> 4) & 1, q4 = (lane >> 2) & 3, p4 = lane & 3;
    const bf16* gp = (const bf16*)(a.ws + WS_GPROJ); bf16* ST = (bf16*)(a.ws + WS_XN); float* DEC = (float*)(a.ws + WS_DEC);
    LAS float* TOT = (LAS float*)(L + G2_TOT); LAS float* BCT = (LAS float*)(L + G2_BCT);
    const int tokA = tid >> 3, dgA = tid & 7;
    const int tokB = tid >> 4, peB = tid & 15;
    for (int kq = k0; kq < k1; ++kq) { const int ci = blockIdx.x + kq * gridDim.x; if (ci >= NB * 4 * NSIG) break;
        const int ck = ci % NSIG, h = (ci / NSIG) & 3, b = ci / (NSIG * 4);
        const size_t row0 = ck < 4 ? (size_t)MLAT + b * CTXL + ck * 64 : (size_t)b * SEQ + (ck - 4) * 64;
        GateRegs g; gla_gate_loads(a, g, gp, row0, h);
        const v4u kr = *(const v4u*)(gp + (row0 + tokA) * NGL + GK + h * 64 + dgA * 8);
        const v4u v0 = *(const v4u*)(gp + (row0 + tokB) * NGL + GV + h * 128 + peB * 8), v1 = *(const v4u*)(gp + (row0 + tokB + 32) * NGL + GV + h * 128 + peB * 8);
        gla_gates2(L, g);
        { float kv[8]; unpack8(kr, kv);
#pragma unroll
          for (int dir = 0; dir < 2; ++dir) { float ko[8];
#pragma unroll
              for (int i = 0; i < 8; ++i) { const int d = dgA * 8 + i; ko[i] = kv[i] * __expf(TOT[dir * 64 + d] - BCT[dir * (64 * 65) + d * 65 + tokA]); }
              v4u kw; kw.x = pk2(ko[0], ko[1]); kw.y = pk2(ko[2], ko[3]); kw.z = pk2(ko[4], ko[5]); kw.w = pk2(ko[6], ko[7]);
              *(LAS v4u*)(L + G3_KE + dir * 64 * G3_KEROWB + tokA * G3_KEROWB + dgA * 16) = kw; }
          *(LAS v4u*)(L + G3_V + tokB * G3_VROWB + peB * 16) = v0; *(LAS v4u*)(L + G3_V + (tokB + 32) * G3_VROWB + peB * 16) = v1;
          if (tid < 128) DEC[gla_item(b, h, tid >> 6, ck) * 64 + (tid & 63)] = __expf(TOT[tid]); }
        LBAR();
#pragma unroll
        for (int j = 0; j < 2; ++j) { const int tile = 2 * wave + j, dir = tile >> 3, mt = (tile >> 2) & 1, nt = tile & 3;
            gf32x16 acc;
#pragma unroll
            for (int i = 0; i < 16; ++i) acc[i] = 0.f;
            const LAS unsigned char* ap = L + G3_KE + dir * 64 * G3_KEROWB + (8 * hh + q4) * G3_KEROWB + (mt * 32 + 16 * g1 + 4 * p4) * 2;
            const LAS unsigned char* bp = L + G3_V + (8 * hh + q4) * G3_VROWB + (nt * 32 + 16 * g1 + 4 * p4) * 2;
#pragma unroll
            for (int kk = 0; kk < 4; ++kk) acc = __builtin_amdgcn_mfma_f32_32x32x16_bf16(gl_frag_tr(ap + 16 * kk * G3_KEROWB, G3_KEROWB), gl_frag_tr(bp + 16 * kk * G3_VROWB, G3_VROWB), acc, 0, 0, 0);
            bf16* sp = ST + gla_item(b, h, dir, ck) * 8192 + (nt * 32 + r) * 64 + mt * 32 + 4 * hh;
#pragma unroll
            for (int gq = 0; gq < 4; ++gq) { v2u o; o.x = pk2(acc[4 * gq], acc[4 * gq + 1]); o.y = pk2(acc[4 * gq + 2], acc[4 * gq + 3]); *(v2u*)(sp + 8 * gq) = o; } }
        LBAR();
        STAMP(44);
    }
}

__device__ __forceinline__ void gla_scan(const Args& a) {
    bf16* ST = (bf16*)(a.ws + WS_XN); const float* DEC = (const float*)(a.ws + WS_DEC);
    for (int w = blockIdx.x * NTHR + threadIdx.x; w < 64 * 1024; w += gridDim.x * NTHR) {
        const int chain = w >> 10, el = (w & 1023) * 8, d0 = el & 63; float s[8];
#pragma unroll
        for (int i = 0; i < 8; ++i) s[i] = 0.f;
#pragma unroll 4
        for (int sig = 0; sig < NSIG; ++sig) { const size_t item = (size_t)chain * NSIG + sig;
            v4u* p = (v4u*)(ST + item * 8192 + el); const v4u dsv = *p;
            const f32x4 d0v = *(const f32x4*)(DEC + item * 64 + d0), d1v = *(const f32x4*)(DEC + item * 64 + d0 + 4);
            v4u o; o.x = pk2(s[0], s[1]); o.y = pk2(s[2], s[3]); o.z = pk2(s[4], s[5]); o.w = pk2(s[6], s[7]); *p = o;
            s[0] = d0v.x * s[0] + bf2f(dsv.x & 0xffffu); s[1] = d0v.y * s[1] + bf2f(dsv.x >> 16);
            s[2] = d0v.z * s[2] + bf2f(dsv.y & 0xffffu); s[3] = d0v.w * s[3] + bf2f(dsv.y >> 16);
            s[4] = d1v.x * s[4] + bf2f(dsv.z & 0xffffu); s[5] = d1v.y * s[5] + bf2f(dsv.z >> 16);
            s[6] = d1v.z * s[6] + bf2f(dsv.w & 0xffffu); s[7] = d1v.w * s[7] + bf2f(dsv.w >> 16); }
    }
}

__device__ __forceinline__ void gla_out_mfma(const Args& a, unsigned char* lds, unsigned long long& tp_) {
    LAS unsigned char* L = (LAS unsigned char*)lds;
    const int tid = threadIdx.x, lane = tid & 63, wave = __builtin_amdgcn_readfirstlane(tid >> 6), r = lane & 31, hh = lane >> 5, g1 = (lane >> 4) & 1, q4 = (lane >> 2) & 3, p4 = lane & 3;
    const bf16* gp = (const bf16*)(a.ws + WS_GPROJ); const bf16* ST = (const bf16*)(a.ws + WS_XN); bf16* ycat = (bf16*)(a.ws + WS_YCAT);
    LAS float* BCT = (LAS float*)(L + G2_BCT); LAS float* OB = (LAS float*)(L + G2_OB); LAS float* RS = (LAS float*)(L + G2_RS);
    const int tokA = tid >> 3, dgA = tid & 7;
    const int tokB = tid >> 4, peB = tid & 15;
    float gnv[8];
#pragma unroll
    for (int i = 0; i < 8; ++i) gnv[i] = a.in[I_GLAN][peB * 8 + i];
    for (int it = blockIdx.x; it < NB * 4 * 64; it += gridDim.x) {
        const int n = it & 63, h = (it >> 6) & 3, b = it >> 8; const size_t row0 = (size_t)b * SEQ + n * 64;
        GateRegs g; gla_gate_loads(a, g, gp, row0, h);
        const v4u qr = *(const v4u*)(gp + (row0 + tokA) * NGL + GQ + h * 64 + dgA * 8), kr = *(const v4u*)(gp + (row0 + tokA) * NGL + GK + h * 64 + dgA * 8);
        const bf16* rb0 = gp + (row0 + tokB) * NGL + h * 128 + peB * 8; const bf16* rb1 = rb0 + (size_t)32 * NGL;
        const v4u v0 = *(const v4u*)(rb0 + GV), v1 = *(const v4u*)(rb1 + GV), og0 = *(const v4u*)(rb0 + GOG), og1 = *(const v4u*)(rb1 + GOG);
        v4u stv[2][2];
#pragma unroll
        for (int dir = 0; dir < 2; ++dir) { const bf16* sp = ST + gla_item(b, h, dir, n + 4) * 8192 + tokA * 64 + dgA * 8; stv[dir][0] = *(const v4u*)sp; stv[dir][1] = *(const v4u*)(sp + 64 * 64); }
        STAMP(50);
        gla_gates2(L, g);
        STAMP(45);
        { float qv[8], kv[8]; unpack8(qr, qv); unpack8(kr, kv);
#pragma unroll
          for (int dir = 0; dir < 2; ++dir) { float qo[8], ko[8];
#pragma unroll
              for (int i = 0; i < 8; ++i) { const float bc = BCT[dir * (64 * 65) + (dgA * 8 + i) * 65 + tokA]; qo[i] = qv[i] * 0.125f * __expf(bc); ko[i] = kv[i] * __expf(-bc); }
              v4u qw, kw; qw.x = pk2(qo[0], qo[1]); qw.y = pk2(qo[2], qo[3]); qw.z = pk2(qo[4], qo[5]); qw.w = pk2(qo[6], qo[7]);
              kw.x = pk2(ko[0], ko[1]); kw.y = pk2(ko[2], ko[3]); kw.z = pk2(ko[4], ko[5]); kw.w = pk2(ko[6], ko[7]);
              *(LAS v4u*)(L + G2_QI + dir * 64 * GL_ROWB + tokA * GL_ROWB + dgA * 16) = qw;
              *(LAS v4u*)(L + G2_KI + dir * 64 * GL_ROWB + tokA * GL_ROWB + dgA * 16) = kw; }
          *(LAS v4u*)(L + G3_V + tokB * G3_VROWB + peB * 16) = v0; *(LAS v4u*)(L + G3_V + (tokB + 32) * G3_VROWB + peB * 16) = v1; }
        LBAR();
        STAMP(46);
#pragma unroll
        for (int dir = 0; dir < 2; ++dir) { *(LAS v4u*)(L + G3_STI + dir * 128 * GL_ROWB + tokA * GL_ROWB + dgA * 16) = stv[dir][0]; *(LAS v4u*)(L + G3_STI + dir * 128 * GL_ROWB + (tokA + 64) * GL_ROWB + dgA * 16) = stv[dir][1]; }
        { const int dir = wave >> 2, mt = (wave >> 1) & 1, nt = wave & 1;
          gf32x16 acc;
#pragma unroll
          for (int i = 0; i < 16; ++i) acc[i] = 0.f;
          const LAS unsigned char* ap = L + G2_QI + dir * 64 * GL_ROWB + (mt * 32 + r) * GL_ROWB + 16 * hh;
          const LAS unsigned char* bp = L + G2_KI + dir * 64 * GL_ROWB + (nt * 32 + r) * GL_ROWB + 16 * hh;
#pragma unroll
          for (int kk = 0; kk < 4; ++kk) acc = __builtin_amdgcn_mfma_f32_32x32x16_bf16(gl_frag(ap + 32 * kk), gl_frag(bp + 32 * kk), acc, 0, 0, 0);
          LAS bf16* at = (LAS bf16*)(L + G2_ATT + dir * 64 * GL_ROWB); const int sc = nt * 32 + r;
#pragma unroll
          for (int i = 0; i < 16; ++i) { const int c = mt * 32 + (i & 3) + 8 * (i >> 2) + 4 * hh; const bool keep = dir == 0 ? (sc <= c) : (sc >= c);
              at[c * 72 + sc] = (bf16)f2bf(keep ? acc[i] : 0.f); } }
        LBAR();
        STAMP(47);
        { const int omt = wave >> 2, ont = wave & 3;
          gf32x16 acc;
#pragma unroll
          for (int i = 0; i < 16; ++i) acc[i] = 0.f;
          const LAS unsigned char* vp = L + G3_V + (8 * hh + q4) * G3_VROWB + (ont * 32 + 16 * g1 + 4 * p4) * 2;
#pragma unroll
          for (int dir = 0; dir < 2; ++dir) {
              const LAS unsigned char* ap = L + G2_ATT + dir * 64 * GL_ROWB + (omt * 32 + r) * GL_ROWB + 16 * hh;
#pragma unroll
              for (int kk = 0; kk < 4; ++kk) acc = __builtin_amdgcn_mfma_f32_32x32x16_bf16(gl_frag(ap + 32 * kk), gl_frag_tr(vp + 16 * kk * G3_VROWB, G3_VROWB), acc, 0, 0, 0);
              const LAS unsigned char* qp = L + G2_QI + dir * 64 * GL_ROWB + (omt * 32 + r) * GL_ROWB + 16 * hh;
              const LAS unsigned char* sp = L + G3_STI + dir * 128 * GL_ROWB + (ont * 32 + r) * GL_ROWB + 16 * hh;
#pragma unroll
              for (int kk = 0; kk < 4; ++kk) acc = __builtin_amdgcn_mfma_f32_32x32x16_bf16(gl_frag(qp + 32 * kk), gl_frag(sp + 32 * kk), acc, 0, 0, 0);
          }
          LBAR();
#pragma unroll
          for (int i = 0; i < 16; ++i) { const int c = omt * 32 + (i & 3) + 8 * (i >> 2) + 4 * hh; OB[c * 132 + ont * 32 + r] = acc[i]; } }
        LBAR();
        STAMP(48);
        for (int j = 0; j < 8; ++j) { const int c = wave * 8 + j; const float x0 = OB[c * 132 + lane], x1 = OB[c * 132 + 64 + lane];
            const float ss = wave_sum(x0 * x0 + x1 * x1); if (lane == 0) RS[c] = rsqrtf(ss * (1.f / 128.f) + EPSF); }
        LBAR();
#pragma unroll
        for (int t2 = 0; t2 < 2; ++t2) { const int tok = tokB + 32 * t2; const float rstd = RS[tok]; float gg[8]; unpack8(t2 ? og1 : og0, gg);
            const f32x4 a0 = *(const LAS f32x4*)(OB + tok * 132 + peB * 8), a1 = *(const LAS f32x4*)(OB + tok * 132 + peB * 8 + 4);
            const float ov[8] = {a0.x, a0.y, a0.z, a0.w, a1.x, a1.y, a1.z, a1.w}; float y[8];
#pragma unroll
            for (int i = 0; i < 8; ++i) y[i] = ov[i] * rstd * gnv[i] * siluf(gg[i]);
            v4u w0; w0.x = pk2(y[0], y[1]); w0.y = pk2(y[2], y[3]); w0.z = pk2(y[4], y[5]); w0.w = pk2(y[6], y[7]);
            *(v4u*)(ycat + (row0 + tok) * DM + DH + h * 128 + peB * 8) = w0; }
        LBAR();
        STAMP(49);
    }
}

typedef short hbf16x8 __attribute__((ext_vector_type(8)));
typedef float hf32x16 __attribute__((ext_vector_type(16)));
constexpr int HK_COPYB = 16448, HK_OFF = 0, HZ_OFF = 4 * HK_COPYB, HZ_ROWB = 8208, HZERO_OFF = HZ_OFF + 8 * HZ_ROWB, HRED_OFF = HZERO_OFF + 64;
constexpr int HK_VEC = 4 * HK_COPYB / 16;
static_assert(HRED_OFF + 64 <= MISC_OFF && 8 * HZ_ROWB <= 4 * HK_COPYB, "hyena LDS map");
__device__ __forceinline__ void hy_unpack8(const v4u r, float* o) {
    o[0] = bf2f(r.x & 0xffffu); o[1] = bf2f(r.x >> 16); o[2] = bf2f(r.y & 0xffffu); o[3] = bf2f(r.y >> 16);
    o[4] = bf2f(r.z & 0xffffu); o[5] = bf2f(r.z >> 16); o[6] = bf2f(r.w & 0xffffu); o[7] = bf2f(r.w >> 16);
}
__device__ __forceinline__ void hyena_conv_mfma(const Args& a, unsigned char* lds, int j0, int j1, unsigned long long& tp_) {
    LAS unsigned char* L = (LAS unsigned char*)lds;
    const int tid = threadIdx.x, lane = tid & 63, wave = __builtin_amdgcn_readfirstlane(tid >> 6), r = lane & 31, h = lane >> 5;
    const bf16* hyT = (const bf16*)(a.ws + WS_HYT); bf16* yT = (bf16*)(a.ws + WS_YT); const float* Kraw = (const float*)(a.ws + WS_KRAW); const float* SSQ = (const float*)(a.ws + WS_SSQ);
    const float* cw = a.in[I_CONVW]; const float* cbv = a.in[I_CONVB];
    for (int jq = j0; jq < j1; ++jq) { const int c = blockIdx.x + jq * gridDim.x; if (c >= DH) break;
        STAMP(40);
        { const float part = SSQ[(tid >> 1) * 1024 + (tid & 1) * 512 + c]; const float wsum = wave_sum(part); if (lane == 0) ((LAS float*)(L + HRED_OFF))[wave] = wsum; }
        { f32x4 kv[4];
#pragma unroll
          for (int i = 0; i < 4; ++i) kv[i] = *(const f32x4*)(Kraw + (size_t)c * 8192 + 4 * (tid + NTHR * i));
#pragma unroll
          for (int i = 0; i < 4; ++i) { const int x0 = 8192 - 4 * (tid + NTHR * i); const float kf[4] = {kv[i].x, kv[i].y, kv[i].z, kv[i].w};
#pragma unroll
              for (int e = 0; e < 4; ++e) { const bf16 hv = (bf16)f2bf(kf[e]);
#pragma unroll
                  for (int s = 0; s < 4; ++s) { const int y = x0 - e - s; if (y >= 0) *(LAS bf16*)(L + HK_OFF + s * HK_COPYB + 2 * y) = hv; } } } }
        if (tid < 4) ((LAS unsigned*)(L + HZERO_OFF))[tid] = 0u;
        { const int c1 = DH + c, c2 = 2 * DH + c;
          const float a0 = cw[c1], a1 = cw[NHY + c1], a2 = cw[2 * NHY + c1], ab = cbv[c1], b0 = cw[c2], b1 = cw[NHY + c2], b2 = cw[2 * NHY + c2], bb = cbv[c2];
#pragma unroll
          for (int ps = 0; ps < 2; ++ps) { v4u r1[4], r2[4]; bf16 e1[4][2], e2[4][2];
#pragma unroll
              for (int i = 0; i < 4; ++i) { const int gi = tid + NTHR * (4 * ps + i), b = gi >> 9, t0 = (gi & 511) * 8, col = b * SEQ + t0;
                  const bf16* p1 = hyT + (size_t)c1 * MLAT + col; const bf16* p2 = hyT + (size_t)c2 * MLAT + col;
                  r1[i] = *(const v4u*)p1; r2[i] = *(const v4u*)p2;
                  const bool hl = (t0 & 63) != 0, hr = ((t0 + 8) & 63) != 0;
                  e1[i][0] = p1[hl ? -1 : 0]; e2[i][0] = p2[hl ? -1 : 0]; e1[i][1] = p1[hr ? 8 : 7]; e2[i][1] = p2[hr ? 8 : 7]; }
#pragma unroll
              for (int i = 0; i < 4; ++i) { const int gi = tid + NTHR * (4 * ps + i), b = gi >> 9, t0 = (gi & 511) * 8;
                  float u[10], w[10]; hy_unpack8(r1[i], u + 1); hy_unpack8(r2[i], w + 1);
                  const bool hl = (t0 & 63) != 0, hr = ((t0 + 8) & 63) != 0;
                  u[0] = hl ? bf2f(e1[i][0]) : 0.f; w[0] = hl ? bf2f(e2[i][0]) : 0.f; u[9] = hr ? bf2f(e1[i][1]) : 0.f; w[9] = hr ? bf2f(e2[i][1]) : 0.f;
                  float z[8];
#pragma unroll
                  for (int k = 0; k < 8; ++k) z[k] = (ab + a0 * u[k] + a1 * u[k + 1] + a2 * u[k + 2]) * (bb + b0 * w[k] + b1 * w[k + 1] + b2 * w[k + 2]);
                  v4u o; o.x = pk2(z[0], z[1]); o.y = pk2(z[2], z[3]); o.z = pk2(z[4], z[5]); o.w = pk2(z[6], z[7]);
                  *(LAS v4u*)(L + HZ_OFF + b * HZ_ROWB + 2 * t0) = o; } } }
        LBAR();
        STAMP(41);
        float sc;
        { float tot = 0.f;
#pragma unroll
          for (int i = 0; i < 8; ++i) tot += ((const LAS float*)(L + HRED_OFF))[i];
          sc = rsqrtf(tot + EPSF); }
        hf32x16 acc[2][2];
#pragma unroll
        for (int m = 0; m < 2; ++m)
#pragma unroll
            for (int n = 0; n < 2; ++n)
#pragma unroll
                for (int i = 0; i < 16; ++i) acc[m][n][i] = 0.f;
        const int I0 = 8 * wave, q = r >> 3, b = r & 7, sh = (-r) & 3;
        const int a_lane = HK_OFF + sh * HK_COPYB + 2 * (4096 - r + 8 * h - sh);
        const int b_lane = HZ_OFF + b * HZ_ROWB + 16 * h;
#define HY_LOADA(dd, AF) do { const int ab_ = a_lane - 128 * (dd); _Pragma("unroll") for (int f = 0; f < 6; ++f) { const int ad = ab_ - 64 + 32 * f; \
            const v2u lo = *(const volatile LAS v2u*)(L + ad), hi = *(const volatile LAS v2u*)(L + ad + 8); AF[f] = __builtin_bit_cast(hbf16x8, (v4u){lo.x, lo.y, hi.x, hi.y}); } } while (0)
#define HY_LOADB(dd, kk_, BF) do { const int J0_ = I0 + q - (dd), J1_ = J0_ + 4; const bool k0_ = (unsigned)J0_ < 64u, k1_ = (unsigned)J1_ < 64u; \
            BF[0] = __builtin_bit_cast(hbf16x8, *(const LAS v4u*)(L + (k0_ ? b_lane + 128 * J0_ + 32 * (kk_) : HZERO_OFF))); \
            BF[1] = __builtin_bit_cast(hbf16x8, *(const LAS v4u*)(L + (k1_ ? b_lane + 128 * J1_ + 32 * (kk_) : HZERO_OFF))); } while (0)
        for (int rep_ = 0; rep_ < 1 + ((PROBE_REPEAT >> 5) & 1); ++rep_) {
        const int dlo = I0 - 63, dhi = I0 + 7;
        hbf16x8 afc[6], bfc[2];
        HY_LOADA(dlo, afc); HY_LOADB(dlo, 0, bfc);
        for (int d = dlo; d <= dhi; ++d) {
            const int dn = d < dhi ? d + 1 : dhi;
            hbf16x8 afn[6], bfn[2];
#pragma unroll
            for (int kk = 0; kk < 4; ++kk) {
                if (kk == 0) HY_LOADA(dn, afn);
                if (kk < 3) HY_LOADB(d, kk + 1, bfn); else HY_LOADB(dn, 0, bfn);
                __builtin_amdgcn_sched_barrier(0);
#pragma unroll
                for (int m = 0; m < 2; ++m)
#pragma unroll
                    for (int n = 0; n < 2; ++n) acc[m][n] = __builtin_amdgcn_mfma_f32_32x32x16_bf16(afc[kk + 2 - 2 * m], bfc[n], acc[m][n], 0, 0, 0);
                __builtin_amdgcn_sched_barrier(0);
                bfc[0] = bfn[0]; bfc[1] = bfn[1];
            }
#pragma unroll
            for (int f = 0; f < 6; ++f) afc[f] = afn[f];
        }
        }
#undef HY_LOADA
#undef HY_LOADB
        v4u x0v[8];
#pragma unroll
        for (int i = 0; i < 8; ++i) { const int gi = tid + NTHR * i, bb = gi >> 9, t0 = (gi & 511) * 8; x0v[i] = *(const v4u*)(hyT + (size_t)c * MLAT + bb * SEQ + t0); }
        STAMP(42);
        LBAR();  STAMP(51);
#pragma unroll
        for (int i = 0; i < 8; ++i) { const int gi = tid + NTHR * i, bb = gi >> 9, t0 = (gi & 511) * 8; *(LAS v4u*)(L + HK_OFF + bb * HZ_ROWB + 2 * t0) = x0v[i]; }
        LBAR();
        STAMP(52);
        for (int repe_ = 0; repe_ < 1 + ((PROBE_REPEAT >> 7) & 1); ++repe_)
        { const float w0 = cw[c], w1 = cw[NHY + c], w2 = cw[2 * NHY + c], wb = cbv[c], hb = a.in[I_HBIAS][c];
#pragma unroll
          for (int m = 0; m < 2; ++m)
#pragma unroll
              for (int n = 0; n < 2; ++n)
#pragma unroll
                  for (int g = 0; g < 4; ++g) { const int t0 = 64 * (I0 + 4 * n + q) + 32 * m + 8 * g + 4 * h;
                      const LAS bf16* xp = (const LAS bf16*)(L + HK_OFF + b * HZ_ROWB + 2 * t0);
                      const v2u xr = *(const LAS v2u*)xp; const v2u zr = *(const LAS v2u*)(L + HZ_OFF + b * HZ_ROWB + 2 * t0);
                      float xv[6];
                      const bool xl = (t0 & 63) != 0, xh = ((t0 + 4) & 63) != 0; const bf16 xlv = xp[xl ? -1 : 0], xhv = xp[xh ? 4 : 3];
                      xv[0] = xl ? bf2f(xlv) : 0.f; xv[5] = xh ? bf2f(xhv) : 0.f;
                      xv[1] = bf2f(xr.x & 0xffffu); xv[2] = bf2f(xr.x >> 16); xv[3] = bf2f(xr.y & 0xffffu); xv[4] = bf2f(xr.y >> 16);
                      const float zv[4] = {bf2f(zr.x & 0xffffu), bf2f(zr.x >> 16), bf2f(zr.y & 0xffffu), bf2f(zr.y >> 16)};
                      float y[4];
#pragma unroll
                      for (int k = 0; k < 4; ++k) y[k] = (wb + w0 * xv[k] + w1 * xv[k + 1] + w2 * xv[k + 2]) * (acc[m][n][4 * g + k] * (((PROBE_REPEAT >> 5) & 1) ? 0.5f * sc : sc) + hb * zv[k]);
                      v2u o; o.x = pk2(y[0], y[1]); o.y = pk2(y[2], y[3]);
                      *(LAS v2u*)(L + HZ_OFF + b * HZ_ROWB + 2 * t0) = o; } }
        LBAR();
        STAMP(53);
#pragma unroll
        for (int i = 0; i < 8; ++i) { const int gi = tid + NTHR * i, bb = gi >> 9, t0 = (gi & 511) * 8;
            *(v4u*)(yT + (size_t)c * MLAT + bb * SEQ + t0) = *(const LAS v4u*)(L + HZ_OFF + bb * HZ_ROWB + 2 * t0); }
        LBAR();
        STAMP(43);
    }
}
__device__ __forceinline__ void hyena_transpose(const Args& a, unsigned char* lds) {
    const int tid = threadIdx.x, lane = tid & 63, wave = tid >> 6;
    bf16* scr = (bf16*)(lds + wave * 16384);
    const bf16* yT = (const bf16*)(a.ws + WS_YT); bf16* ycat = (bf16*)(a.ws + WS_YCAT);
    const int gw = blockIdx.x * NWAVES + wave, NGW = gridDim.x * NWAVES;
    for (int t = gw; t < (DH / 64) * (MLAT / 64); t += NGW) { const int cb = t & 7, tb = t >> 3, c0 = cb * 64, k0 = tb * 64;
        for (int r = 0; r < 64; ++r) scr[r * 66 + lane] = yT[(size_t)(c0 + r) * MLAT + k0 + lane];
        LDS_WAIT(); asm volatile("" ::: "memory");
        for (int r = 0; r < 64; ++r) ycat[(size_t)(k0 + r) * DM + c0 + lane] = scr[lane * 66 + r];
        LDS_WAIT(); asm volatile("" ::: "memory"); }
}

__device__ __forceinline__ void bias2_gemv(const Args& a) {
    const int tid = threadIdx.x, lane = tid & 63, wave = tid >> 6;
    const int gw = blockIdx.x * NWAVES + wave, NGW = gridDim.x * NWAVES;
    const bf16* W1T = (const bf16*)(a.ws + WS_W1); const float* mod = (const float*)(a.ws + WS_MOD); float* B2 = (float*)(a.ws + WS_BIAS2);
    for (int n = gw; n < FF; n += NGW) {
        const v4u w0 = *(const v4u*)(W1T + (size_t)n * DM + lane * 8), w1 = *(const v4u*)(W1T + (size_t)n * DM + 512 + lane * 8);
        float wf[16]; unpack8(w0, wf); unpack8(w1, wf + 8);
        float accb[NB];
#pragma unroll
        for (int b = 0; b < NB; ++b) { const float* sh = mod + b * MODW + MOD_SH2; const f32x4 p0 = *(const f32x4*)(sh + lane * 8), p1 = *(const f32x4*)(sh + lane * 8 + 4), p2 = *(const f32x4*)(sh + 512 + lane * 8), p3 = *(const f32x4*)(sh + 512 + lane * 8 + 4);
            float s = (p0.x * wf[0] + p0.y * wf[1]) + (p0.z * wf[2] + p0.w * wf[3]) + (p1.x * wf[4] + p1.y * wf[5]) + (p1.z * wf[6] + p1.w * wf[7]);
            s += (p2.x * wf[8] + p2.y * wf[9]) + (p2.z * wf[10] + p2.w * wf[11]) + (p3.x * wf[12] + p3.y * wf[13]) + (p3.z * wf[14] + p3.w * wf[15]);
            accb[b] = wave_sum(s); }
        if (lane < NB) { float v = accb[0];
#pragma unroll
            for (int b = 1; b < NB; ++b) v = lane == b ? accb[b] : v;
            B2[lane * FF + n] = v; }
    }
}

#define XB_TMO      128
#define XB_XCNT(j)  (256  + 64 * (j))
#define XB_XSUB(j)  (1280 + 64 * (j))
#define XB_XGEN(j)  (2304 + 64 * (j))
#define XB_TOP      3328
#define XB_TOPGEN   3392
#define XCD_BAR_WORDS 3456
#define XB_SPIN_CAP (1u << 18)

__device__ __forceinline__ unsigned xb_ld(unsigned* p)              { return __hip_atomic_load(p, __ATOMIC_RELAXED, __HIP_MEMORY_SCOPE_AGENT); }
__device__ __forceinline__ unsigned xb_add(unsigned* p, unsigned v) { return __hip_atomic_fetch_add(p, v, __ATOMIC_RELAXED, __HIP_MEMORY_SCOPE_AGENT); }
__device__ __forceinline__ unsigned xb_xcc_id() { return (unsigned)__builtin_amdgcn_s_getreg((3 << 11) | 20) & 0xFu; }
#define XB_SPIN(cond, bar) do { unsigned _sp = 0; while (cond) { __builtin_amdgcn_s_sleep(1); \
    if ((++_sp & 255u) == 0u) { if (xb_ld(&(bar)[XB_TMO])) break; if (_sp > XB_SPIN_CAP) { atomicAdd(&(bar)[XB_TMO], 1u); break; } } } } while (0)

struct XcdBarrier {
    unsigned* bar; unsigned x;
    volatile LAS unsigned* st;
};

__device__ __forceinline__ XcdBarrier xcd_barrier_post(unsigned* bar, volatile LAS unsigned* st) {
    XcdBarrier b; b.bar = bar; b.x = xb_xcc_id(); b.st = st;
    if (threadIdx.x == 0) (void)xb_add(&bar[XB_XCNT(b.x)], 1u);
    return b;
}
__device__ __forceinline__ void xcd_barrier_complete(unsigned* bar, unsigned x, unsigned& nloc, unsigned& nx) {
    const unsigned G = gridDim.x * gridDim.y * gridDim.z;
    unsigned sum, cnt, mine, sp = 0u;
    for (;;) {
        sum = 0u; cnt = 0u; mine = 0u;
#pragma unroll
        for (unsigned j = 0; j < 16; ++j) { const unsigned c = xb_ld(&bar[XB_XCNT(j)]); sum += c; cnt += (c > 0u) ? 1u : 0u; mine = (j == x) ? c : mine; }
        if (sum == G) break;
        __builtin_amdgcn_s_sleep(1);
        if ((++sp & 255u) == 0u) { if (xb_ld(&bar[XB_TMO])) break; if (sp > XB_SPIN_CAP) { atomicAdd(&bar[XB_TMO], 1u); break; } }
    }
    nloc = mine > 0u ? mine : 1u; nx = cnt > 0u ? cnt : 1u;
}

__device__ __forceinline__ void xcd_barrier(const XcdBarrier& b) {
    asm volatile("s_waitcnt vmcnt(0)" ::: "memory");
    __syncthreads();
    if (threadIdx.x == 0) {
        unsigned* bar = b.bar;
        __builtin_amdgcn_s_waitcnt(0);
        unsigned nloc = b.st[0], nx = b.st[1];
        if (nloc == 0u) { xcd_barrier_complete(bar, b.x, nloc, nx); b.st[0] = nloc; b.st[1] = nx; }
        const unsigned old = xb_add(&bar[XB_XSUB(b.x)], 1u);
        const unsigned gen = old / nloc;
        if (old + 1u == (gen + 1u) * nloc) {
            __builtin_amdgcn_fence(__ATOMIC_RELEASE, "agent");
            asm volatile("s_waitcnt vmcnt(0)" ::: "memory");
            const unsigned og = xb_add(&bar[XB_TOP], 1u);
            const unsigned tg = og / nx;
            if (og + 1u == (tg + 1u) * nx) xb_add(&bar[XB_TOPGEN], 1u);
            else XB_SPIN(xb_ld(&bar[XB_TOPGEN]) == tg, bar);
            __builtin_amdgcn_fence(__ATOMIC_ACQUIRE, "agent");
            xb_add(&bar[XB_XGEN(b.x)], 1u);
            asm volatile("s_waitcnt vmcnt(0)" ::: "memory");
        } else {
            XB_SPIN(xb_ld(&bar[XB_XGEN(b.x)]) == gen, bar);
            __builtin_amdgcn_fence(__ATOMIC_ACQUIRE, "agent");
            asm volatile("s_waitcnt vmcnt(0)" ::: "memory");
        }
    }
    __syncthreads();
}

constexpr int NPHASE = 11;
__global__ void __launch_bounds__(NTHR, 2) fwd_kernel(Args a) {
    extern __shared__ __attribute__((aligned(16))) unsigned char lds[];
    const int lo = a.ph_lo, hi = a.ph_hi;
    unsigned long long tp_ = PROBE_TS >= 0 ? __builtin_amdgcn_s_memrealtime() : 0ull;
    volatile LAS unsigned* MISC = (volatile LAS unsigned*)((LAS unsigned char*)lds + MISC_OFF);
    if (threadIdx.x < 16) MISC[threadIdx.x] = 0u;
    __syncthreads();
    XcdBarrier bar = xcd_barrier_post((unsigned*)(a.ws + WS_CTL) + CW_BAR, MISC + 8);
#define IN(k) (lo <= (k) && (k) < hi)
#define SEAM(k) do { STAMP(2 * (k)); if (IN(k) && IN((k) + 1)) xcd_barrier(bar); STAMP(2 * (k) + 1); } while (0)
    unsigned char* ws = a.ws;
    PG8_LAS unsigned char* ldsg = (PG8_LAS unsigned char*)lds;
    if (IN(0)) { for (int rep = 0; rep < 1 + ((PROBE_REPEAT >> 4) & 1); ++rep) { p0_prologue(a, lds); __syncthreads(); } } SEAM(0);
    if (IN(1)) { norm_mod_rows(a, a.in[I_X], a.in[I_CTX], MALL, a.in[I_NMIX], MOD_SC1, MOD_SH1, (bf16*)(ws + WS_XN)); } SEAM(1);
    if (IN(2)) {
        { pg8::Gemm g{(const pg8::bf16_t*)(ws + WS_WIN), (const pg8::bf16_t*)(ws + WS_XN), NHY, MLAT, DM}; pg8::StaticOrder S; S.init(NHY, MLAT, gridDim.x, blockIdx.x);
          pg8::EpiBf16<0> E{(pg8::bf16_t*)(ws + WS_HYT), MLAT};
          pg8::gemm_phase<pg8::EpiBf16<0>, pg8::StaticOrder, true, true>(ldsg, g, S, E); }
        __syncthreads();
        { pg8::Gemm g{(const pg8::bf16_t*)(ws + WS_XN), (const pg8::bf16_t*)(ws + WS_WIN) + (size_t)NHY * DM, MALL, NGL, DM}; pg8::StaticOrder S; S.init(MALL, NGL, gridDim.x, blockIdx.x);
          pg8::EpiBf16<0> E{(pg8::bf16_t*)(ws + WS_GPROJ), NGL};
          pg8::gemm_phase<pg8::EpiBf16<0>, pg8::StaticOrder, true, true>(ldsg, g, S, E); }
    } SEAM(2);
    if (IN(3)) {
        const int nG = (NB * 4 * NSIG - (int)blockIdx.x + (int)gridDim.x - 1) / (int)gridDim.x, nH = (DH - (int)blockIdx.x + (int)gridDim.x - 1) / (int)gridDim.x;
        const int pos0 = blockIdx.x & 7, hstep = 4; int kG = 0, jH = 0;
        for (;;) {
            const bool wantH = jH < nH && (kG >= nG || kG >= pos0 + hstep * jH);
            if (wantH) { hyena_conv_mfma(a, lds, jH, jH + 1, tp_); ++jH; }
            else if (kG < nG) { gla_local_mfma(a, lds, kG, kG + 1, tp_); ++kG; }
            else break;
        }
    } SEAM(3);
    if (IN(4)) { gla_scan(a); bias2_gemv(a); } SEAM(4);
    if (IN(5)) { for (int rep = 0; rep < 1 + ((PROBE_REPEAT >> 2) & 1); ++rep) { gla_out_mfma(a, lds, tp_); __syncthreads(); }
                 for (int rep = 0; rep < 1 + ((PROBE_REPEAT >> 3) & 1); ++rep) { hyena_transpose(a, lds); __syncthreads(); } } SEAM(5);
    if (IN(6)) { pg8::Gemm g{(const pg8::bf16_t*)(ws + WS_YCAT), (const pg8::bf16_t*)(ws + WS_WOUT), MLAT, DM, DM}; pg8::StaticOrder S; S.init(MLAT, DM, gridDim.x, blockIdx.x);
        pg8::EpiResidH2 E{a.in[I_X], a.out, DM, (const float*)(ws + WS_MOD) + MOD_G1, (const float*)(ws + WS_MOD) + MOD_SC2, a.in[I_NMLP], SEQ, MODW, (pg8::bf16_t*)(ws + WS_XN), (float*)(ws + WS_SSQ2)};
        pg8::gemm_phase<pg8::EpiResidH2, pg8::StaticOrder, true, true>(ldsg, g, S, E); } SEAM(6);
    if (IN(8)) { pg8::Gemm g{(const pg8::bf16_t*)(ws + WS_XN), (const pg8::bf16_t*)(ws + WS_W1), MLAT, FF, DM}; pg8::StaticOrder S; S.init(MLAT, FF, gridDim.x, blockIdx.x);
        pg8::EpiSqReluRstd E{(pg8::bf16_t*)(ws + WS_HID), FF, (const float*)(ws + WS_SSQ2), (const float*)(ws + WS_BIAS2), SEQ, FF, 1.0f / DM, EPSF};
        pg8::gemm_phase<pg8::EpiSqReluRstd, pg8::StaticOrder, true, true>(ldsg, g, S, E); } SEAM(8);
    if (IN(9)) { pg8::Gemm g{(const pg8::bf16_t*)(ws + WS_HID), (const pg8::bf16_t*)(ws + WS_W2), MLAT, DM, FF}; pg8::StaticOrder S; S.init(MLAT, DM, gridDim.x, blockIdx.x);
        pg8::EpiResid E{a.out, a.out, DM, (const float*)(ws + WS_MOD) + MOD_G2, SEQ, MODW};
        pg8::gemm_phase<pg8::EpiResid, pg8::StaticOrder, true, true>(ldsg, g, S, E); } SEAM(9);
    if (IN(10)) { final_norm_rows(a); }
    STAMP(20);
    if (PROBE_TS >= 0 && blockIdx.x == 0 && threadIdx.x == 0) a.out[0] = (float)((unsigned long long*)(a.ws + 32768))[PROBE_TS < 0 ? 0 : PROBE_TS] * 0.01f;
#undef IN
#undef SEAM
}

#ifndef N_LAUNCH_MODE
#define N_LAUNCH_MODE 1
#endif
extern "C" void kernel_launch(void* const* d_in, const int* in_sizes, int n_in, void* d_out, int out_size, void* d_ws, size_t ws_size, hipStream_t stream) {
    static int grid = 0;
    if (grid == 0) {
        if (n_in != 29 || out_size != MLAT * DM || ws_size < WS_END) { fprintf(stderr, "kernel_launch: unexpected shapes (n_in %d out %d ws %zu)\n", n_in, out_size, ws_size); grid = -1; return; }
        int dev = 0, cus = 0, per_cu = 0;
        if (hipGetDevice(&dev) != hipSuccess || hipDeviceGetAttribute(&cus, hipDeviceAttributeMultiprocessorCount, dev) != hipSuccess) { grid = -1; return; }
        if (hipFuncSetAttribute((const void*)fwd_kernel, hipFuncAttributeMaxDynamicSharedMemorySize, LDS_BYTES) != hipSuccess) { fprintf(stderr, "kernel_launch: hipFuncSetAttribute failed\n"); grid = -1; return; }
        if (hipOccupancyMaxActiveBlocksPerMultiprocessor(&per_cu, (const void*)fwd_kernel, NTHR, LDS_BYTES) != hipSuccess || per_cu < 1) { fprintf(stderr, "kernel_launch: occupancy query says %d blocks per CU\n", per_cu); (void)hipGetLastError(); grid = -1; return; }
        grid = cus;
    }
    if (grid < 0) return;
    Args a{};
    for (int i = 0; i < 29; ++i) a.in[i] = (const float*)d_in[i];
    a.out = (float*)d_out; a.ws = (unsigned char*)d_ws;
#if N_LAUNCH_MODE == 0
    for (int p = 0; p < NPHASE; ++p) { a.ph_lo = p; a.ph_hi = p + 1; hipLaunchKernelGGL(fwd_kernel, dim3(grid), dim3(NTHR), LDS_BYTES, stream, a); }
#else
    a.ph_lo = 0; a.ph_hi = NPHASE;
    if (hipMemsetAsync((char*)d_ws + WS_CTL, 0, CTL_ZERO_BYTES, stream) != hipSuccess) { fprintf(stderr, "kernel_launch: memset of the control words failed\n"); return; }
    hipLaunchKernelGGL(fwd_kernel, dim3(grid), dim3(NTHR), LDS_BYTES, stream, a);
#endif
}
```

```cpp
#include <hip/hip_runtime.h>
#include <hip/hip_cooperative_groups.h>
#include <cstdio>
#include <cstdint>
#include <cmath>
namespace cg = cooperative_groups;
namespace pg8 {
#define PG8_LAS __attribute__((address_space(3)))
typedef unsigned short bf16_t;
typedef short bf16x8 __attribute__((ext_vector_type(8)));
typedef float f32x4 __attribute__((ext_vector_type(4)));
typedef unsigned u32x4 __attribute__((ext_vector_type(4)));
constexpr int BM = 256, BK = 64, HALF = 128, HTB = HALF * BK * 2  , STAGE_BYTES = 8 * HTB, NXCD = 8, WGM = 8;

__host__ __device__ __forceinline__ int lds_byte(int r, int c) { const int st = (r >> 4) * 2 + (c >> 5), rr = r & 15, cc = c & 31, ob = rr * 64 + cc * 2; return st * 1024 + (ob ^ (((ob >> 9) & 1) << 5)); }
__host__ __device__ __forceinline__ void stage_rc(int b, int& R, int& C) { const int st = b / 1024, sb = b % 1024, swz = sb ^ (((sb >> 9) & 1) << 5); R = (st >> 1) * 16 + swz / 64; C = (st & 1) * 32 + (swz % 64) / 2; }
__host__ __device__ __forceinline__ int perm32(int rho) { const int n = rho >> 4, i = rho & 15; return 8 * (i >> 2) + 4 * n + (i & 3); }

struct Unit { int pm, pn; };
struct Gemm { const bf16_t* A; const bf16_t* Bt; int M, N, K; };

struct StaticOrder {
    int nM, nN, nwg, G, c;
    __host__ __device__ void init(int M, int N, int G_, int c_) { nM = M / BM; nN = N / BM; nwg = nM * nN; G = G_; c = c_; }
    __host__ __device__ bool next(int i, Unit& u) const {
        const long L = (long)i * G + c; if (L >= nwg) return false;
        int wgid = (int)L; { const int q = nwg / NXCD, r = nwg % NXCD, xcd = wgid % NXCD, off = wgid / NXCD; wgid = (xcd < r ? xcd * (q + 1) : r * (q + 1) + (xcd - r) * q) + off; }
        const int nig = WGM * nN, gid = wgid / nig, fm = gid * WGM, gsz = (nM - fm) < WGM ? (nM - fm) : WGM;
        u.pm = fm + ((wgid % nig) % gsz); u.pn = (wgid % nig) / gsz; return true;
    }
    __device__ __forceinline__ void a_ready(const Unit&) const {}
    __device__ __forceinline__ void done(const Unit&) const {}
};


__device__ __forceinline__ unsigned cvt_pk_bf16(float lo, float hi) { unsigned r; asm volatile("v_cvt_pk_bf16_f32 %0, %1, %2" : "=v"(r) : "v"(lo), "v"(hi)); return r; }

template <int ACT> struct EpiBf16 {
    static constexpr bool PERM = true, AFTER_DRAIN = false;
    bf16_t* O; int ldc;
    __device__ __forceinline__ void operator()(const f32x4 (&acc)[2][2][4][2], const Unit& u, int wr, int wc, int fr, int fq) const {
        const int row0 = u.pm * BM + wr * 64 + fr; const int col0 = u.pn * BM + wc * 32 + 8 * fq;
#pragma unroll
        for (int ai = 0; ai < 2; ++ai)
#pragma unroll
            for (int m = 0; m < 4; ++m) { bf16_t* rowp = O + (size_t)(row0 + ai * HALF + m * 16) * ldc + col0;
#pragma unroll
                for (int bj = 0; bj < 2; ++bj) { f32x4 v0 = acc[ai][bj][m][0], v1 = acc[ai][bj][m][1];
                    if (ACT == 1) {
#pragma unroll
                        for (int q = 0; q < 4; ++q) { const float a0 = fmaxf(v0[q], 0.f), a1 = fmaxf(v1[q], 0.f); v0[q] = a0 * a0; v1[q] = a1 * a1; } }
                    u32x4 w; w.x = cvt_pk_bf16(v0[0], v0[1]); w.y = cvt_pk_bf16(v0[2], v0[3]); w.z = cvt_pk_bf16(v1[0], v1[1]); w.w = cvt_pk_bf16(v1[2], v1[3]);
                    *(u32x4*)(rowp + bj * HALF) = w; } }
    }
};
struct EpiResid {
    static constexpr bool PERM = false, AFTER_DRAIN = false;
    const float* base; float* out; int ldc; const float* gate; int rows_per_gate; int gate_stride;
    __device__ __forceinline__ void operator()(const f32x4 (&acc)[2][2][4][2], const Unit& u, int wr, int wc, int fr, int fq) const {
        const int row0 = u.pm * BM + wr * 64 + fr, col0 = u.pn * BM + wc * 32 + 4 * fq;
        const float* gp = gate + (size_t)((u.pm * BM) / rows_per_gate) * gate_stride + col0;
        f32x4 gv[2][2];
#pragma unroll
        for (int bj = 0; bj < 2; ++bj)
#pragma unroll
            for (int n = 0; n < 2; ++n) gv[bj][n] = *(const f32x4*)(gp + bj * HALF + n * 16);
#pragma unroll
        for (int ai = 0; ai < 2; ++ai)
#pragma unroll
            for (int m = 0; m < 4; ++m) { const size_t off = (size_t)(row0 + ai * HALF + m * 16) * ldc + col0;
#pragma unroll
                for (int bj = 0; bj < 2; ++bj)
#pragma unroll
                    for (int n = 0; n < 2; ++n) { const f32x4 bs = *(const f32x4*)(base + off + bj * HALF + n * 16);
                        *(f32x4*)(out + off + bj * HALF + n * 16) = bs + gv[bj][n] * acc[ai][bj][m][n]; } }
    }
};

struct EpiResidH2 {
    static constexpr bool PERM = false, AFTER_DRAIN = false;
    const float* base; float* out; int ldc; const float* gate; const float* sc; const float* nm; int rows_per_gate; int gate_stride; bf16_t* h2; float* ssq;
    __device__ __forceinline__ void operator()(const f32x4 (&acc)[2][2][4][2], const Unit& u, int wr, int wc, int fr, int fq) const {
        const int row0 = u.pm * BM + wr * 64 + fr, col0 = u.pn * BM + wc * 32 + 4 * fq;
        const size_t gofs = (size_t)((u.pm * BM) / rows_per_gate) * gate_stride + col0;
        f32x4 gv[2][2], cv[2][2];
#pragma unroll
        for (int bj = 0; bj < 2; ++bj)
#pragma unroll
            for (int n = 0; n < 2; ++n) { gv[bj][n] = *(const f32x4*)(gate + gofs + bj * HALF + n * 16);
                cv[bj][n] = *(const f32x4*)(nm + col0 + bj * HALF + n * 16) * (*(const f32x4*)(sc + gofs + bj * HALF + n * 16) + 1.0f); }
#pragma unroll
        for (int ai = 0; ai < 2; ++ai)
#pragma unroll
            for (int m = 0; m < 4; ++m) { const int row = row0 + ai * HALF + m * 16; const size_t off = (size_t)row * ldc + col0; float ss = 0.f;
#pragma unroll
                for (int bj = 0; bj < 2; ++bj)
#pragma unroll
                    for (int n = 0; n < 2; ++n) { const f32x4 bs = *(const f32x4*)(base + off + bj * HALF + n * 16); const f32x4 x1 = bs + gv[bj][n] * acc[ai][bj][m][n];
                        ss += (x1.x * x1.x + x1.y * x1.y) + (x1.z * x1.z + x1.w * x1.w);
                        const f32x4 hv = x1 * cv[bj][n]; unsigned long long w = (unsigned long long)cvt_pk_bf16(hv.x, hv.y) | ((unsigned long long)cvt_pk_bf16(hv.z, hv.w) << 32);
                        *(unsigned long long*)(h2 + off + bj * HALF + n * 16) = w; }
                ss += __shfl_xor(ss, 16); ss += __shfl_xor(ss, 32);
                if (fq == 0) ssq[(size_t)row * 16 + u.pn * 4 + wc] = ss; }
    }
};
struct EpiResidFromH2 {
    static constexpr bool PERM = false, AFTER_DRAIN = false;
    const bf16_t* h2; float* out; int ldc; const float* gate; const float* sc; const float* nm; int rows_per_gate; int gate_stride;
    __device__ __forceinline__ void operator()(const f32x4 (&acc)[2][2][4][2], const Unit& u, int wr, int wc, int fr, int fq) const {
        const int row0 = u.pm * BM + wr * 64 + fr, col0 = u.pn * BM + wc * 32 + 4 * fq;
        const size_t gofs = (size_t)((u.pm * BM) / rows_per_gate) * gate_stride + col0;
        f32x4 gv[2][2], ci[2][2];
#pragma unroll
        for (int bj = 0; bj < 2; ++bj)
#pragma unroll
            for (int n = 0; n < 2; ++n) { gv[bj][n] = *(const f32x4*)(gate + gofs + bj * HALF + n * 16);
                const f32x4 cs = *(const f32x4*)(nm + col0 + bj * HALF + n * 16) * (*(const f32x4*)(sc + gofs + bj * HALF + n * 16) + 1.0f);
                ci[bj][n] = (f32x4){1.0f / cs.x, 1.0f / cs.y, 1.0f / cs.z, 1.0f / cs.w}; }
#pragma unroll
        for (int ai = 0; ai < 2; ++ai)
#pragma unroll
            for (int m = 0; m < 4; ++m) { const size_t off = (size_t)(row0 + ai * HALF + m * 16) * ldc + col0;
#pragma unroll
                for (int bj = 0; bj < 2; ++bj)
#pragma unroll
                    for (int n = 0; n < 2; ++n) { const unsigned long long hw = *(const unsigned long long*)(h2 + off + bj * HALF + n * 16);
                        const unsigned lo = (unsigned)hw, hi = (unsigned)(hw >> 32);
                        const f32x4 hv = {__builtin_bit_cast(float, lo << 16), __builtin_bit_cast(float, lo & 0xffff0000u), __builtin_bit_cast(float, hi << 16), __builtin_bit_cast(float, hi & 0xffff0000u)};
                        *(f32x4*)(out + off + bj * HALF + n * 16) = hv * ci[bj][n] + gv[bj][n] * acc[ai][bj][m][n]; } }
    }
};
struct EpiSqReluRstd {
    static constexpr bool PERM = true, AFTER_DRAIN = false;
    bf16_t* O; int ldc; const float* ssq; const float* bias; int rows_per_bias; int bias_stride; float inv_k, eps;
    __device__ __forceinline__ void operator()(const f32x4 (&acc)[2][2][4][2], const Unit& u, int wr, int wc, int fr, int fq) const {
        const int row0 = u.pm * BM + wr * 64 + fr; const int col0 = u.pn * BM + wc * 32 + 8 * fq;
        const float* bp = bias + (size_t)((u.pm * BM) / rows_per_bias) * bias_stride + col0;
        f32x4 bv[2][2];
#pragma unroll
        for (int bj = 0; bj < 2; ++bj)
#pragma unroll
            for (int n = 0; n < 2; ++n) bv[bj][n] = *(const f32x4*)(bp + bj * HALF + 4 * n);
#pragma unroll
        for (int ai = 0; ai < 2; ++ai)
#pragma unroll
            for (int m = 0; m < 4; ++m) { const int row = row0 + ai * HALF + m * 16; const f32x4* sp = (const f32x4*)(ssq + (size_t)row * 16);
                const f32x4 s0 = sp[0], s1 = sp[1], s2 = sp[2], s3 = sp[3];
                const float tot = ((s0.x + s0.y) + (s0.z + s0.w)) + ((s1.x + s1.y) + (s1.z + s1.w)) + ((s2.x + s2.y) + (s2.z + s2.w)) + ((s3.x + s3.y) + (s3.z + s3.w));
                const float rstd = rsqrtf(tot * inv_k + eps);
                bf16_t* rowp = O + (size_t)row * ldc + col0;
#pragma unroll
                for (int bj = 0; bj < 2; ++bj) { f32x4 v0 = acc[ai][bj][m][0] * rstd + bv[bj][0], v1 = acc[ai][bj][m][1] * rstd + bv[bj][1];
#pragma unroll
                    for (int q = 0; q < 4; ++q) { const float a0 = fmaxf(v0[q], 0.f), a1 = fmaxf(v1[q], 0.f); v0[q] = a0 * a0; v1[q] = a1 * a1; }
                    u32x4 w; w.x = cvt_pk_bf16(v0[0], v0[1]); w.y = cvt_pk_bf16(v0[2], v0[3]); w.z = cvt_pk_bf16(v1[0], v1[1]); w.w = cvt_pk_bf16(v1[2], v1[3]);
                    *(u32x4*)(rowp + bj * HALF) = w; } }
    }
};

template <class Epi, class Sched, bool ALIGN_EPI = false, bool SP2 = false>
__device__ __forceinline__ void gemm_phase(PG8_LAS unsigned char* lds, const Gemm g, const Sched& S, const Epi& E) {
    const int tid = threadIdx.x, wid = __builtin_amdgcn_readfirstlane(tid >> 6), lane = tid & 63, wr = wid >> 2, wc = wid & 3, fr = lane & 15, fq = lane >> 4;
    const int K = g.K, nt = K / BK;
    unsigned voffA[2], voffB[2];
#pragma unroll
    for (int i = 0; i < 2; ++i) { int R, C; stage_rc(tid * 16 + i * 8192, R, C); const int Rb = Epi::PERM ? ((R & ~31) + perm32(R & 31)) : R;
        voffA[i] = (unsigned)(R * K + C) * 2u; voffB[i] = (unsigned)(Rb * K + C) * 2u; }
    const size_t kstep = (size_t)(BK * 2);
    const size_t hstep = (size_t)HALF * K * 2;
    const size_t tstep = 2 * hstep;
    const unsigned ldsw = (unsigned)wid * 1024u;
    const int aoff = lds_byte(wr * 64 + fr, fq * 8), boff = lds_byte(wc * 32 + fr, fq * 8);
#define PG8_SA(b, h) (((b) * 2 + (h)) * HTB)
#define PG8_SB(b, h) ((4 + (b) * 2 + (h)) * HTB)
#define PG8_STAGE(bufoff, gbase, voff) do { _Pragma("unroll") for (int _i = 0; _i < 2; ++_i) \
        __builtin_amdgcn_global_load_lds((const unsigned*)((const char*)(gbase) + (voff)[_i]), (PG8_LAS unsigned*)(lds + (bufoff) + ldsw + _i * 8192), 16, 0, 0); } while (0)
#define PG8_LDA(dst, b, h) do { _Pragma("unroll") for (int m = 0; m < 4; ++m) _Pragma("unroll") for (int k = 0; k < 2; ++k) dst[m][k] = *(const PG8_LAS bf16x8*)(lds + PG8_SA(b, h) + aoff + m * 2048 + k * 1024); } while (0)
#define PG8_LDB(dst, b, h) do { _Pragma("unroll") for (int n = 0; n < 2; ++n) _Pragma("unroll") for (int k = 0; k < 2; ++k) dst[n][k] = *(const PG8_LAS bf16x8*)(lds + PG8_SB(b, h) + boff + n * 2048 + k * 1024); } while (0)
#define PG8_MMA(ai, bj, At, Bt) do { __builtin_amdgcn_s_setprio(1); _Pragma("unroll") for (int m = 0; m < 4; ++m) _Pragma("unroll") for (int n = 0; n < 2; ++n) _Pragma("unroll") for (int k = 0; k < 2; ++k) \
        acc[ai][bj][m][n] = __builtin_amdgcn_mfma_f32_16x16x32_bf16(Bt[n][k], At[m][k], acc[ai][bj][m][n], 0, 0, 0); __builtin_amdgcn_s_setprio(0); } while (0)
#define PG8_WAIT_V(n) asm volatile("s_waitcnt vmcnt(" #n ")" ::: "memory")
#define PG8_WAIT_L(n) asm volatile("s_waitcnt lgkmcnt(" #n ")" ::: "memory")
#define PG8_BAR __builtin_amdgcn_s_barrier()
#define PG8_SCHED __builtin_amdgcn_sched_barrier(0)
    Unit cur, nxt; int ui = 0;
    if (!S.next(0, cur)) return;
    f32x4 acc[2][2][4][2];
#pragma unroll
    for (int a = 0; a < 2; ++a)
#pragma unroll
        for (int b = 0; b < 2; ++b)
#pragma unroll
            for (int m = 0; m < 4; ++m)
#pragma unroll
                for (int n = 0; n < 2; ++n) acc[a][b][m][n] = (f32x4){0.f, 0.f, 0.f, 0.f};
    bf16x8 At[4][2], B0[2][2], B1[2][2];
    const char* cA = (const char*)g.A + (size_t)cur.pm * tstep; const char* cB = (const char*)g.Bt + (size_t)cur.pn * tstep;
    S.a_ready(cur);
    if constexpr (SP2) {
        PG8_STAGE(PG8_SB(0, 0), cB, voffB); PG8_STAGE(PG8_SB(0, 1), cB + hstep, voffB); PG8_STAGE(PG8_SA(0, 0), cA, voffA); PG8_STAGE(PG8_SA(0, 1), cA + hstep, voffA);
        if (wr == 1) PG8_BAR;
        PG8_WAIT_V(2); PG8_BAR;
        PG8_STAGE(PG8_SB(1, 0), cB + kstep, voffB); PG8_STAGE(PG8_SA(1, 0), cA + kstep, voffA); PG8_STAGE(PG8_SB(1, 1), cB + hstep + kstep, voffB);
        PG8_WAIT_V(6); PG8_BAR;
    } else {
        PG8_STAGE(PG8_SB(0, 0), cB, voffB); PG8_STAGE(PG8_SA(0, 0), cA, voffA); PG8_STAGE(PG8_SB(0, 1), cB + hstep, voffB); PG8_STAGE(PG8_SA(0, 1), cA + hstep, voffA);
        if (wr == 1) PG8_BAR;
        PG8_WAIT_V(4); PG8_BAR;
        PG8_STAGE(PG8_SB(1, 0), cB + kstep, voffB); PG8_STAGE(PG8_SA(1, 0), cA + kstep, voffA); PG8_STAGE(PG8_SB(1, 1), cB + hstep + kstep, voffB);
        PG8_WAIT_V(6); PG8_BAR;
    }
    for (;;) {
        const bool has_next = S.next(ui + 1, nxt);
        const char* nA = has_next ? (const char*)g.A + (size_t)nxt.pm * tstep : cA; const char* nB = has_next ? (const char*)g.Bt + (size_t)nxt.pn * tstep : cB;
        for (int t = 0; t < nt; t += 2) {
            const bool last = (t == nt - 2);
            const char* a1 = cA + (size_t)(t + 1) * kstep;
            const char* a2 = last ? nA : cA + (size_t)(t + 2) * kstep; const char* b2 = last ? nB : cB + (size_t)(t + 2) * kstep;
            const char* a3 = a2 + kstep; const char* b3 = b2 + kstep;
            if (last && has_next) S.a_ready(nxt);
            if constexpr (SP2) {
            PG8_LDB(B0, 0, 0); PG8_LDB(B1, 0, 1); PG8_SCHED; PG8_LDA(At, 0, 0); PG8_STAGE(PG8_SA(1, 1), a1 + hstep, voffA);
            PG8_WAIT_V(8); PG8_WAIT_L(0); PG8_BAR; PG8_MMA(0, 0, At, B0); PG8_MMA(0, 1, At, B1); PG8_BAR; PG8_SCHED;
            PG8_LDA(At, 0, 1); PG8_STAGE(PG8_SB(0, 0), b2, voffB); PG8_STAGE(PG8_SB(0, 1), b2 + hstep, voffB); PG8_STAGE(PG8_SA(0, 0), a2, voffA);
            PG8_WAIT_V(8); PG8_WAIT_L(0); PG8_BAR; PG8_MMA(1, 0, At, B0); PG8_MMA(1, 1, At, B1); PG8_BAR; PG8_SCHED;
            PG8_LDB(B0, 1, 0); PG8_LDB(B1, 1, 1); PG8_SCHED; PG8_LDA(At, 1, 0); PG8_STAGE(PG8_SA(0, 1), a2 + hstep, voffA);
            PG8_WAIT_V(8); PG8_WAIT_L(0); PG8_BAR; PG8_MMA(0, 0, At, B0); PG8_MMA(0, 1, At, B1); PG8_BAR; PG8_SCHED;
            PG8_LDA(At, 1, 1); PG8_STAGE(PG8_SB(1, 0), b3, voffB); PG8_STAGE(PG8_SB(1, 1), b3 + hstep, voffB); PG8_STAGE(PG8_SA(1, 0), a3, voffA);
            PG8_WAIT_V(8); PG8_WAIT_L(0); PG8_BAR; PG8_MMA(1, 0, At, B0); PG8_MMA(1, 1, At, B1); PG8_BAR; PG8_SCHED;
            } else {
            PG8_LDB(B0, 0, 0); PG8_SCHED; PG8_LDA(At, 0, 0); PG8_STAGE(PG8_SA(1, 1), a1 + hstep, voffA);
            PG8_WAIT_L(8); PG8_BAR; PG8_WAIT_L(0); PG8_MMA(0, 0, At, B0); PG8_BAR; PG8_SCHED;
            PG8_LDB(B1, 0, 1); PG8_STAGE(PG8_SB(0, 0), b2, voffB);
            PG8_BAR; PG8_WAIT_L(0); PG8_MMA(0, 1, At, B1); PG8_BAR;
            PG8_LDA(At, 0, 1); PG8_STAGE(PG8_SA(0, 0), a2, voffA);
            PG8_BAR; PG8_WAIT_L(0); PG8_MMA(1, 0, At, B0); PG8_BAR; PG8_SCHED;
            PG8_STAGE(PG8_SB(0, 1), b2 + hstep, voffB);
            PG8_WAIT_V(6); PG8_BAR; PG8_MMA(1, 1, At, B1); PG8_BAR;
            PG8_LDB(B0, 1, 0); PG8_SCHED; PG8_LDA(At, 1, 0); PG8_STAGE(PG8_SA(0, 1), a2 + hstep, voffA);
            PG8_WAIT_L(8); PG8_BAR; PG8_WAIT_L(0); PG8_MMA(0, 0, At, B0); PG8_BAR; PG8_SCHED;
            PG8_LDB(B1, 1, 1); PG8_STAGE(PG8_SB(1, 0), b3, voffB);
            PG8_BAR; PG8_WAIT_L(0); PG8_MMA(0, 1, At, B1); PG8_BAR;
            PG8_LDA(At, 1, 1); PG8_STAGE(PG8_SA(1, 0), a3, voffA);
            PG8_BAR; PG8_WAIT_L(0); PG8_MMA(1, 0, At, B0); PG8_BAR; PG8_SCHED;
            PG8_STAGE(PG8_SB(1, 1), b3 + hstep, voffB);
            PG8_WAIT_V(6); PG8_BAR; PG8_MMA(1, 1, At, B1); PG8_BAR;
            }
        }
        if constexpr (ALIGN_EPI) { if (wr == 0) PG8_BAR; }
        if constexpr (!Epi::AFTER_DRAIN) { E(acc, cur, wr, wc, fr, fq); S.done(cur); }
        if (!has_next) break;
#pragma unroll
        for (int a = 0; a < 2; ++a)
#pragma unroll
            for (int b = 0; b < 2; ++b)
#pragma unroll
                for (int m = 0; m < 4; ++m)
#pragma unroll
                    for (int n = 0; n < 2; ++n) acc[a][b][m][n] = (f32x4){0.f, 0.f, 0.f, 0.f};
        cur = nxt; cA = nA; cB = nB; ++ui;
        if constexpr (ALIGN_EPI) { if (wr == 1) PG8_BAR; }
    }
    PG8_WAIT_V(0);
    if constexpr (!ALIGN_EPI) { if (wr == 0) PG8_BAR; }
    PG8_BAR;
    if constexpr (Epi::AFTER_DRAIN) { E.fused(acc, cur, wr, wc, fr, fq, lds, wid, lane); S.done(cur); }
#undef PG8_SA
#undef PG8_SB
#undef PG8_STAGE
#undef PG8_LDA
#undef PG8_LDB
#undef PG8_MMA
#undef PG8_WAIT_V
#undef PG8_WAIT_L
#undef PG8_BAR
#undef PG8_SCHED
}
}

constexpr int NB = 8, SEQ = 4096, DM = 1024, CTXL = 256;
constexpr int MLAT = NB * SEQ, MCTX = NB * CTXL, MALL = MLAT + MCTX;
constexpr int DH = 512, NHY = 1536, NGL = 1792, NINP = NHY + NGL, NIN = 3104, FF = 4096;
constexpr int GQ = 0, GK = 256, GV = 512, GOG = 1024, GGF = 1536;
constexpr int NSIG = 68, NITEM = NB * 4 * 2 * NSIG;
constexpr float EPSF = 1e-6f;
constexpr int MOD_SH1 = 0, MOD_SC1 = 1024, MOD_G1 = 2048, MOD_SH2 = 3072, MOD_SC2 = 4096, MOD_G2 = 5120, MODW = 6144;

constexpr size_t MiB = 1u << 20;
constexpr size_t WS_CTL = 0, WS_MOD = 1 * MiB, WS_SSQ = 2 * MiB, WS_WIN = 4 * MiB, WS_WOUT = 11 * MiB, WS_W1 = 13 * MiB, WS_W2 = 21 * MiB;
constexpr size_t WS_KRAW = 30 * MiB, WS_DEC = 46 * MiB, WS_XN = 48 * MiB  , WS_HYT = 116 * MiB, WS_GPROJ = 212 * MiB;
constexpr size_t WS_YT = 331 * MiB, WS_YCAT = 363 * MiB, WS_HID = 116 * MiB  , WS_SSQ2 = 427 * MiB  , WS_BIAS2 = 430 * MiB  , WS_END = 431 * MiB;
static_assert(WS_WIN + (size_t)NINP * DM * 2 <= WS_WOUT && WS_W2 + (size_t)DM * FF * 2 <= WS_KRAW && WS_KRAW + (size_t)DH * 8192 * 4 <= WS_DEC, "ws map 1");
static_assert(WS_DEC + (size_t)NITEM * 64 * 4 <= WS_XN && WS_XN + (size_t)MALL * DM * 2 <= WS_HYT && WS_XN + (size_t)NITEM * 8192 * 2 <= WS_HYT, "ws map 2");
static_assert(WS_HYT + (size_t)NHY * MLAT * 2 <= WS_GPROJ && WS_GPROJ + (size_t)MALL * NGL * 2 <= WS_YT && WS_YT + (size_t)DH * MLAT * 2 <= WS_YCAT, "ws map 3");
static_assert(WS_HID + (size_t)MLAT * FF * 2 <= WS_YCAT + (size_t)MLAT * DM * 2 && WS_YCAT + (size_t)MLAT * DM * 2 <= WS_SSQ2 && WS_SSQ2 + (size_t)MLAT * 64 <= WS_BIAS2 && WS_BIAS2 + (size_t)NB * FF * 4 <= WS_END, "ws map 4");

#define PROBE_REPEAT 0
#define PROBE_TS (-1)
#define STAMP(k) do { if (PROBE_TS >= 0) { const unsigned long long t__ = __builtin_amdgcn_s_memrealtime(); if (blockIdx.x == 0 && threadIdx.x == 0) ((unsigned long long*)(a.ws + 32768))[k] += t__ - tp_; tp_ = t__; } } while (0)
constexpr int NTHR = 512, NWAVES = 8;
constexpr int LDS_BYTES = 147456;
constexpr int MISC_OFF = LDS_BYTES - 256;
constexpr int CW_BAR = 4096, CTL_ZERO_BYTES = 65536;

#define LAS __attribute__((address_space(3)))
typedef unsigned short bf16;
typedef unsigned v4u __attribute__((ext_vector_type(4)));
typedef unsigned v2u __attribute__((ext_vector_type(2)));
typedef float f32x4 __attribute__((ext_vector_type(4)));
#define LDS_WAIT() asm volatile("s_waitcnt lgkmcnt(0)" ::: "memory")

__device__ __forceinline__ unsigned f2bf(float f) { unsigned u = __builtin_bit_cast(unsigned, f); return (u + 0x7fffu + ((u >> 16) & 1u)) >> 16; }
__device__ __forceinline__ unsigned pk2(float lo, float hi) { return f2bf(lo) | (f2bf(hi) << 16); }
__device__ __forceinline__ float bf2f(unsigned h) { return __builtin_bit_cast(float, h << 16); }
template <int CTRL> __device__ __forceinline__ float dpp_f(float v) { return __builtin_bit_cast(float, __builtin_amdgcn_mov_dpp(__builtin_bit_cast(int, v), CTRL, 0xF, 0xF, true)); }
__device__ __forceinline__ float row16_sum(float v) {
    v += dpp_f<0xB1>(v); v += dpp_f<0x4E>(v); v += dpp_f<0x141>(v); v += dpp_f<0x140>(v); return v;
}
__device__ __forceinline__ float wave_sum(float v) {
    v = row16_sum(v);
    const int iv = __builtin_bit_cast(int, v);
    const float s0 = __builtin_bit_cast(float, __builtin_amdgcn_readlane(iv, 0)), s1 = __builtin_bit_cast(float, __builtin_amdgcn_readlane(iv, 16));
    const float s2 = __builtin_bit_cast(float, __builtin_amdgcn_readlane(iv, 32)), s3 = __builtin_bit_cast(float, __builtin_amdgcn_readlane(iv, 48));
    return (s0 + s1) + (s2 + s3);
}
__device__ __forceinline__ float siluf(float v) { return v / (1.f + __expf(-v)); }
__device__ __forceinline__ float logsigmoidf(float a) { return fminf(a, 0.f) - log1pf(__expf(-fabsf(a))); }

struct Args { const float* in[29]; float* out; unsigned char* ws; int ph_lo, ph_hi; };

enum { I_X = 0, I_C, I_CTX, I_CCTX, I_WADA, I_BADA, I_NMIX, I_NMLP, I_WIN, I_CONVW, I_CONVB, I_FW1, I_FB1, I_FW2, I_FB2, I_FW3, I_FB3, I_FFREQ, I_FWOUT,
       I_HBIAS, I_GKWF, I_GKBF, I_GKWB, I_GKBB, I_GLAN, I_WOUT, I_WM1, I_WM2, I_NFIN };

__device__ __forceinline__ void p0_transpose_item(const float* W, int K, int N, bf16* WT, int row_off, float* scr, int item, int lane) {
    const int nblk = N / 32, kb = item / nblk, nb = item % nblk, k0 = 64 * kb, n0 = 32 * nb;
    float wv[32];
#pragma unroll
    for (int i = 0; i < 32; ++i) { const int kk = 2 * i + (lane >> 5); wv[i] = W[(size_t)(k0 + kk) * N + n0 + (lane & 31)]; }
#pragma unroll
    for (int i = 0; i < 32; ++i) { const int kk = 2 * i + (lane >> 5); scr[kk * 33 + (lane & 31)] = wv[i]; }
    LDS_WAIT(); asm volatile("" ::: "memory");
    const int c = lane & 7;
#pragma unroll
    for (int j = 0; j < 4; ++j) { const int n = (lane >> 3) + 8 * j; const float* s = scr + (8 * c) * 33 + n;
        v4u o; o.x = pk2(s[0 * 33], s[1 * 33]); o.y = pk2(s[2 * 33], s[3 * 33]); o.z = pk2(s[4 * 33], s[5 * 33]); o.w = pk2(s[6 * 33], s[7 * 33]);
        *(v4u*)(WT + (size_t)(row_off + n0 + n) * K + k0 + 8 * c) = o; }
    LDS_WAIT(); asm volatile("" ::: "memory");
}

__device__ __forceinline__ void p0_filter(const Args& a, unsigned char* lds) {
    float* zb = (float*)lds;
    float* h1 = zb + 17 * 33 + 3;
    float* h2 = h1 + 17 * 64;
    float* hT = h2 + 17 * 64;
    const int tid = threadIdx.x;
    float* Kraw = (float*)(a.ws + WS_KRAW); float* SSQ = (float*)(a.ws + WS_SSQ);
    const float* w1 = a.in[I_FW1]; const float* b1 = a.in[I_FB1]; const float* w2 = a.in[I_FW2]; const float* b2 = a.in[I_FB2];
    const float* w3 = a.in[I_FW3]; const float* b3 = a.in[I_FB3]; const float* fr = a.in[I_FFREQ]; const float* wo = a.in[I_FWOUT];
    for (int pg = blockIdx.x; pg < 256; pg += gridDim.x) {
        const int p0 = pg * 16;
        for (int i = tid; i < 17 * 33; i += NTHR) { const int pp = i / 33, j = i % 33; const int p = p0 + pp; float val;
            if (j == 0) val = (float)p * (1.0f / 4095.0f);
            else { const int bi = (j - 1) & 15; const float f = 1e-4f + (float)bi * ((15.0f - 1e-4f) / 15.0f); const float w = 6.283185307179586f * (float)p / 4096.0f; const float ang = w * f;
                   val = (j <= 16) ? cosf(ang) : -sinf(ang); }
            zb[i] = val; }
        __syncthreads();
        for (int i = tid; i < 17 * 64; i += NTHR) { const int pp = i >> 6, j = i & 63; float acc = b1[j];
            for (int k = 0; k < 33; ++k) acc += zb[pp * 33 + k] * w1[k * 64 + j];
            h1[i] = sinf(fr[j] * acc); }
        __syncthreads();
        for (int i = tid; i < 17 * 64; i += NTHR) { const int pp = i >> 6, j = i & 63; float acc = b2[j];
#pragma unroll 16
            for (int k = 0; k < 64; ++k) acc += h1[pp * 64 + k] * w2[k * 64 + j];
            h2[i] = sinf(fr[j] * acc); }
        __syncthreads();
        for (int i = tid; i < 17 * 64; i += NTHR) { const int pp = i >> 6, j = i & 63; float acc = b3[j];
#pragma unroll 16
            for (int k = 0; k < 64; ++k) acc += h2[pp * 64 + k] * w3[k * 64 + j];
            hT[j * 20 + pp] = sinf(fr[j] * acc); }
        __syncthreads();
        for (int dir = 0; dir < 2; ++dir) { const int c = tid, o = dir * 512 + c; float acc[17];
#pragma unroll
            for (int pp = 0; pp < 17; ++pp) acc[pp] = 0.f;
#pragma unroll 4
            for (int j = 0; j < 64; ++j) { const float w = wo[j * 1024 + o]; const f32x4* hp = (const f32x4*)(hT + j * 20);
                const f32x4 q0 = hp[0], q1 = hp[1], q2 = hp[2], q3 = hp[3]; const float q4 = hT[j * 20 + 16];
                acc[0] += q0.x * w; acc[1] += q0.y * w; acc[2] += q0.z * w; acc[3] += q0.w * w; acc[4] += q1.x * w; acc[5] += q1.y * w; acc[6] += q1.z * w; acc[7] += q1.w * w;
                acc[8] += q2.x * w; acc[9] += q2.y * w; acc[10] += q2.z * w; acc[11] += q2.w * w; acc[12] += q3.x * w; acc[13] += q3.y * w; acc[14] += q3.z * w; acc[15] += q3.w * w; acc[16] += q4 * w; }
            const float delta = 3.0701134573253945f + (float)c * ((15.350567286626972f - 3.0701134573253945f) / 511.0f); float ssq = 0.f; float val[17];
#pragma unroll
            for (int pp = 0; pp < 17; ++pp) { const int p = p0 + pp; const float tn = (float)p * (1.0f / 4095.0f); val[pp] = p <= 4095 ? acc[pp] * expf(-tn * delta) : 0.f; }
            if (dir == 0) {
#pragma unroll
                for (int pp = 0; pp < 16; ++pp) ssq += val[pp] * val[pp];
                f32x4* kp = (f32x4*)(Kraw + (size_t)c * 8192 + 4096 + p0);
#pragma unroll
                for (int v = 0; v < 4; ++v) kp[v] = (f32x4){val[4 * v], val[4 * v + 1], val[4 * v + 2], val[4 * v + 3]};
            } else {
#pragma unroll
                for (int pp = 1; pp < 17; ++pp) ssq += val[pp] * val[pp];
                f32x4* kp = (f32x4*)(Kraw + (size_t)c * 8192 + 4096 - p0 - 16);
#pragma unroll
                for (int v = 0; v < 4; ++v) kp[v] = (f32x4){val[16 - 4 * v], val[15 - 4 * v], val[14 - 4 * v], val[13 - 4 * v]};
            }
            SSQ[pg * 1024 + o] = ssq; }
        __syncthreads();
    }
}

__device__ __forceinline__ void p0_mod(const Args& a, unsigned char* lds) {
    float* sc = (float*)lds;
    float* red = sc + 9 * 1024;
    const int tid = threadIdx.x;
    if ((int)blockIdx.x >= 192) return;
    for (int i = tid; i < 9 * 1024; i += NTHR) { const float v = (i < 8192) ? a.in[I_C][i] : a.in[I_CCTX][i - 8192]; sc[i] = siluf(v); }
    __syncthreads();
    const float* wa = a.in[I_WADA]; const float* ba = a.in[I_BADA]; float* mod = (float*)(a.ws + WS_MOD);
    for (int it = blockIdx.x; it < 192; it += gridDim.x) {
        const int col = tid & 31, ks = tid >> 5, c0 = it * 32; float acc[9];
#pragma unroll
        for (int r = 0; r < 9; ++r) acc[r] = 0.f;
#pragma unroll
        for (int kb = 0; kb < 4; ++kb) { float wv[16];
#pragma unroll
            for (int kk = 0; kk < 16; ++kk) wv[kk] = wa[(size_t)(ks * 64 + kb * 16 + kk) * MODW + c0 + col];
#pragma unroll
            for (int kk = 0; kk < 16; ++kk) { const int k = ks * 64 + kb * 16 + kk;
#pragma unroll
                for (int r = 0; r < 9; ++r) acc[r] += sc[r * 1024 + k] * wv[kk]; } }
#pragma unroll
        for (int r = 0; r < 9; ++r) red[(ks * 9 + r) * 32 + col] = acc[r];
        __syncthreads();
        if (tid < 288) { const int r = tid >> 5, cc = tid & 31; float s = ba[c0 + cc];
            for (int k2 = 0; k2 < 16; ++k2) s += red[(k2 * 9 + r) * 32 + cc];
            mod[r * MODW + c0 + cc] = s; }
        __syncthreads();
    }
}

__device__ __forceinline__ void p0_prologue(const Args& a, unsigned char* lds) {
    const int tid = threadIdx.x, lane = tid & 63, wave = tid >> 6;
    p0_filter(a, lds);
    __syncthreads();
    p0_mod(a, lds);
    __syncthreads();
    { v4u* z = (v4u*)((bf16*)(a.ws + WS_WIN) + (size_t)NIN * DM); const int n16 = (NINP - NIN) * DM * 2 / 16;
      for (int i = blockIdx.x * NTHR + tid; i < n16; i += gridDim.x * NTHR) z[i] = (v4u){0u, 0u, 0u, 0u}; }
    float* scr = (float*)(lds + wave * 16384);
    const int gw = blockIdx.x * NWAVES + wave, NGW = gridDim.x * NWAVES;
    constexpr int I_IN = (DM / 64) * (NIN / 32), I_O = (DM / 64) * (DM / 32), I_1 = (DM / 64) * (FF / 32), I_2 = (FF / 64) * (DM / 32);
    constexpr int NITEMS = I_IN + I_O + I_1 + I_2;
    for (int it = gw; it < NITEMS; it += NGW) {
        int r = it;
        if (r < I_IN) { p0_transpose_item(a.in[I_WIN], DM, NIN, (bf16*)(a.ws + WS_WIN), 0, scr, r, lane); continue; } r -= I_IN;
        if (r < I_O) { p0_transpose_item(a.in[I_WOUT], DM, DM, (bf16*)(a.ws + WS_WOUT), 0, scr, r, lane); continue; } r -= I_O;
        if (r < I_1) { p0_transpose_item(a.in[I_WM1], DM, FF, (bf16*)(a.ws + WS_W1), 0, scr, r, lane); continue; } r -= I_1;
        p0_transpose_item(a.in[I_WM2], FF, DM, (bf16*)(a.ws + WS_W2), 0, scr, r, lane);
    }
}

__device__ __forceinline__ void norm_mod_rows(const Args& a, const float* src_lat, const float* src_ctx, int nrows, const float* g, int sc_off, int sh_off, bf16* dst) {
    const int tid = threadIdx.x, lane = tid & 63, wave = tid >> 6;
    const int gw = blockIdx.x * NWAVES + wave, NGW = gridDim.x * NWAVES;
    const float* mod = (const float*)(a.ws + WS_MOD);
    for (int row = gw; row < nrows; row += NGW) {
        const float* src = row < MLAT ? src_lat + (size_t)row * DM : src_ctx + (size_t)(row - MLAT) * DM;
        const int mrow = row < MLAT ? row / SEQ : 8;
        const f32x4* xr = (const f32x4*)src + lane;
        f32x4 v[4]; float s = 0.f;
#pragma unroll
        for (int j = 0; j < 4; ++j) { v[j] = xr[64 * j]; s += (v[j].x * v[j].x + v[j].y * v[j].y) + (v[j].z * v[j].z + v[j].w * v[j].w); }
        const float rstd = rsqrtf(wave_sum(s) * (1.f / DM) + EPSF);
        unsigned long long* o8 = (unsigned long long*)(dst + (size_t)row * DM) + lane;
#pragma unroll
        for (int j = 0; j < 4; ++j) { const int col = 256 * j + 4 * lane;
            const f32x4 gg = *(const f32x4*)(g + col), scv = *(const f32x4*)(mod + mrow * MODW + sc_off + col), shv = *(const f32x4*)(mod + mrow * MODW + sh_off + col);
            const f32x4 y = (v[j] * rstd * gg) * (scv + 1.f) + shv;
            o8[64 * j] = (unsigned long long)pk2(y.x, y.y) | ((unsigned long long)pk2(y.z, y.w) << 32); }
    }
}
__device__ __forceinline__ void final_norm_rows(const Args& a) {
    const int tid = threadIdx.x, lane = tid & 63, wave = tid >> 6;
    const int gw = blockIdx.x * NWAVES + wave, NGW = gridDim.x * NWAVES;
    const float* g = a.in[I_NFIN];
    for (int row = gw; row < MLAT; row += NGW) {
        f32x4* xr = (f32x4*)(a.out + (size_t)row * DM) + lane;
        f32x4 v[4]; float s = 0.f;
#pragma unroll
        for (int j = 0; j < 4; ++j) { v[j] = xr[64 * j]; s += (v[j].x * v[j].x + v[j].y * v[j].y) + (v[j].z * v[j].z + v[j].w * v[j].w); }
        const float rstd = rsqrtf(wave_sum(s) * (1.f / DM) + EPSF);
#pragma unroll
        for (int j = 0; j < 4; ++j) { const f32x4 gg = *(const f32x4*)(g + 256 * j + 4 * lane); xr[64 * j] = v[j] * rstd * gg; }
    }
}

typedef short gbf16x8 __attribute__((ext_vector_type(8)));
typedef float gf32x16 __attribute__((ext_vector_type(16)));
constexpr int GL_ROWB = 144;
constexpr int G2_GR = 0;
constexpr int G2_WG = G2_GR + 2 * 64 * 17 * 4;
constexpr int G2_BG = G2_WG + 2 * 4096;
constexpr int G2_TOT = G2_BG + 512;
constexpr int G2_BCT = G2_TOT + 512;
constexpr int G2_OB = 0;
constexpr int G2_RS = G2_OB + 64 * 132 * 4;
constexpr int G2_QI = G2_BCT + 2 * 64 * 65 * 4;
constexpr int G2_KI = G2_QI + 2 * 64 * GL_ROWB;
constexpr int G2_ATT = G2_KI + 2 * 64 * GL_ROWB;
constexpr int G2_VT = G2_ATT + 2 * 64 * GL_ROWB;
constexpr int G2_END = G2_VT + 128 * GL_ROWB;
static_assert(G2_END <= MISC_OFF && G2_RS + 256 <= G2_QI && G2_QI % 16 == 0, "GLA LDS map");

#define LBAR() asm volatile("s_waitcnt lgkmcnt(0)\n\ts_barrier" ::: "memory")
__device__ __forceinline__ gbf16x8 gl_frag(const LAS unsigned char* p) { return __builtin_bit_cast(gbf16x8, *(const LAS v4u*)p); }
__device__ __forceinline__ void unpack8(const v4u r, float* o) {
    o[0] = bf2f(r.x & 0xffffu); o[1] = bf2f(r.x >> 16); o[2] = bf2f(r.y & 0xffffu); o[3] = bf2f(r.y >> 16);
    o[4] = bf2f(r.z & 0xffffu); o[5] = bf2f(r.z >> 16); o[6] = bf2f(r.w & 0xffffu); o[7] = bf2f(r.w >> 16);
}
__device__ __forceinline__ size_t gla_item(int b, int h, int dir, int ck) {
    const int sig = ck < 4 ? (dir == 0 ? ck : 3 - ck) : (dir == 0 ? ck : 71 - ck);
    return (size_t)((b * 4 + h) * 2 + dir) * NSIG + sig;
}
__device__ __forceinline__ float logsig16(float a) { return (fminf(a, 0.f) - __logf(1.0f + __expf(-fabsf(a)))) * (1.0f / 16.0f); }
struct GateRegs { v2u gr; float wg[4]; float bg; };
__device__ __forceinline__ void gla_gate_loads(const Args& a, GateRegs& g, const bf16* gp, size_t row0, int h) {
    const int tid = threadIdx.x;
    g.gr = *(const v2u*)(gp + (row0 + (tid >> 3)) * NGL + GGF + (tid & 7) * 4);
#pragma unroll
    for (int i = 0; i < 4; ++i) { const int idx = tid + NTHR * i, rem = idx & 1023; const float* w = a.in[(i >> 1) ? I_GKWB : I_GKWF]; g.wg[i] = w[(rem >> 6) * 256 + h * 64 + (rem & 63)]; }
    g.bg = tid < 128 ? a.in[(tid >> 6) ? I_GKBB : I_GKBF][h * 64 + (tid & 63)] : 0.f;
}
__device__ __forceinline__ void gla_gates2(LAS unsigned char* L, const GateRegs& g) {
    const int tid = threadIdx.x;
    LAS float* GR = (LAS float*)(L + G2_GR); LAS float* WG = (LAS float*)(L + G2_WG); LAS float* BG = (LAS float*)(L + G2_BG); LAS float* TOT = (LAS float*)(L + G2_TOT); LAS float* BCT = (LAS float*)(L + G2_BCT);
    { const int tok = tid >> 3, j = tid & 7, dir = j >> 2, r0 = (j & 3) * 4; LAS float* p = GR + dir * (16 * 68) + r0 * 68 + tok;
      p[0] = bf2f(g.gr.x & 0xffffu); p[68] = bf2f(g.gr.x >> 16); p[136] = bf2f(g.gr.y & 0xffffu); p[204] = bf2f(g.gr.y >> 16); }
#pragma unroll
    for (int i = 0; i < 4; ++i) WG[tid + NTHR * i] = g.wg[i];
    if (tid < 128) BG[tid] = g.bg;
    LBAR();
    { const int tb = tid & 15, db = (tid >> 4) & 15, dir = tid >> 8;
      const f32x4 bgv = *(const LAS f32x4*)(BG + dir * 64 + 4 * db); float acc[4][4];
#pragma unroll
      for (int i = 0; i < 4; ++i) { acc[i][0] = bgv.x; acc[i][1] = bgv.y; acc[i][2] = bgv.z; acc[i][3] = bgv.w; }
#pragma unroll
      for (int r = 0; r < 16; ++r) { const f32x4 gv = *(const LAS f32x4*)(GR + dir * (16 * 68) + r * 68 + 4 * tb), wv = *(const LAS f32x4*)(WG + dir * 1024 + r * 64 + 4 * db);
          const float ga[4] = {gv.x, gv.y, gv.z, gv.w}, wa[4] = {wv.x, wv.y, wv.z, wv.w};
#pragma unroll
          for (int i = 0; i < 4; ++i)
#pragma unroll
              for (int j = 0; j < 4; ++j) acc[i][j] += ga[i] * wa[j]; }
#pragma unroll
      for (int i = 0; i < 4; ++i)
#pragma unroll
          for (int j = 0; j < 4; ++j) BCT[dir * (64 * 65) + (4 * db + j) * 65 + 4 * tb + i] = logsig16(acc[i][j]); }
    LBAR();
    { const int d = tid >> 3, seg = tid & 7;
#pragma unroll
      for (int dir = 0; dir < 2; ++dir) { LAS float* bp = BCT + dir * (64 * 65) + d * 65; float v[8]; float run = 0.f;
#pragma unroll
          for (int j = 0; j < 8; ++j) { const int tp = seg * 8 + j, tok = dir ? 63 - tp : tp; run += bp[tok]; v[j] = run; }
          float inc = run;
          { float t; t = dpp_f<0x111>(inc); if (seg >= 1) inc += t; t = dpp_f<0x112>(inc); if (seg >= 2) inc += t; t = dpp_f<0x114>(inc); if (seg >= 4) inc += t; }
          const float excl = inc - run;
#pragma unroll
          for (int j = 0; j < 8; ++j) { const int tp = seg * 8 + j, tok = dir ? 63 - tp : tp; bp[tok] = v[j] + excl; }
          if (seg == 7) TOT[dir * 64 + d] = inc; } }
    LBAR();
}
constexpr int G3_KEROWB = 192, G3_VROWB = 320;
constexpr int G3_KE = G2_QI;
constexpr int G3_V = G2_VT;
constexpr int G3_STI = 0;
static_assert(G3_KE + 2 * 64 * G3_KEROWB <= G3_V && G3_V + 64 * G3_VROWB <= MISC_OFF && 2 * 128 * GL_ROWB <= G2_QI, "GLA v3 LDS map");
typedef short v4i16_t __attribute__((ext_vector_type(4)));
__device__ __forceinline__ gbf16x8 gl_frag_tr(const LAS unsigned char* p, int rowb) {
    const v4i16_t lo = __builtin_amdgcn_ds_read_tr16_b64_v4i16((LAS v4i16_t*)p);
    const v4i16_t hi = __builtin_amdgcn_ds_read_tr16_b64_v4i16((LAS v4i16_t*)(p + 4 * rowb));
    return (gbf16x8){lo[0], lo[1], lo[2], lo[3], hi[0], hi[1], hi[2], hi[3]};
}

__device__ __forceinline__ void gla_local_mfma(const Args& a, unsigned char* lds, int k0, int k1, unsigned long long& tp_) {
    LAS unsigned char* L = (LAS unsigned char*)lds;
    const int tid = threadIdx.x, lane = tid & 63, wave = __builtin_amdgcn_readfirstlane(tid >> 6), r = lane & 31, hh = lane >> 5, g1 = (lane >> 4) & 1, q4 = (lane >> 2) & 3, p4 = lane & 3;
    const bf16* gp = (const bf16*)(a.ws + WS_GPROJ); bf16* ST = (bf16*)(a.ws + WS_XN); float* DEC = (float*)(a.ws + WS_DEC);
    LAS float* TOT = (LAS float*)(L + G2_TOT); LAS float* BCT = (LAS float*)(L + G2_BCT);
    const int tokA = tid >> 3, dgA = tid & 7;
    const int tokB = tid >> 4, peB = tid & 15;
    for (int kq = k0; kq < k1; ++kq) { const int ci = blockIdx.x + kq * gridDim.x; if (ci >= NB * 4 * NSIG) break;
        const int ck = ci % NSIG, h = (ci / NSIG) & 3, b = ci / (NSIG * 4);
        const size_t row0 = ck < 4 ? (size_t)MLAT + b * CTXL + ck * 64 : (size_t)b * SEQ + (ck - 4) * 64;
        GateRegs g; gla_gate_loads(a, g, gp, row0, h);
        const v4u kr = *(const v4u*)(gp + (row0 + tokA) * NGL + GK + h * 64 + dgA * 8);
        const v4u v0 = *(const v4u*)(gp + (row0 + tokB) * NGL + GV + h * 128 + peB * 8), v1 = *(const v4u*)(gp + (row0 + tokB + 32) * NGL + GV + h * 128 + peB * 8);
        gla_gates2(L, g);
        { float kv[8]; unpack8(kr, kv);
#pragma unroll
          for (int dir = 0; dir < 2; ++dir) { float ko[8];
#pragma unroll
              for (int i = 0; i < 8; ++i) { const int d = dgA * 8 + i; ko[i] = kv[i] * __expf(TOT[dir * 64 + d] - BCT[dir * (64 * 65) + d * 65 + tokA]); }
              v4u kw; kw.x = pk2(ko[0], ko[1]); kw.y = pk2(ko[2], ko[3]); kw.z = pk2(ko[4], ko[5]); kw.w = pk2(ko[6], ko[7]);
              *(LAS v4u*)(L + G3_KE + dir * 64 * G3_KEROWB + tokA * G3_KEROWB + dgA * 16) = kw; }
          *(LAS v4u*)(L + G3_V + tokB * G3_VROWB + peB * 16) = v0; *(LAS v4u*)(L + G3_V + (tokB + 32) * G3_VROWB + peB * 16) = v1;
          if (tid < 128) DEC[gla_item(b, h, tid >> 6, ck) * 64 + (tid & 63)] = __expf(TOT[tid]); }
        LBAR();
#pragma unroll
        for (int j = 0; j < 2; ++j) { const int tile = 2 * wave + j, dir = tile >> 3, mt = (tile >> 2) & 1, nt = tile & 3;
            gf32x16 acc;
#pragma unroll
            for (int i = 0; i < 16; ++i) acc[i] = 0.f;
            const LAS unsigned char* ap = L + G3_KE + dir * 64 * G3_KEROWB + (8 * hh + q4) * G3_KEROWB + (mt * 32 + 16 * g1 + 4 * p4) * 2;
            const LAS unsigned char* bp = L + G3_V + (8 * hh + q4) * G3_VROWB + (nt * 32 + 16 * g1 + 4 * p4) * 2;
#pragma unroll
            for (int kk = 0; kk < 4; ++kk) acc = __builtin_amdgcn_mfma_f32_32x32x16_bf16(gl_frag_tr(ap + 16 * kk * G3_KEROWB, G3_KEROWB), gl_frag_tr(bp + 16 * kk * G3_VROWB, G3_VROWB), acc, 0, 0, 0);
            bf16* sp = ST + gla_item(b, h, dir, ck) * 8192 + (nt * 32 + r) * 64 + mt * 32 + 4 * hh;
#pragma unroll
            for (int gq = 0; gq < 4; ++gq) { v2u o; o.x = pk2(acc[4 * gq], acc[4 * gq + 1]); o.y = pk2(acc[4 * gq + 2], acc[4 * gq + 3]); *(v2u*)(sp + 8 * gq) = o; } }
        LBAR();
        STAMP(44);
    }
}

__device__ __forceinline__ void gla_scan(const Args& a) {
    bf16* ST = (bf16*)(a.ws + WS_XN); const float* DEC = (const float*)(a.ws + WS_DEC);
    static_assert(NSIG % 4 == 0, "scan batches");
    for (int w = blockIdx.x * NTHR + threadIdx.x; w < 64 * 1024; w += gridDim.x * NTHR) {
        const int chain = w >> 10, el = (w & 1023) * 8, d0 = el & 63; float s[8];
#pragma unroll
        for (int i = 0; i < 8; ++i) s[i] = 0.f;
        constexpr int NBAT = 4;
        v4u dsv[2][NBAT]; f32x4 dv0[2][NBAT], dv1[2][NBAT];
#pragma unroll
        for (int k = 0; k < NBAT; ++k) { const size_t item = (size_t)chain * NSIG + k; dsv[0][k] = *(const v4u*)(ST + item * 8192 + el); dv0[0][k] = *(const f32x4*)(DEC + item * 64 + d0); dv1[0][k] = *(const f32x4*)(DEC + item * 64 + d0 + 4); }
#pragma unroll
        for (int bt = 0; bt < NSIG / NBAT; ++bt) { const int cur = bt & 1, nxt = cur ^ 1;
            if (bt + 1 < NSIG / NBAT) {
#pragma unroll
                for (int k = 0; k < NBAT; ++k) { const size_t item = (size_t)chain * NSIG + (bt + 1) * NBAT + k; dsv[nxt][k] = *(const v4u*)(ST + item * 8192 + el); dv0[nxt][k] = *(const f32x4*)(DEC + item * 64 + d0); dv1[nxt][k] = *(const f32x4*)(DEC + item * 64 + d0 + 4); } }
#pragma unroll
            for (int k = 0; k < NBAT; ++k) { const size_t item = (size_t)chain * NSIG + bt * NBAT + k; const v4u dsq = dsv[cur][k]; const f32x4 d0v = dv0[cur][k], d1v = dv1[cur][k];
                v4u o; o.x = pk2(s[0], s[1]); o.y = pk2(s[2], s[3]); o.z = pk2(s[4], s[5]); o.w = pk2(s[6], s[7]); *(v4u*)(ST + item * 8192 + el) = o;
                s[0] = d0v.x * s[0] + bf2f(dsq.x & 0xffffu); s[1] = d0v.y * s[1] + bf2f(dsq.x >> 16);
                s[2] = d0v.z * s[2] + bf2f(dsq.y & 0xffffu); s[3] = d0v.w * s[3] + bf2f(dsq.y >> 16);
                s[4] = d1v.x * s[4] + bf2f(dsq.z & 0xffffu); s[5] = d1v.y * s[5] + bf2f(dsq.z >> 16);
                s[6] = d1v.z * s[6] + bf2f(dsq.w & 0xffffu); s[7] = d1v.w * s[7] + bf2f(dsq.w >> 16); } }
    }
}

__device__ __forceinline__ void gla_out_mfma(const Args& a, unsigned char* lds, unsigned long long& tp_) {
    LAS unsigned char* L = (LAS unsigned char*)lds;
    const int tid = threadIdx.x, lane = tid & 63, wave = __builtin_amdgcn_readfirstlane(tid >> 6), r = lane & 31, hh = lane >> 5, g1 = (lane >> 4) & 1, q4 = (lane >> 2) & 3, p4 = lane & 3;
    const bf16* gp = (const bf16*)(a.ws + WS_GPROJ); const bf16* ST = (const bf16*)(a.ws + WS_XN); bf16* ycat = (bf16*)(a.ws + WS_YCAT);
    LAS float* BCT = (LAS float*)(L + G2_BCT); LAS float* OB = (LAS float*)(L + G2_OB); LAS float* RS = (LAS float*)(L + G2_RS);
    const int tokA = tid >> 3, dgA = tid & 7;
    const int tokB = tid >> 4, peB = tid & 15;
    float gnv[8];
#pragma unroll
    for (int i = 0; i < 8; ++i) gnv[i] = a.in[I_GLAN][peB * 8 + i];
    GateRegs g;
    if ((int)blockIdx.x < NB * 4 * 64) { const int it0 = blockIdx.x; gla_gate_loads(a, g, gp, (size_t)(it0 >> 8) * SEQ + (it0 & 63) * 64, (it0 >> 6) & 3); }
    for (int it = blockIdx.x; it < NB * 4 * 64; it += gridDim.x) {
        const int n = it & 63, h = (it >> 6) & 3, b = it >> 8; const size_t row0 = (size_t)b * SEQ + n * 64;
        const v4u qr = *(const v4u*)(gp + (row0 + tokA) * NGL + GQ + h * 64 + dgA * 8), kr = *(const v4u*)(gp + (row0 + tokA) * NGL + GK + h * 64 + dgA * 8);
        const bf16* rb0 = gp + (row0 + tokB) * NGL + h * 128 + peB * 8; const bf16* rb1 = rb0 + (size_t)32 * NGL;
        const v4u v0 = *(const v4u*)(rb0 + GV), v1 = *(const v4u*)(rb1 + GV), og0 = *(const v4u*)(rb0 + GOG), og1 = *(const v4u*)(rb1 + GOG);
        v4u stv[2][2];
#pragma unroll
        for (int dir = 0; dir < 2; ++dir) { const bf16* sp = ST + gla_item(b, h, dir, n + 4) * 8192 + tokA * 64 + dgA * 8; stv[dir][0] = *(const v4u*)sp; stv[dir][1] = *(const v4u*)(sp + 64 * 64); }
        STAMP(50);
        gla_gates2(L, g);
        STAMP(45);
        { float qv[8], kv[8]; unpack8(qr, qv); unpack8(kr, kv);
#pragma unroll
          for (int dir = 0; dir < 2; ++dir) { float qo[8], ko[8];
#pragma unroll
              for (int i = 0; i < 8; ++i) { const float bc = BCT[dir * (64 * 65) + (dgA * 8 + i) * 65 + tokA]; qo[i] = qv[i] * 0.125f * __expf(bc); ko[i] = kv[i] * __expf(-bc); }
              v4u qw, kw; qw.x = pk2(qo[0], qo[1]); qw.y = pk2(qo[2], qo[3]); qw.z = pk2(qo[4], qo[5]); qw.w = pk2(qo[6], qo[7]);
              kw.x = pk2(ko[0], ko[1]); kw.y = pk2(ko[2], ko[3]); kw.z = pk2(ko[4], ko[5]); kw.w = pk2(ko[6], ko[7]);
              *(LAS v4u*)(L + G2_QI + dir * 64 * GL_ROWB + tokA * GL_ROWB + dgA * 16) = qw;
              *(LAS v4u*)(L + G2_KI + dir * 64 * GL_ROWB + tokA * GL_ROWB + dgA * 16) = kw; }
          *(LAS v4u*)(L + G3_V + tokB * G3_VROWB + peB * 16) = v0; *(LAS v4u*)(L + G3_V + (tokB + 32) * G3_VROWB + peB * 16) = v1; }
        LBAR();
        STAMP(46);
#pragma unroll
        for (int dir = 0; dir < 2; ++dir) { *(LAS v4u*)(L + G3_STI + dir * 128 * GL_ROWB + tokA * GL_ROWB + dgA * 16) = stv[dir][0]; *(LAS v4u*)(L + G3_STI + dir * 128 * GL_ROWB + (tokA + 64) * GL_ROWB + dgA * 16) = stv[dir][1]; }
        { const int dir = wave >> 2, mt = (wave >> 1) & 1, nt = wave & 1;
          gf32x16 acc;
#pragma unroll
          for (int i = 0; i < 16; ++i) acc[i] = 0.f;
          const LAS unsigned char* ap = L + G2_QI + dir * 64 * GL_ROWB + (mt * 32 + r) * GL_ROWB + 16 * hh;
          const LAS unsigned char* bp = L + G2_KI + dir * 64 * GL_ROWB + (nt * 32 + r) * GL_ROWB + 16 * hh;
#pragma unroll
          for (int kk = 0; kk < 4; ++kk) acc = __builtin_amdgcn_mfma_f32_32x32x16_bf16(gl_frag(ap + 32 * kk), gl_frag(bp + 32 * kk), acc, 0, 0, 0);
          LAS bf16* at = (LAS bf16*)(L + G2_ATT + dir * 64 * GL_ROWB); const int sc = nt * 32 + r;
#pragma unroll
          for (int i = 0; i < 16; ++i) { const int c = mt * 32 + (i & 3) + 8 * (i >> 2) + 4 * hh; const bool keep = dir == 0 ? (sc <= c) : (sc >= c);
              at[c * 72 + sc] = (bf16)f2bf(keep ? acc[i] : 0.f); } }
        LBAR();
        STAMP(47);
        { const int omt = wave >> 2, ont = wave & 3;
          gf32x16 acc;
#pragma unroll
          for (int i = 0; i < 16; ++i) acc[i] = 0.f;
          const LAS unsigned char* vp = L + G3_V + (8 * hh + q4) * G3_VROWB + (ont * 32 + 16 * g1 + 4 * p4) * 2;
#pragma unroll
          for (int dir = 0; dir < 2; ++dir) {
              const LAS unsigned char* ap = L + G2_ATT + dir * 64 * GL_ROWB + (omt * 32 + r) * GL_ROWB + 16 * hh;
#pragma unroll
              for (int kk = 0; kk < 4; ++kk) acc = __builtin_amdgcn_mfma_f32_32x32x16_bf16(gl_frag(ap + 32 * kk), gl_frag_tr(vp + 16 * kk * G3_VROWB, G3_VROWB), acc, 0, 0, 0);
              const LAS unsigned char* qp = L + G2_QI + dir * 64 * GL_ROWB + (omt * 32 + r) * GL_ROWB + 16 * hh;
              const LAS unsigned char* sp = L + G3_STI + dir * 128 * GL_ROWB + (ont * 32 + r) * GL_ROWB + 16 * hh;
#pragma unroll
              for (int kk = 0; kk < 4; ++kk) acc = __builtin_amdgcn_mfma_f32_32x32x16_bf16(gl_frag(qp + 32 * kk), gl_frag(sp + 32 * kk), acc, 0, 0, 0);
          }
          LBAR();
#pragma unroll
          for (int i = 0; i < 16; ++i) { const int c = omt * 32 + (i & 3) + 8 * (i >> 2) + 4 * hh; OB[c * 132 + ont * 32 + r] = acc[i]; } }
        LBAR();
        STAMP(48);
#pragma unroll
        for (int t2 = 0; t2 < 2; ++t2) { const int tok = tokB + 32 * t2; float gg[8]; unpack8(t2 ? og1 : og0, gg);
            const f32x4 a0 = *(const LAS f32x4*)(OB + tok * 132 + peB * 8), a1 = *(const LAS f32x4*)(OB + tok * 132 + peB * 8 + 4);
            const float ov[8] = {a0.x, a0.y, a0.z, a0.w, a1.x, a1.y, a1.z, a1.w}; float y[8];
            const float ss = row16_sum(((a0.x * a0.x + a0.y * a0.y) + (a0.z * a0.z + a0.w * a0.w)) + ((a1.x * a1.x + a1.y * a1.y) + (a1.z * a1.z + a1.w * a1.w)));
            const float rstd = rsqrtf(ss * (1.f / 128.f) + EPSF);
#pragma unroll
            for (int i = 0; i < 8; ++i) y[i] = ov[i] * rstd * gnv[i] * siluf(gg[i]);
            v4u w0; w0.x = pk2(y[0], y[1]); w0.y = pk2(y[2], y[3]); w0.z = pk2(y[4], y[5]); w0.w = pk2(y[6], y[7]);
            *(v4u*)(ycat + (row0 + tok) * DM + DH + h * 128 + peB * 8) = w0; }
        { const int itn = it + gridDim.x; if (itn < NB * 4 * 64) gla_gate_loads(a, g, gp, (size_t)(itn >> 8) * SEQ + (itn & 63) * 64, (itn >> 6) & 3); }
        LBAR();
        STAMP(49);
    }
}

typedef short hbf16x8 __attribute__((ext_vector_type(8)));
typedef float hf32x16 __attribute__((ext_vector_type(16)));
constexpr int HK_COPYB = 16448, HK_OFF = 0, HZ_OFF = 4 * HK_COPYB, HZ_ROWB = 8208, HZERO_OFF = HZ_OFF + 8 * HZ_ROWB, HRED_OFF = HZERO_OFF + 64;
constexpr int HK_VEC = 4 * HK_COPYB / 16;
static_assert(HRED_OFF + 64 <= MISC_OFF && 8 * HZ_ROWB <= 4 * HK_COPYB, "hyena LDS map");
__device__ __forceinline__ void hy_unpack8(const v4u r, float* o) {
    o[0] = bf2f(r.x & 0xffffu); o[1] = bf2f(r.x >> 16); o[2] = bf2f(r.y & 0xffffu); o[3] = bf2f(r.y >> 16);
    o[4] = bf2f(r.z & 0xffffu); o[5] = bf2f(r.z >> 16); o[6] = bf2f(r.w & 0xffffu); o[7] = bf2f(r.w >> 16);
}
__device__ __forceinline__ void hyena_conv_mfma(const Args& a, unsigned char* lds, int j0, int j1, unsigned long long& tp_) {
    LAS unsigned char* L = (LAS unsigned char*)lds;
    const int tid = threadIdx.x, lane = tid & 63, wave = __builtin_amdgcn_readfirstlane(tid >> 6), r = lane & 31, h = lane >> 5;
    const bf16* hyT = (const bf16*)(a.ws + WS_HYT); bf16* yT = (bf16*)(a.ws + WS_YT); const float* Kraw = (const float*)(a.ws + WS_KRAW); const float* SSQ = (const float*)(a.ws + WS_SSQ);
    const float* cw = a.in[I_CONVW]; const float* cbv = a.in[I_CONVB];
    for (int jq = j0; jq < j1; ++jq) { const int c = blockIdx.x + jq * gridDim.x; if (c >= DH) break;
        STAMP(40);
        { const float part = SSQ[(tid >> 1) * 1024 + (tid & 1) * 512 + c]; const float wsum = wave_sum(part); if (lane == 0) ((LAS float*)(L + HRED_OFF))[wave] = wsum; }
        { f32x4 kv[4];
#pragma unroll
          for (int i = 0; i < 4; ++i) kv[i] = *(const f32x4*)(Kraw + (size_t)c * 8192 + 4 * (tid + NTHR * i));
#pragma unroll
          for (int i = 0; i < 4; ++i) { const int x0 = 8192 - 4 * (tid + NTHR * i); const float kf[4] = {kv[i].x, kv[i].y, kv[i].z, kv[i].w};
#pragma unroll
              for (int e = 0; e < 4; ++e) { const bf16 hv = (bf16)f2bf(kf[e]);
#pragma unroll
                  for (int s = 0; s < 4; ++s) { const int y = x0 - e - s; if (y >= 0) *(LAS bf16*)(L + HK_OFF + s * HK_COPYB + 2 * y) = hv; } } } }
        if (tid < 4) ((LAS unsigned*)(L + HZERO_OFF))[tid] = 0u;
        { const int c1 = DH + c, c2 = 2 * DH + c;
          const float a0 = cw[c1], a1 = cw[NHY + c1], a2 = cw[2 * NHY + c1], ab = cbv[c1], b0 = cw[c2], b1 = cw[NHY + c2], b2 = cw[2 * NHY + c2], bb = cbv[c2];
#pragma unroll
          for (int ps = 0; ps < 2; ++ps) { v4u r1[4], r2[4]; bf16 e1[4][2], e2[4][2];
#pragma unroll
              for (int i = 0; i < 4; ++i) { const int gi = tid + NTHR * (4 * ps + i), b = gi >> 9, t0 = (gi & 511) * 8, col = b * SEQ + t0;
                  const bf16* p1 = hyT + (size_t)c1 * MLAT + col; const bf16* p2 = hyT + (size_t)c2 * MLAT + col;
                  r1[i] = *(const v4u*)p1; r2[i] = *(const v4u*)p2;
                  const bool hl = (t0 & 63) != 0, hr = ((t0 + 8) & 63) != 0;
                  e1[i][0] = p1[hl ? -1 : 0]; e2[i][0] = p2[hl ? -1 : 0]; e1[i][1] = p1[hr ? 8 : 7]; e2[i][1] = p2[hr ? 8 : 7]; }
#pragma unroll
              for (int i = 0; i < 4; ++i) { const int gi = tid + NTHR * (4 * ps + i), b = gi >> 9, t0 = (gi & 511) * 8;
                  float u[10], w[10]; hy_unpack8(r1[i], u + 1); hy_unpack8(r2[i], w + 1);
                  const bool hl = (t0 & 63) != 0, hr = ((t0 + 8) & 63) != 0;
                  u[0] = hl ? bf2f(e1[i][0]) : 0.f; w[0] = hl ? bf2f(e2[i][0]) : 0.f; u[9] = hr ? bf2f(e1[i][1]) : 0.f; w[9] = hr ? bf2f(e2[i][1]) : 0.f;
                  float z[8];
#pragma unroll
                  for (int k = 0; k < 8; ++k) z[k] = (ab + a0 * u[k] + a1 * u[k + 1] + a2 * u[k + 2]) * (bb + b0 * w[k] + b1 * w[k + 1] + b2 * w[k + 2]);
                  v4u o; o.x = pk2(z[0], z[1]); o.y = pk2(z[2], z[3]); o.z = pk2(z[4], z[5]); o.w = pk2(z[6], z[7]);
                  *(LAS v4u*)(L + HZ_OFF + b * HZ_ROWB + 2 * t0) = o; } } }
        LBAR();
        STAMP(41);
        float sc;
        { float tot = 0.f;
#pragma unroll
          for (int i = 0; i < 8; ++i) tot += ((const LAS float*)(L + HRED_OFF))[i];
          sc = rsqrtf(tot + EPSF); }
        hf32x16 acc[2][2];
#pragma unroll
        for (int m = 0; m < 2; ++m)
#pragma unroll
            for (int n = 0; n < 2; ++n)
#pragma unroll
                for (int i = 0; i < 16; ++i) acc[m][n][i] = 0.f;
        const int I0 = 8 * wave, q = r >> 3, b = r & 7, sh = (-r) & 3;
        const int a_lane = HK_OFF + sh * HK_COPYB + 2 * (4096 - r + 8 * h - sh);
        const int b_lane = HZ_OFF + b * HZ_ROWB + 16 * h;
#define HY_LOADA(dd, AF) do { const int ab_ = a_lane - 128 * (dd); _Pragma("unroll") for (int f = 0; f < 6; ++f) { const int ad = ab_ - 64 + 32 * f; \
            const v2u lo = *(const volatile LAS v2u*)(L + ad), hi = *(const volatile LAS v2u*)(L + ad + 8); AF[f] = __builtin_bit_cast(hbf16x8, (v4u){lo.x, lo.y, hi.x, hi.y}); } } while (0)
#define HY_LOADB(dd, kk_, BF) do { const int J0_ = I0 + q - (dd), J1_ = J0_ + 4; const bool k0_ = (unsigned)J0_ < 64u, k1_ = (unsigned)J1_ < 64u; \
            BF[0] = __builtin_bit_cast(hbf16x8, *(const LAS v4u*)(L + (k0_ ? b_lane + 128 * J0_ + 32 * (kk_) : HZERO_OFF))); \
            BF[1] = __builtin_bit_cast(hbf16x8, *(const LAS v4u*)(L + (k1_ ? b_lane + 128 * J1_ + 32 * (kk_) : HZERO_OFF))); } while (0)
        for (int rep_ = 0; rep_ < 1 + ((PROBE_REPEAT >> 5) & 1); ++rep_) {
        const int dlo = I0 - 63, dhi = I0 + 7;
        hbf16x8 afc[6], bfc[2];
        HY_LOADA(dlo, afc); HY_LOADB(dlo, 0, bfc);
        for (int d = dlo; d <= dhi; ++d) {
            const int dn = d < dhi ? d + 1 : dhi;
            hbf16x8 afn[6], bfn[2];
#pragma unroll
            for (int kk = 0; kk < 4; ++kk) {
                if (kk == 0) HY_LOADA(dn, afn);
                if (kk < 3) HY_LOADB(d, kk + 1, bfn); else HY_LOADB(dn, 0, bfn);
                __builtin_amdgcn_sched_barrier(0);
#pragma unroll
                for (int m = 0; m < 2; ++m)
#pragma unroll
                    for (int n = 0; n < 2; ++n) acc[m][n] = __builtin_amdgcn_mfma_f32_32x32x16_bf16(afc[kk + 2 - 2 * m], bfc[n], acc[m][n], 0, 0, 0);
                __builtin_amdgcn_sched_barrier(0);
                bfc[0] = bfn[0]; bfc[1] = bfn[1];
            }
#pragma unroll
            for (int f = 0; f < 6; ++f) afc[f] = afn[f];
        }
        }
#undef HY_LOADA
#undef HY_LOADB
        v4u x0v[8];
#pragma unroll
        for (int i = 0; i < 8; ++i) { const int gi = tid + NTHR * i, bb = gi >> 9, t0 = (gi & 511) * 8; x0v[i] = *(const v4u*)(hyT + (size_t)c * MLAT + bb * SEQ + t0); }
        STAMP(42);
        LBAR();  STAMP(51);
#pragma unroll
        for (int i = 0; i < 8; ++i) { const int gi = tid + NTHR * i, bb = gi >> 9, t0 = (gi & 511) * 8; *(LAS v4u*)(L + HK_OFF + bb * HZ_ROWB + 2 * t0) = x0v[i]; }
        LBAR();
        STAMP(52);
        for (int repe_ = 0; repe_ < 1 + ((PROBE_REPEAT >> 7) & 1); ++repe_)
        { const float w0 = cw[c], w1 = cw[NHY + c], w2 = cw[2 * NHY + c], wb = cbv[c], hb = a.in[I_HBIAS][c];
#pragma unroll
          for (int m = 0; m < 2; ++m)
#pragma unroll
              for (int n = 0; n < 2; ++n)
#pragma unroll
                  for (int g = 0; g < 4; ++g) { const int t0 = 64 * (I0 + 4 * n + q) + 32 * m + 8 * g + 4 * h;
                      const LAS bf16* xp = (const LAS bf16*)(L + HK_OFF + b * HZ_ROWB + 2 * t0);
                      const v2u xr = *(const LAS v2u*)xp; const v2u zr = *(const LAS v2u*)(L + HZ_OFF + b * HZ_ROWB + 2 * t0);
                      float xv[6];
                      const bool xl = (t0 & 63) != 0, xh = ((t0 + 4) & 63) != 0; const bf16 xlv = xp[xl ? -1 : 0], xhv = xp[xh ? 4 : 3];
                      xv[0] = xl ? bf2f(xlv) : 0.f; xv[5] = xh ? bf2f(xhv) : 0.f;
                      xv[1] = bf2f(xr.x & 0xffffu); xv[2] = bf2f(xr.x >> 16); xv[3] = bf2f(xr.y & 0xffffu); xv[4] = bf2f(xr.y >> 16);
                      const float zv[4] = {bf2f(zr.x & 0xffffu), bf2f(zr.x >> 16), bf2f(zr.y & 0xffffu), bf2f(zr.y >> 16)};
                      float y[4];
#pragma unroll
                      for (int k = 0; k < 4; ++k) y[k] = (wb + w0 * xv[k] + w1 * xv[k + 1] + w2 * xv[k + 2]) * (acc[m][n][4 * g + k] * (((PROBE_REPEAT >> 5) & 1) ? 0.5f * sc : sc) + hb * zv[k]);
                      v2u o; o.x = pk2(y[0], y[1]); o.y = pk2(y[2], y[3]);
                      *(LAS v2u*)(L + HZ_OFF + b * HZ_ROWB + 2 * t0) = o; } }
        LBAR();
        STAMP(53);
#pragma unroll
        for (int i = 0; i < 8; ++i) { const int gi = tid + NTHR * i, bb = gi >> 9, t0 = (gi & 511) * 8;
            *(v4u*)(yT + (size_t)c * MLAT + bb * SEQ + t0) = *(const LAS v4u*)(L + HZ_OFF + bb * HZ_ROWB + 2 * t0); }
        LBAR();
        STAMP(43);
    }
}
__device__ __forceinline__ void hyena_transpose(const Args& a, unsigned char* lds) {
    const int tid = threadIdx.x, lane = tid & 63, wave = tid >> 6;
    bf16* scr = (bf16*)(lds + wave * 16384);
    const bf16* yT = (const bf16*)(a.ws + WS_YT); bf16* ycat = (bf16*)(a.ws + WS_YCAT);
    const int gw = blockIdx.x * NWAVES + wave, NGW = gridDim.x * NWAVES;
    for (int t = gw; t < (DH / 64) * (MLAT / 64); t += NGW) { const int cb = t & 7, tb = t >> 3, c0 = cb * 64, k0 = tb * 64;
        for (int r = 0; r < 64; ++r) scr[r * 66 + lane] = yT[(size_t)(c0 + r) * MLAT + k0 + lane];
        LDS_WAIT(); asm volatile("" ::: "memory");
        for (int r = 0; r < 64; ++r) ycat[(size_t)(k0 + r) * DM + c0 + lane] = scr[lane * 66 + r];
        LDS_WAIT(); asm volatile("" ::: "memory"); }
}

__device__ __forceinline__ void bias2_gemv(const Args& a) {
    const int tid = threadIdx.x, lane = tid & 63, wave = tid >> 6;
    const int gw = blockIdx.x * NWAVES + wave, NGW = gridDim.x * NWAVES;
    const bf16* W1T = (const bf16*)(a.ws + WS_W1); const float* mod = (const float*)(a.ws + WS_MOD); float* B2 = (float*)(a.ws + WS_BIAS2);
    for (int n = gw; n < FF; n += NGW) {
        const v4u w0 = *(const v4u*)(W1T + (size_t)n * DM + lane * 8), w1 = *(const v4u*)(W1T + (size_t)n * DM + 512 + lane * 8);
        float wf[16]; unpack8(w0, wf); unpack8(w1, wf + 8);
        float accb[NB];
#pragma unroll
        for (int b = 0; b < NB; ++b) { const float* sh = mod + b * MODW + MOD_SH2; const f32x4 p0 = *(const f32x4*)(sh + lane * 8), p1 = *(const f32x4*)(sh + lane * 8 + 4), p2 = *(const f32x4*)(sh + 512 + lane * 8), p3 = *(const f32x4*)(sh + 512 + lane * 8 + 4);
            float s = (p0.x * wf[0] + p0.y * wf[1]) + (p0.z * wf[2] + p0.w * wf[3]) + (p1.x * wf[4] + p1.y * wf[5]) + (p1.z * wf[6] + p1.w * wf[7]);
            s += (p2.x * wf[8] + p2.y * wf[9]) + (p2.z * wf[10] + p2.w * wf[11]) + (p3.x * wf[12] + p3.y * wf[13]) + (p3.z * wf[14] + p3.w * wf[15]);
            accb[b] = wave_sum(s); }
        if (lane < NB) { float v = accb[0];
#pragma unroll
            for (int b = 1; b < NB; ++b) v = lane == b ? accb[b] : v;
            B2[lane * FF + n] = v; }
    }
}

#define XB_TMO      128
#define XB_XCNT(j)  (256  + 64 * (j))
#define XB_XSUB(j)  (1280 + 64 * (j))
#define XB_XGEN(j)  (2304 + 64 * (j))
#define XB_TOP      3328
#define XB_TOPGEN   3392
#define XCD_BAR_WORDS 3456
#define XB_SPIN_CAP (1u << 18)

__device__ __forceinline__ unsigned xb_ld(unsigned* p)              { return __hip_atomic_load(p, __ATOMIC_RELAXED, __HIP_MEMORY_SCOPE_AGENT); }
__device__ __forceinline__ unsigned xb_add(unsigned* p, unsigned v) { return __hip_atomic_fetch_add(p, v, __ATOMIC_RELAXED, __HIP_MEMORY_SCOPE_AGENT); }
__device__ __forceinline__ unsigned xb_xcc_id() { return (unsigned)__builtin_amdgcn_s_getreg((3 << 11) | 20) & 0xFu; }
#define XB_SPIN(cond, bar) do { unsigned _sp = 0; while (cond) { __builtin_amdgcn_s_sleep(1); \
    if ((++_sp & 255u) == 0u) { if (xb_ld(&(bar)[XB_TMO])) break; if (_sp > XB_SPIN_CAP) { atomicAdd(&(bar)[XB_TMO], 1u); break; } } } } while (0)

struct XcdBarrier {
    unsigned* bar; unsigned x;
    volatile LAS unsigned* st;
};

__device__ __forceinline__ XcdBarrier xcd_barrier_post(unsigned* bar, volatile LAS unsigned* st) {
    XcdBarrier b; b.bar = bar; b.x = xb_xcc_id(); b.st = st;
    if (threadIdx.x == 0) (void)xb_add(&bar[XB_XCNT(b.x)], 1u);
    return b;
}
__device__ __forceinline__ void xcd_barrier_complete(unsigned* bar, unsigned x, unsigned& nloc, unsigned& nx) {
    const unsigned G = gridDim.x * gridDim.y * gridDim.z;
    unsigned sum, cnt, mine, sp = 0u;
    for (;;) {
        sum = 0u; cnt = 0u; mine = 0u;
#pragma unroll
        for (unsigned j = 0; j < 16; ++j) { const unsigned c = xb_ld(&bar[XB_XCNT(j)]); sum += c; cnt += (c > 0u) ? 1u : 0u; mine = (j == x) ? c : mine; }
        if (sum == G) break;
        __builtin_amdgcn_s_sleep(1);
        if ((++sp & 255u) == 0u) { if (xb_ld(&bar[XB_TMO])) break; if (sp > XB_SPIN_CAP) { atomicAdd(&bar[XB_TMO], 1u); break; } }
    }
    nloc = mine > 0u ? mine : 1u; nx = cnt > 0u ? cnt : 1u;
}

__device__ __forceinline__ void xcd_barrier(const XcdBarrier& b) {
    asm volatile("s_waitcnt vmcnt(0)" ::: "memory");
    __syncthreads();
    if (threadIdx.x == 0) {
        unsigned* bar = b.bar;
        __builtin_amdgcn_s_waitcnt(0);
        unsigned nloc = b.st[0], nx = b.st[1];
        if (nloc == 0u) { xcd_barrier_complete(bar, b.x, nloc, nx); b.st[0] = nloc; b.st[1] = nx; }
        const unsigned old = xb_add(&bar[XB_XSUB(b.x)], 1u);
        const unsigned gen = old / nloc;
        if (old + 1u == (gen + 1u) * nloc) {
            __builtin_amdgcn_fence(__ATOMIC_RELEASE, "agent");
            asm volatile("s_waitcnt vmcnt(0)" ::: "memory");
            const unsigned og = xb_add(&bar[XB_TOP], 1u);
            const unsigned tg = og / nx;
            if (og + 1u == (tg + 1u) * nx) xb_add(&bar[XB_TOPGEN], 1u);
            else XB_SPIN(xb_ld(&bar[XB_TOPGEN]) == tg, bar);
            __builtin_amdgcn_fence(__ATOMIC_ACQUIRE, "agent");
            xb_add(&bar[XB_XGEN(b.x)], 1u);
            asm volatile("s_waitcnt vmcnt(0)" ::: "memory");
        } else {
            XB_SPIN(xb_ld(&bar[XB_XGEN(b.x)]) == gen, bar);
            __builtin_amdgcn_fence(__ATOMIC_ACQUIRE, "agent");
            asm volatile("s_waitcnt vmcnt(0)" ::: "memory");
        }
    }
    __syncthreads();
}

constexpr int NPHASE = 11;
__global__ void __launch_bounds__(NTHR, 2) fwd_kernel(Args a) {
    extern __shared__ __attribute__((aligned(16))) unsigned char lds[];
    const int lo = a.ph_lo, hi = a.ph_hi;
    unsigned long long tp_ = PROBE_TS >= 0 ? __builtin_amdgcn_s_memrealtime() : 0ull;
    volatile LAS unsigned* MISC = (volatile LAS unsigned*)((LAS unsigned char*)lds + MISC_OFF);
    if (threadIdx.x < 16) MISC[threadIdx.x] = 0u;
    __syncthreads();
    XcdBarrier bar = xcd_barrier_post((unsigned*)(a.ws + WS_CTL) + CW_BAR, MISC + 8);
#define IN(k) (lo <= (k) && (k) < hi)
#define SEAM(k) do { STAMP(2 * (k)); if (IN(k) && IN((k) + 1)) xcd_barrier(bar); STAMP(2 * (k) + 1); } while (0)
    unsigned char* ws = a.ws;
    PG8_LAS unsigned char* ldsg = (PG8_LAS unsigned char*)lds;
    if (IN(0)) { for (int rep = 0; rep < 1 + ((PROBE_REPEAT >> 4) & 1); ++rep) { p0_prologue(a, lds); __syncthreads(); } } SEAM(0);
    if (IN(1)) { norm_mod_rows(a, a.in[I_X], a.in[I_CTX], MALL, a.in[I_NMIX], MOD_SC1, MOD_SH1, (bf16*)(ws + WS_XN)); } SEAM(1);
    if (IN(2)) {
        { pg8::Gemm g{(const pg8::bf16_t*)(ws + WS_WIN), (const pg8::bf16_t*)(ws + WS_XN), NHY, MLAT, DM}; pg8::StaticOrder S; S.init(NHY, MLAT, gridDim.x, blockIdx.x);
          pg8::EpiBf16<0> E{(pg8::bf16_t*)(ws + WS_HYT), MLAT};
          pg8::gemm_phase<pg8::EpiBf16<0>, pg8::StaticOrder, true, true>(ldsg, g, S, E); }
        __syncthreads();
        { pg8::Gemm g{(const pg8::bf16_t*)(ws + WS_XN), (const pg8::bf16_t*)(ws + WS_WIN) + (size_t)NHY * DM, MALL, NGL, DM}; pg8::StaticOrder S; S.init(MALL, NGL, gridDim.x, blockIdx.x);
          pg8::EpiBf16<0> E{(pg8::bf16_t*)(ws + WS_GPROJ), NGL};
          pg8::gemm_phase<pg8::EpiBf16<0>, pg8::StaticOrder, true, true>(ldsg, g, S, E); }
    } SEAM(2);
    if (IN(3)) {
        const int nG = (NB * 4 * NSIG - (int)blockIdx.x + (int)gridDim.x - 1) / (int)gridDim.x, nH = (DH - (int)blockIdx.x + (int)gridDim.x - 1) / (int)gridDim.x;
        const int pos0 = blockIdx.x & 7, hstep = 4; int kG = 0, jH = 0;
        for (;;) {
            const bool wantH = jH < nH && (kG >= nG || kG >= pos0 + hstep * jH);
            if (wantH) { hyena_conv_mfma(a, lds, jH, jH + 1, tp_); ++jH; }
            else if (kG < nG) { gla_local_mfma(a, lds, kG, kG + 1, tp_); ++kG; }
            else break;
        }
    } SEAM(3);
    if (IN(4)) { gla_scan(a); bias2_gemv(a); } SEAM(4);
    if (IN(5)) { for (int rep = 0; rep < 1 + ((PROBE_REPEAT >> 2) & 1); ++rep) { gla_out_mfma(a, lds, tp_); __syncthreads(); }
                 for (int rep = 0; rep < 1 + ((PROBE_REPEAT >> 3) & 1); ++rep) { hyena_transpose(a, lds); __syncthreads(); } } SEAM(5);
    if (IN(6)) { pg8::Gemm g{(const pg8::bf16_t*)(ws + WS_YCAT), (const pg8::bf16_t*)(ws + WS_WOUT), MLAT, DM, DM}; pg8::StaticOrder S; S.init(MLAT, DM, gridDim.x, blockIdx.x);
        pg8::EpiResidH2 E{a.in[I_X], a.out, DM, (const float*)(ws + WS_MOD) + MOD_G1, (const float*)(ws + WS_MOD) + MOD_SC2, a.in[I_NMLP], SEQ, MODW, (pg8::bf16_t*)(ws + WS_XN), (float*)(ws + WS_SSQ2)};
        pg8::gemm_phase<pg8::EpiResidH2, pg8::StaticOrder, true, true>(ldsg, g, S, E); } SEAM(6);
    if (IN(8)) { pg8::Gemm g{(const pg8::bf16_t*)(ws + WS_XN), (const pg8::bf16_t*)(ws + WS_W1), MLAT, FF, DM}; pg8::StaticOrder S; S.init(MLAT, FF, gridDim.x, blockIdx.x);
        pg8::EpiSqReluRstd E{(pg8::bf16_t*)(ws + WS_HID), FF, (const float*)(ws + WS_SSQ2), (const float*)(ws + WS_BIAS2), SEQ, FF, 1.0f / DM, EPSF};
        pg8::gemm_phase<pg8::EpiSqReluRstd, pg8::StaticOrder, true, true>(ldsg, g, S, E); } SEAM(8);
    if (IN(9)) { pg8::Gemm g{(const pg8::bf16_t*)(ws + WS_HID), (const pg8::bf16_t*)(ws + WS_W2), MLAT, DM, FF}; pg8::StaticOrder S; S.init(MLAT, DM, gridDim.x, blockIdx.x);
        pg8::EpiResidFromH2 E{(const pg8::bf16_t*)(ws + WS_XN), a.out, DM, (const float*)(ws + WS_MOD) + MOD_G2, (const float*)(ws + WS_MOD) + MOD_SC2, a.in[I_NMLP], SEQ, MODW};
        pg8::gemm_phase<pg8::EpiResidFromH2, pg8::StaticOrder, true, true>(ldsg, g, S, E); } SEAM(9);
    if (IN(10)) { final_norm_rows(a); }
    STAMP(20);
    if (PROBE_TS >= 0 && blockIdx.x == 0 && threadIdx.x == 0) a.out[0] = (float)((unsigned long long*)(a.ws + 32768))[PROBE_TS < 0 ? 0 : PROBE_TS] * 0.01f;
#undef IN
#undef SEAM
}

#ifndef N_LAUNCH_MODE
#define N_LAUNCH_MODE 1
#endif
extern "C" void kernel_launch(void* const* d_in, const int* in_sizes, int n_in, void* d_out, int out_size, void* d_ws, size_t ws_size, hipStream_t stream) {
    static int grid = 0;
    if (grid == 0) {
        if (n_in != 29 || out_size != MLAT * DM || ws_size < WS_END) { fprintf(stderr, "kernel_launch: unexpected shapes (n_in %d out %d ws %zu)\n", n_in, out_size, ws_size); grid = -1; return; }
        int dev = 0, cus = 0, per_cu = 0;
        if (hipGetDevice(&dev) != hipSuccess || hipDeviceGetAttribute(&cus, hipDeviceAttributeMultiprocessorCount, dev) != hipSuccess) { grid = -1; return; }
        if (hipFuncSetAttribute((const void*)fwd_kernel, hipFuncAttributeMaxDynamicSharedMemorySize, LDS_BYTES) != hipSuccess) { fprintf(stderr, "kernel_launch: hipFuncSetAttribute failed\n"); grid = -1; return; }
        if (hipOccupancyMaxActiveBlocksPerMultiprocessor(&per_cu, (const void*)fwd_kernel, NTHR, LDS_BYTES) != hipSuccess || per_cu < 1) { fprintf(stderr, "kernel_launch: occupancy query says %d blocks per CU\n", per_cu); (void)hipGetLastError(); grid = -1; return; }
        grid = cus;
    }
    if (grid < 0) return;
    Args a{};
    for (int i = 0; i < 29; ++i) a.in[i] = (const float*)d_in[i];
    a.out = (float*)d_out; a.ws = (unsigned char*)d_ws;
#if N_LAUNCH_MODE == 0
    for (int p = 0; p < NPHASE; ++p) { a.ph_lo = p; a.ph_hi = p + 1; hipLaunchKernelGGL(fwd_kernel, dim3(grid), dim3(NTHR), LDS_BYTES, stream, a); }
#else
    a.ph_lo = 0; a.ph_hi = NPHASE;
    if (hipMemsetAsync((char*)d_ws + WS_CTL, 0, CTL_ZERO_BYTES, stream) != hipSuccess) { fprintf(stderr, "kernel_launch: memset of the control words failed\n"); return; }
    hipLaunchKernelGGL(fwd_kernel, dim3(grid), dim3(NTHR), LDS_BYTES, stream, a);
#endif
}
```
